# Optimizing an MI355X kernel written in HIP

```python
import jax, jax.numpy as jnp
from jax import lax
import numpy as np

D_MODEL = 1024
BATCH = 8
SEQ = 8192
DEPTH = 1

CHUNK = 64
GMLP_BLOCK = 128
GMLP_WIDTH = D_MODEL
GMLP_GROUPS = 8
GMLP_GROUP_DIM = GMLP_WIDTH // GMLP_GROUPS
LRU_WIDTH = D_MODEL
LRU_HEADS = 16
LRU_HEAD_DIM = LRU_WIDTH // LRU_HEADS
CONV_WIDTH = 4
LRU_C = 8.0
D_FF = ((-(-8 * D_MODEL // 3) + 255) // 256) * 256
PLE_DIM = 256
EPS = 1e-6
SPLITS = (GMLP_WIDTH, 2 * GMLP_WIDTH, 2 * GMLP_WIDTH + LRU_WIDTH,
          2 * GMLP_WIDTH + 2 * LRU_WIDTH, 2 * GMLP_WIDTH + 2 * LRU_WIDTH + D_MODEL)
IN_COLS = 2 * GMLP_WIDTH + 2 * LRU_WIDTH + 2 * D_MODEL

kernel_name = "hybrid_gmlp_rglru_sandwich_block"


def rms_norm(x, g):
    xf = x.astype(jnp.float32)
    y = xf * lax.rsqrt(jnp.mean(xf * xf, axis=-1, keepdims=True) + EPS)
    return (y * g.astype(jnp.float32)).astype(x.dtype)


def layer_norm(x, g, b):
    xf = x.astype(jnp.float32)
    mu = jnp.mean(xf, axis=-1, keepdims=True)
    var = jnp.mean(jnp.square(xf - mu), axis=-1, keepdims=True)
    y = (xf - mu) * lax.rsqrt(var + EPS)
    return (y * g.astype(jnp.float32) + b.astype(jnp.float32)).astype(x.dtype)


def gmlp_spatial_gate(u, v, ln_g, ln_b, w_s, b_s):
    bsz, seq, _ = v.shape
    n_blk = seq // GMLP_BLOCK
    v = layer_norm(v, ln_g, ln_b)
    vb = v.reshape(bsz, n_blk, GMLP_BLOCK, GMLP_GROUPS, GMLP_GROUP_DIM)
    chunk_id = jnp.arange(GMLP_BLOCK) // CHUNK
    mask = chunk_id[None, :] <= chunk_id[:, None]
    w = jnp.where(mask[None], w_s, jnp.zeros_like(w_s))
    mixed = jnp.einsum('gij,bnjgc->bnigc', w, vb) + b_s.T[None, None, :, :, None]
    return u * mixed.reshape(bsz, seq, GMLP_WIDTH)


def causal_depthwise_conv(x, w, b):
    c = x.shape[-1]
    y = lax.conv_general_dilated(
        x, w[:, None, :].astype(x.dtype), window_strides=(1,),
        padding=[(CONV_WIDTH - 1, 0)],
        dimension_numbers=('NWC', 'WIO', 'NWC'), feature_group_count=c)
    return y + b


def block_diag_linear(x, w, b):
    bsz, seq, _ = x.shape
    xh = x.reshape(bsz, seq, LRU_HEADS, LRU_HEAD_DIM)
    y = jnp.einsum('bshi,hij->bshj', xh, w).reshape(bsz, seq, LRU_WIDTH)
    return y + b


def rg_lru(x, w_r, b_r, w_i, b_i, lam):
    r = jax.nn.sigmoid(block_diag_linear(x, w_r, b_r).astype(jnp.float32))
    i = jax.nn.sigmoid(block_diag_linear(x, w_i, b_i).astype(jnp.float32))
    log_a = -LRU_C * r * jax.nn.softplus(-lam.astype(jnp.float32))
    a = jnp.exp(log_a)
    gated_x = jnp.sqrt(-jnp.expm1(2.0 * log_a)) * (i * x.astype(jnp.float32))

    def combine(left, right):
        a1, h1 = left
        a2, h2 = right
        return a1 * a2, a2 * h1 + h2

    _, h = lax.associative_scan(combine, (a, gated_x), axis=1)
    return h.astype(x.dtype)


def setup_inputs(seed: int = 0) -> dict:
    key = jax.random.key(seed)
    ks = iter(jax.random.split(key, 40))

    def nrm(shape, fan_in):
        return jax.random.normal(next(ks), shape, jnp.float32) * (fan_in ** -0.5)

    def gain(shape):
        return 1.0 + 0.05 * jax.random.normal(next(ks), shape, jnp.float32)

    def bias(shape, scale=0.02):
        return scale * jax.random.normal(next(ks), shape, jnp.float32)

    L = DEPTH
    x = jax.random.normal(next(ks), (BATCH, SEQ, D_MODEL), jnp.float32)
    p = jax.random.normal(next(ks), (L, BATCH, SEQ, PLE_DIM), jnp.float32)
    a0 = jax.random.uniform(next(ks), (L, LRU_WIDTH), jnp.float32, minval=0.9, maxval=0.999)
    s = a0 ** (1.0 / LRU_C)
    lru_lambda = jnp.log(s) - jnp.log1p(-s)
    return {
        "x": x,
        "p": p,
        "norm_mix_pre": gain((L, D_MODEL)),
        "norm_mix_post": gain((L, D_MODEL)),
        "w_in": nrm((L, D_MODEL, IN_COLS), D_MODEL),
        "gmlp_ln_g": gain((L, GMLP_WIDTH)),
        "gmlp_ln_b": bias((L, GMLP_WIDTH)),
        "gmlp_w_s": nrm((L, GMLP_GROUPS, GMLP_BLOCK, GMLP_BLOCK), GMLP_BLOCK),
        "gmlp_b_s": 1.0 + 0.1 * jax.random.normal(next(ks), (L, GMLP_GROUPS, GMLP_BLOCK), jnp.float32),
        "conv_w": nrm((L, CONV_WIDTH, LRU_WIDTH), CONV_WIDTH),
        "conv_b": bias((L, LRU_WIDTH)),
        "lru_w_r": nrm((L, LRU_HEADS, LRU_HEAD_DIM, LRU_HEAD_DIM), LRU_HEAD_DIM),
        "lru_b_r": bias((L, LRU_WIDTH)),
        "lru_w_i": nrm((L, LRU_HEADS, LRU_HEAD_DIM, LRU_HEAD_DIM), LRU_HEAD_DIM),
        "lru_b_i": bias((L, LRU_WIDTH)),
        "lru_lambda": lru_lambda,
        "w_branch_a": nrm((L, GMLP_WIDTH, D_MODEL), GMLP_WIDTH),
        "w_branch_b": nrm((L, LRU_WIDTH, D_MODEL), LRU_WIDTH),
        "w_out": nrm((L, D_MODEL, D_MODEL), D_MODEL),
        "norm_ffn_pre": gain((L, D_MODEL)),
        "norm_ffn_post": gain((L, D_MODEL)),
        "ffn_w_gate": nrm((L, D_MODEL, D_FF), D_MODEL),
        "ffn_w_up": nrm((L, D_MODEL, D_FF), D_MODEL),
        "ffn_w_down": nrm((L, D_FF, D_MODEL), D_FF),
        "norm_ple_pre": gain((L, D_MODEL)),
        "norm_ple_post": gain((L, D_MODEL)),
        "ple_w_in": nrm((L, PLE_DIM, D_MODEL), PLE_DIM),
        "ple_w_gate": nrm((L, D_MODEL, D_MODEL), D_MODEL),
    }


def reference(x, p, norm_mix_pre, norm_mix_post, w_in, gmlp_ln_g, gmlp_ln_b, gmlp_w_s,
              gmlp_b_s, conv_w, conv_b, lru_w_r, lru_b_r, lru_w_i, lru_b_i, lru_lambda,
              w_branch_a, w_branch_b, w_out, norm_ffn_pre, norm_ffn_post, ffn_w_gate,
              ffn_w_up, ffn_w_down, norm_ple_pre, norm_ple_post, ple_w_in, ple_w_gate):
    for l in range(DEPTH):
        h = rms_norm(x, norm_mix_pre[l])
        z = h @ w_in[l]
        u, v, xr, yr, ga, gb = jnp.split(z, SPLITS, axis=-1)
        a_out = gmlp_spatial_gate(jax.nn.gelu(u), jax.nn.gelu(v), gmlp_ln_g[l], gmlp_ln_b[l],
                                  gmlp_w_s[l], gmlp_b_s[l])
        xr = causal_depthwise_conv(xr, conv_w[l], conv_b[l])
        b_out = rg_lru(xr, lru_w_r[l], lru_b_r[l], lru_w_i[l], lru_b_i[l], lru_lambda[l]) * jax.nn.gelu(yr)
        merged = jax.nn.sigmoid(ga) * (a_out @ w_branch_a[l]) + jax.nn.sigmoid(gb) * (b_out @ w_branch_b[l])
        x = x + rms_norm(merged @ w_out[l], norm_mix_post[l])
        h = rms_norm(x, norm_ffn_pre[l])
        f = (jax.nn.silu(h @ ffn_w_gate[l]) * (h @ ffn_w_up[l])) @ ffn_w_down[l]
        x = x + rms_norm(f, norm_ffn_post[l])
        gate = jax.nn.sigmoid(rms_norm(x, norm_ple_pre[l]) @ ple_w_gate[l])
        e = p[l] @ ple_w_in[l]
        x = x + rms_norm(gate * e, norm_ple_post[l])
    return x
```

```cpp
#include <hip/hip_runtime.h>
#include <hip/hip_cooperative_groups.h>
#include <cstdio>
#include <cstdint>
namespace cg = cooperative_groups;
#ifndef REP_MASK
#define REP_MASK 0
#endif
#ifndef MK_ONE
#define MK_ONE 1
#endif
namespace pg8 {
#define PG8_LAS __attribute__((address_space(3)))
typedef unsigned short bf16_t;
typedef short bf16x8 __attribute__((ext_vector_type(8)));
typedef float f32x4 __attribute__((ext_vector_type(4)));
typedef unsigned u32x4 __attribute__((ext_vector_type(4)));
constexpr int BM = 256, BK = 64, HALF = 128, HTB = HALF * BK * 2  , STAGE_BYTES = 8 * HTB, NXCD = 8, WGM = 8;

__host__ __device__ __forceinline__ int lds_byte(int r, int c) { const int st = (r >> 4) * 2 + (c >> 5), rr = r & 15, cc = c & 31, ob = rr * 64 + cc * 2; return st * 1024 + (ob ^ (((ob >> 9) & 1) << 5)); }
__host__ __device__ __forceinline__ void stage_rc(int b, int& R, int& C) { const int st = b / 1024, sb = b % 1024, swz = sb ^ (((sb >> 9) & 1) << 5); R = (st >> 1) * 16 + swz / 64; C = (st & 1) * 32 + (swz % 64) / 2; }
__host__ __device__ __forceinline__ int perm32(int rho) { const int n = rho >> 4, i = rho & 15; return 8 * (i >> 2) + 4 * n + (i & 3); }

struct Unit { int pm, pn; };
struct Gemm { const bf16_t* A; const bf16_t* Bt; int M, N, K, lda; };

struct StaticOrder {
    int nM, nN, nwg, G, c;
    __host__ __device__ void init(int M, int N, int G_, int c_) { nM = M / BM; nN = N / BM; nwg = nM * nN; G = G_; c = c_; }
    __host__ __device__ bool next(int i, Unit& u) const {
        const long L = (long)i * G + c; if (L >= nwg) return false;
        int wgid = (int)L; { const int q = nwg / NXCD, r = nwg % NXCD, xcd = wgid % NXCD, off = wgid / NXCD; wgid = (xcd < r ? xcd * (q + 1) : r * (q + 1) + (xcd - r) * q) + off; }
        const int nig = WGM * nN, gid = wgid / nig, fm = gid * WGM, gsz = (nM - fm) < WGM ? (nM - fm) : WGM;
        u.pm = fm + ((wgid % nig) % gsz); u.pn = (wgid % nig) / gsz; return true;
    }
    __device__ __forceinline__ void a_ready(const Unit&) const {}
    __device__ __forceinline__ void done(const Unit&) const {}
};

__device__ __forceinline__ unsigned cvt_pk_bf16(float lo, float hi) { unsigned r; asm volatile("v_cvt_pk_bf16_f32 %0, %1, %2" : "=v"(r) : "v"(lo), "v"(hi)); return r; }
typedef float f32x2 __attribute__((ext_vector_type(2)));
template <class Epi, class Sched, bool ALIGN_EPI = false, bool SP2 = false>
__device__ __forceinline__ void gemm_phase(PG8_LAS unsigned char* lds, const Gemm g, const Sched& S, const Epi& E) {
    const int tid = threadIdx.x, wid = __builtin_amdgcn_readfirstlane(tid >> 6), lane = tid & 63, wr = wid >> 2, wc = wid & 3, fr = lane & 15, fq = lane >> 4;
    const int K = g.K, nt = K / BK;
    unsigned voffA[2], voffB[2];
#pragma unroll
    for (int i = 0; i < 2; ++i) { int R, C; stage_rc(tid * 16 + i * 8192, R, C); const int Rb = Epi::PERM ? ((R & ~31) + perm32(R & 31)) : R;
        voffA[i] = (unsigned)(R * g.lda + C) * 2u; voffB[i] = (unsigned)(Rb * K + C) * 2u; }
    const size_t kstep = (size_t)(BK * 2);
    const size_t hstepA = (size_t)HALF * g.lda * 2, hstepB = (size_t)HALF * K * 2;
    const size_t tstepA = 2 * hstepA, tstepB = 2 * hstepB;
    const unsigned ldsw = (unsigned)wid * 1024u;
    const int aoff = lds_byte(wr * 64 + fr, fq * 8), boff = lds_byte(wc * 32 + fr, fq * 8);
#define PG8_SA(b, h) (((b) * 2 + (h)) * HTB)
#define PG8_SB(b, h) ((4 + (b) * 2 + (h)) * HTB)
#define PG8_STAGE(bufoff, gbase, voff) do { _Pragma("unroll") for (int _i = 0; _i < 2; ++_i) \
        __builtin_amdgcn_global_load_lds((const unsigned*)((const char*)(gbase) + (voff)[_i]), (PG8_LAS unsigned*)(lds + (bufoff) + ldsw + _i * 8192), 16, 0, 0); } while (0)
#define PG8_LDA(dst, b, h) do { _Pragma("unroll") for (int m = 0; m < 4; ++m) _Pragma("unroll") for (int k = 0; k < 2; ++k) dst[m][k] = *(const PG8_LAS bf16x8*)(lds + PG8_SA(b, h) + aoff + m * 2048 + k * 1024); } while (0)
#define PG8_LDB(dst, b, h) do { _Pragma("unroll") for (int n = 0; n < 2; ++n) _Pragma("unroll") for (int k = 0; k < 2; ++k) dst[n][k] = *(const PG8_LAS bf16x8*)(lds + PG8_SB(b, h) + boff + n * 2048 + k * 1024); } while (0)
#define PG8_MMA(ai, bj, At, Bt) do { __builtin_amdgcn_s_setprio(1); _Pragma("unroll") for (int m = 0; m < 4; ++m) _Pragma("unroll") for (int n = 0; n < 2; ++n) _Pragma("unroll") for (int k = 0; k < 2; ++k) \
        acc[ai][bj][m][n] = __builtin_amdgcn_mfma_f32_16x16x32_bf16(Bt[n][k], At[m][k], acc[ai][bj][m][n], 0, 0, 0); __builtin_amdgcn_s_setprio(0); } while (0)
#define PG8_WAIT_V(n) asm volatile("s_waitcnt vmcnt(" #n ")" ::: "memory")
#define PG8_WAIT_L(n) asm volatile("s_waitcnt lgkmcnt(" #n ")" ::: "memory")
#define PG8_BAR __builtin_amdgcn_s_barrier()
#define PG8_SCHED __builtin_amdgcn_sched_barrier(0)
    Unit cur, nxt; int ui = 0;
    if (!S.next(0, cur)) return;
    f32x4 acc[2][2][4][2];
#pragma unroll
    for (int a = 0; a < 2; ++a)
#pragma unroll
        for (int b = 0; b < 2; ++b)
#pragma unroll
            for (int m = 0; m < 4; ++m)
#pragma unroll
                for (int n = 0; n < 2; ++n) acc[a][b][m][n] = (f32x4){0.f, 0.f, 0.f, 0.f};
    bf16x8 At[4][2], B0[2][2], B1[2][2];
    const char* cA = (const char*)g.A + (size_t)cur.pm * tstepA; const char* cB = (const char*)g.Bt + (size_t)cur.pn * tstepB;
    S.a_ready(cur);
    if constexpr (SP2) {
        PG8_STAGE(PG8_SB(0, 0), cB, voffB); PG8_STAGE(PG8_SB(0, 1), cB + hstepB, voffB); PG8_STAGE(PG8_SA(0, 0), cA, voffA); PG8_STAGE(PG8_SA(0, 1), cA + hstepA, voffA);
        if (wr == 1) PG8_BAR;
        PG8_WAIT_V(2); PG8_BAR;
        PG8_STAGE(PG8_SB(1, 0), cB + kstep, voffB); PG8_STAGE(PG8_SA(1, 0), cA + kstep, voffA); PG8_STAGE(PG8_SB(1, 1), cB + hstepB + kstep, voffB);
        PG8_WAIT_V(6); PG8_BAR;
    } else {
        PG8_STAGE(PG8_SB(0, 0), cB, voffB); PG8_STAGE(PG8_SA(0, 0), cA, voffA); PG8_STAGE(PG8_SB(0, 1), cB + hstepB, voffB); PG8_STAGE(PG8_SA(0, 1), cA + hstepA, voffA);
        if (wr == 1) PG8_BAR;
        PG8_WAIT_V(4); PG8_BAR;
        PG8_STAGE(PG8_SB(1, 0), cB + kstep, voffB); PG8_STAGE(PG8_SA(1, 0), cA + kstep, voffA); PG8_STAGE(PG8_SB(1, 1), cB + hstepB + kstep, voffB);
        PG8_WAIT_V(6); PG8_BAR;
    }
    for (;;) {
        const bool has_next = S.next(ui + 1, nxt);
        const char* nA = has_next ? (const char*)g.A + (size_t)nxt.pm * tstepA : cA; const char* nB = has_next ? (const char*)g.Bt + (size_t)nxt.pn * tstepB : cB;
        for (int t = 0; t < nt; t += 2) {
            const bool last = (t == nt - 2);
            const char* a1 = cA + (size_t)(t + 1) * kstep;
            const char* a2 = last ? nA : cA + (size_t)(t + 2) * kstep; const char* b2 = last ? nB : cB + (size_t)(t + 2) * kstep;
            const char* a3 = a2 + kstep; const char* b3 = b2 + kstep;
            if (last && has_next) S.a_ready(nxt);
            if constexpr (SP2) {
            PG8_LDB(B0, 0, 0); PG8_LDB(B1, 0, 1); PG8_SCHED; PG8_LDA(At, 0, 0); PG8_STAGE(PG8_SA(1, 1), a1 + hstepA, voffA);
            PG8_WAIT_V(8); PG8_WAIT_L(0); PG8_BAR; PG8_MMA(0, 0, At, B0); PG8_MMA(0, 1, At, B1); PG8_BAR; PG8_SCHED;
            PG8_LDA(At, 0, 1); PG8_STAGE(PG8_SB(0, 0), b2, voffB); PG8_STAGE(PG8_SB(0, 1), b2 + hstepB, voffB); PG8_STAGE(PG8_SA(0, 0), a2, voffA);
            PG8_WAIT_V(8); PG8_WAIT_L(0); PG8_BAR; PG8_MMA(1, 0, At, B0); PG8_MMA(1, 1, At, B1); PG8_BAR; PG8_SCHED;
            PG8_LDB(B0, 1, 0); PG8_LDB(B1, 1, 1); PG8_SCHED; PG8_LDA(At, 1, 0); PG8_STAGE(PG8_SA(0, 1), a2 + hstepA, voffA);
            PG8_WAIT_V(8); PG8_WAIT_L(0); PG8_BAR; PG8_MMA(0, 0, At, B0); PG8_MMA(0, 1, At, B1); PG8_BAR; PG8_SCHED;
            PG8_LDA(At, 1, 1); PG8_STAGE(PG8_SB(1, 0), b3, voffB); PG8_STAGE(PG8_SB(1, 1), b3 + hstepB, voffB); PG8_STAGE(PG8_SA(1, 0), a3, voffA);
            PG8_WAIT_V(8); PG8_WAIT_L(0); PG8_BAR; PG8_MMA(1, 0, At, B0); PG8_MMA(1, 1, At, B1); PG8_BAR; PG8_SCHED;
            } else {
            PG8_LDB(B0, 0, 0); PG8_SCHED; PG8_LDA(At, 0, 0); PG8_STAGE(PG8_SA(1, 1), a1 + hstepA, voffA);
            PG8_WAIT_L(8); PG8_BAR; PG8_WAIT_L(0); PG8_MMA(0, 0, At, B0); PG8_BAR; PG8_SCHED;
            PG8_LDB(B1, 0, 1); PG8_STAGE(PG8_SB(0, 0), b2, voffB);
            PG8_BAR; PG8_WAIT_L(0); PG8_MMA(0, 1, At, B1); PG8_BAR;
            PG8_LDA(At, 0, 1); PG8_STAGE(PG8_SA(0, 0), a2, voffA);
            PG8_BAR; PG8_WAIT_L(0); PG8_MMA(1, 0, At, B0); PG8_BAR; PG8_SCHED;
            PG8_STAGE(PG8_SB(0, 1), b2 + hstepB, voffB);
            PG8_WAIT_V(6); PG8_BAR; PG8_MMA(1, 1, At, B1); PG8_BAR;
            PG8_LDB(B0, 1, 0); PG8_SCHED; PG8_LDA(At, 1, 0); PG8_STAGE(PG8_SA(0, 1), a2 + hstepA, voffA);
            PG8_WAIT_L(8); PG8_BAR; PG8_WAIT_L(0); PG8_MMA(0, 0, At, B0); PG8_BAR; PG8_SCHED;
            PG8_LDB(B1, 1, 1); PG8_STAGE(PG8_SB(1, 0), b3, voffB);
            PG8_BAR; PG8_WAIT_L(0); PG8_MMA(0, 1, At, B1); PG8_BAR;
            PG8_LDA(At, 1, 1); PG8_STAGE(PG8_SA(1, 0), a3, voffA);
            PG8_BAR; PG8_WAIT_L(0); PG8_MMA(1, 0, At, B0); PG8_BAR; PG8_SCHED;
            PG8_STAGE(PG8_SB(1, 1), b3 + hstepB, voffB);
            PG8_WAIT_V(6); PG8_BAR; PG8_MMA(1, 1, At, B1); PG8_BAR;
            }
        }
        if constexpr (ALIGN_EPI) { if (wr == 0) PG8_BAR; }
        if constexpr (!Epi::AFTER_DRAIN) { E(acc, cur, wr, wc, fr, fq); S.done(cur); }
        if (!has_next) break;
#pragma unroll
        for (int a = 0; a < 2; ++a)
#pragma unroll
            for (int b = 0; b < 2; ++b)
#pragma unroll
                for (int m = 0; m < 4; ++m)
#pragma unroll
                    for (int n = 0; n < 2; ++n) acc[a][b][m][n] = (f32x4){0.f, 0.f, 0.f, 0.f};
        cur = nxt; cA = nA; cB = nB; ++ui;
        if constexpr (ALIGN_EPI) { if (wr == 1) PG8_BAR; }
    }
    PG8_WAIT_V(0);
    if constexpr (!ALIGN_EPI) { if (wr == 0) PG8_BAR; }
    PG8_BAR;
    if constexpr (Epi::AFTER_DRAIN) { E.fused(acc, cur, wr, wc, fr, fq, lds, wid, lane); S.done(cur); }
#undef PG8_SA
#undef PG8_SB
#undef PG8_STAGE
#undef PG8_LDA
#undef PG8_LDB
#undef PG8_MMA
#undef PG8_WAIT_V
#undef PG8_WAIT_L
#undef PG8_BAR
#undef PG8_SCHED
}
}
using pg8::bf16_t; using pg8::bf16x8; using pg8::f32x4; using pg8::u32x4; using pg8::Unit; using pg8::cvt_pk_bf16;
#define LAS __attribute__((address_space(3)))
typedef unsigned u32x2 __attribute__((ext_vector_type(2)));

constexpr int DM = 1024, BATCH = 8, SEQ = 8192, M = BATCH * SEQ, NIN = 6144, DFF = 2816, NGU = 2 * DFF, PLE = 256, ZLD = 6144;
constexpr float EPS = 1e-6f;
constexpr size_t MiB = 1u << 20;
constexpr size_t WS_WIN = 1 * MiB, WS_WA = 13 * MiB, WS_WB = 15 * MiB, WS_WO = 17 * MiB, WS_WPG = 19 * MiB, WS_WGU = 21 * MiB, WS_WDN = 32 * MiB, WS_WPIN = 38 * MiB;
constexpr size_t WS_WSB = 38 * MiB + 512 * 1024, WS_BIASP = 38 * MiB + 768 * 1024, WS_LRT = 39 * MiB;
constexpr size_t WS_PB = 40 * MiB, WS_H = 72 * MiB, WS_Z = 200 * MiB, WS_ACT = 200 * MiB, WS_F = 552 * MiB, WS_GE = 680 * MiB, WS_END = 968 * MiB;
constexpr int NWAVES = 8, NTHR = 512, LDS_BYTES = 147456;

__device__ __forceinline__ float bf_lo(unsigned w) { return __builtin_bit_cast(float, w << 16); }
__device__ __forceinline__ float bf_hi(unsigned w) { return __builtin_bit_cast(float, w & 0xffff0000u); }
__device__ __forceinline__ float bf1(unsigned short h) { return __builtin_bit_cast(float, ((unsigned)h) << 16); }
__device__ __forceinline__ unsigned short f2bf(float f) { unsigned u = __builtin_bit_cast(unsigned, f); return (unsigned short)((u + 0x7fffu + ((u >> 16) & 1u)) >> 16); }
__device__ __forceinline__ float fsigmoid(float x) { return __builtin_amdgcn_rcpf(1.0f + __builtin_amdgcn_exp2f(-1.4426950408889634f * x)); }
__device__ __forceinline__ float fgelu(float x) { const float u = x * (0.7978845608028654f + 0.035677408136300125f * x * x); return x * __builtin_amdgcn_rcpf(1.0f + __builtin_amdgcn_exp2f(-2.8853900817779268f * u)); }
__device__ __forceinline__ float wave_sum(float v) {
#pragma unroll
    for (int o = 1; o < 64; o <<= 1) v += __shfl_xor(v, o);
    return v;
}

#define EPI_LOOP_BEGIN \
    const int row0 = u.pm * 256 + wr * 64 + fr, col0 = u.pn * 256 + wc * 32 + 8 * fq; \
    _Pragma("unroll") for (int ai = 0; ai < 2; ++ai) _Pragma("unroll") for (int m = 0; m < 4; ++m) { const size_t row = (size_t)(row0 + ai * 128 + m * 16); \
    _Pragma("unroll") for (int bj = 0; bj < 2; ++bj) { const int col = col0 + bj * 128; f32x4 v0 = acc[ai][bj][m][0], v1 = acc[ai][bj][m][1];
#define EPI_LOOP_END } }
__device__ __forceinline__ u32x4 pack8(f32x4 v0, f32x4 v1) { u32x4 w; w.x = cvt_pk_bf16(v0[0], v0[1]); w.y = cvt_pk_bf16(v0[2], v0[3]); w.z = cvt_pk_bf16(v1[0], v1[1]); w.w = cvt_pk_bf16(v1[2], v1[3]); return w; }

struct EpiZ {
    static constexpr bool PERM = true, AFTER_DRAIN = false; bf16_t* Z;
    __device__ __forceinline__ void operator()(const f32x4 (&acc)[2][2][4][2], const Unit& u, int wr, int wc, int fr, int fq) const {
        const int sec = u.pn >> 2; const int mode = (sec == 2) ? 0 : (sec >= 4 ? 2 : 1);
        EPI_LOOP_BEGIN
            if (mode == 1) {
#pragma unroll
                for (int e = 0; e < 4; ++e) { v0[e] = fgelu(v0[e]); v1[e] = fgelu(v1[e]); }
            } else if (mode == 2) {
#pragma unroll
                for (int e = 0; e < 4; ++e) { v0[e] = fsigmoid(v0[e]); v1[e] = fsigmoid(v1[e]); }
            }
            *(u32x4*)(Z + row * ZLD + col) = pack8(v0, v1);
        EPI_LOOP_END
    }
};
struct EpiPlain {
    static constexpr bool PERM = true, AFTER_DRAIN = false; bf16_t* O; int ldc;
    __device__ __forceinline__ void operator()(const f32x4 (&acc)[2][2][4][2], const Unit& u, int wr, int wc, int fr, int fq) const {
        EPI_LOOP_BEGIN
            *(u32x4*)(O + row * ldc + col) = pack8(v0, v1);
        EPI_LOOP_END
    }
};
__device__ __forceinline__ void mul8(f32x4& v0, f32x4& v1, const u32x4 w) { v0[0] *= bf_lo(w.x); v0[1] *= bf_hi(w.x); v0[2] *= bf_lo(w.y); v0[3] *= bf_hi(w.y); v1[0] *= bf_lo(w.z); v1[1] *= bf_hi(w.z); v1[2] *= bf_lo(w.w); v1[3] *= bf_hi(w.w); }
__device__ __forceinline__ void add8(f32x4& v0, f32x4& v1, const u32x4 w) { v0[0] += bf_lo(w.x); v0[1] += bf_hi(w.x); v0[2] += bf_lo(w.y); v0[3] += bf_hi(w.y); v1[0] += bf_lo(w.z); v1[1] += bf_hi(w.z); v1[2] += bf_lo(w.w); v1[3] += bf_hi(w.w); }
template <bool ADD> struct EpiGate {
    static constexpr bool PERM = true, AFTER_DRAIN = false; bf16_t* O; const bf16_t* G; int ld;
    __device__ __forceinline__ void operator()(const f32x4 (&acc)[2][2][4][2], const Unit& u, int wr, int wc, int fr, int fq) const {
        const int row0 = u.pm * 256 + wr * 64 + fr, col0 = u.pn * 256 + wc * 32 + 8 * fq;
#pragma unroll
        for (int ai = 0; ai < 2; ++ai) {
            u32x4 gw[4][2], ow[4][2];
#pragma unroll
            for (int m = 0; m < 4; ++m)
#pragma unroll
                for (int bj = 0; bj < 2; ++bj) { const size_t off = (size_t)(row0 + ai * 128 + m * 16) * ld + col0 + bj * 128; gw[m][bj] = *(const u32x4*)(G + off); if (ADD) ow[m][bj] = *(const u32x4*)(O + off); }
#pragma unroll
            for (int m = 0; m < 4; ++m)
#pragma unroll
                for (int bj = 0; bj < 2; ++bj) { const size_t off = (size_t)(row0 + ai * 128 + m * 16) * ld + col0 + bj * 128; f32x4 v0 = acc[ai][bj][m][0], v1 = acc[ai][bj][m][1];
                    mul8(v0, v1, gw[m][bj]); if (ADD) add8(v0, v1, ow[m][bj]);
                    *(u32x4*)(O + off) = pack8(v0, v1); }
        }
    }
};
struct EpiSwiglu {
    static constexpr bool PERM = true, AFTER_DRAIN = false; bf16_t* O;
    __device__ __forceinline__ void operator()(const f32x4 (&acc)[2][2][4][2], const Unit& u, int wr, int wc, int fr, int fq) const {
        EPI_LOOP_BEGIN
            const int hid = u.pn * 128 + bj * 64 + wc * 16 + 4 * fq; (void)col;
            f32x4 o;
#pragma unroll
            for (int e = 0; e < 4; ++e) o[e] = v0[e] * fsigmoid(v0[e]) * v1[e];
            u32x2 w; w.x = cvt_pk_bf16(o[0], o[1]); w.y = cvt_pk_bf16(o[2], o[3]);
            *(u32x2*)(O + row * DFF + hid) = w;
        EPI_LOOP_END
    }
};
struct EpiSigMul {
    static constexpr bool PERM = true, AFTER_DRAIN = false; bf16_t* O;
    __device__ __forceinline__ void operator()(const f32x4 (&acc)[2][2][4][2], const Unit& u, int wr, int wc, int fr, int fq) const {
        const int row0 = u.pm * 256 + wr * 64 + fr, col0 = u.pn * 256 + wc * 32 + 8 * fq;
#pragma unroll
        for (int ai = 0; ai < 2; ++ai) {
            u32x4 ow[4][2];
#pragma unroll
            for (int m = 0; m < 4; ++m)
#pragma unroll
                for (int bj = 0; bj < 2; ++bj) ow[m][bj] = *(const u32x4*)(O + (size_t)(row0 + ai * 128 + m * 16) * DM + col0 + bj * 128);
#pragma unroll
            for (int m = 0; m < 4; ++m)
#pragma unroll
                for (int bj = 0; bj < 2; ++bj) { f32x4 v0 = acc[ai][bj][m][0], v1 = acc[ai][bj][m][1];
#pragma unroll
                    for (int e = 0; e < 4; ++e) { v0[e] = fsigmoid(v0[e]); v1[e] = fsigmoid(v1[e]); }
                    mul8(v0, v1, ow[m][bj]);
                    *(u32x4*)(O + (size_t)(row0 + ai * 128 + m * 16) * DM + col0 + bj * 128) = pack8(v0, v1); }
        }
    }
};

struct PanelOrder {
    int nN, pm;
    __device__ void init(int N, int pm_) { nN = N / 256; pm = pm_; }
    __device__ bool next(int i, Unit& u) const { if (i >= nN) return false; u.pm = pm; u.pn = i; return true; }
    __device__ __forceinline__ void a_ready(const Unit&) const {}
    __device__ __forceinline__ void done(const Unit&) const {}
};
template <int MODE> __device__ __forceinline__ void transpose_item(const float* W, int K, int N, bf16_t* WT, LAS float* scr, int item, int lane) {
    const int nblk = N / 32, kb = item / nblk, nb = item % nblk, k0 = 64 * kb, n0 = 32 * nb;
#pragma unroll 8
    for (int i = 0; i < 32; ++i) { const int kk = 2 * i + (lane >> 5); scr[kk * 33 + (lane & 31)] = W[(size_t)(k0 + kk) * N + n0 + (lane & 31)]; }
    asm volatile("s_waitcnt lgkmcnt(0)" ::: "memory");
    const int c = lane & 7;
#pragma unroll
    for (int j = 0; j < 4; ++j) { const int n = (lane >> 3) + 8 * j; const LAS float* s = scr + (8 * c) * 33 + n;
        u32x4 o; o.x = cvt_pk_bf16(s[0 * 33], s[1 * 33]); o.y = cvt_pk_bf16(s[2 * 33], s[3 * 33]); o.z = cvt_pk_bf16(s[4 * 33], s[5 * 33]); o.w = cvt_pk_bf16(s[6 * 33], s[7 * 33]);
        const int ng = n0 + n; const int drow = (MODE == 0) ? ng : (256 * (ng >> 7) + 8 * ((ng & 127) >> 2) + (ng & 3) + 4 * (MODE - 1));
        *(u32x4*)(WT + (size_t)drow * K + k0 + 8 * c) = o; }
    asm volatile("s_waitcnt lgkmcnt(0)" ::: "memory");
}

struct Args { const float* in[28]; float* out; unsigned char* ws; int ph_lo, ph_hi; };

__device__ __forceinline__ void prologue(const __attribute__((address_space(4))) Args* ap, LAS unsigned char* lds, int gw, int NGW, int wave, int lane) {
    Args a;
    for (int i = 0; i < 28; ++i) a.in[i] = ap->in[i];
    a.out = ap->out; a.ws = ap->ws;
    unsigned char* ws = a.ws;
    LAS float* scr = (LAS float*)(lds + wave * 16384);
    constexpr int I_IN = 16 * (NIN / 32), I_SQ = 16 * 32, I_GU = 16 * (DFF / 32), I_DN = (DFF / 64) * 32, I_PI = 4 * 32;
    constexpr int NITEMS = I_IN + 4 * I_SQ + 2 * I_GU + I_DN + I_PI;
    for (int it = gw; it < NITEMS; it += NGW) {
        int r = it;
        if (r < I_IN) { transpose_item<0>(a.in[4], DM, NIN, (bf16_t*)(ws + WS_WIN), scr, r, lane); continue; } r -= I_IN;
        if (r < I_SQ) { transpose_item<0>(a.in[16], DM, DM, (bf16_t*)(ws + WS_WA), scr, r, lane); continue; } r -= I_SQ;
        if (r < I_SQ) { transpose_item<0>(a.in[17], DM, DM, (bf16_t*)(ws + WS_WB), scr, r, lane); continue; } r -= I_SQ;
        if (r < I_SQ) { transpose_item<0>(a.in[18], DM, DM, (bf16_t*)(ws + WS_WO), scr, r, lane); continue; } r -= I_SQ;
        if (r < I_SQ) { transpose_item<0>(a.in[27], DM, DM, (bf16_t*)(ws + WS_WPG), scr, r, lane); continue; } r -= I_SQ;
        if (r < I_GU) { transpose_item<1>(a.in[21], DM, DFF, (bf16_t*)(ws + WS_WGU), scr, r, lane); continue; } r -= I_GU;
        if (r < I_GU) { transpose_item<2>(a.in[22], DM, DFF, (bf16_t*)(ws + WS_WGU), scr, r, lane); continue; } r -= I_GU;
        if (r < I_DN) { transpose_item<0>(a.in[23], DFF, DM, (bf16_t*)(ws + WS_WDN), scr, r, lane); continue; } r -= I_DN;
        transpose_item<0>(a.in[26], PLE, DM, (bf16_t*)(ws + WS_WPIN), scr, r, lane);
    }
    const int gt = gw * 64 + lane, NGT = NGW * 64;
    { const float* wsrc = a.in[7]; bf16_t* d = (bf16_t*)(ws + WS_WSB);
      for (int e = gt; e < 8 * 128 * 128; e += NGT) { const int i = (e >> 7) & 127, j = e & 127; d[e] = ((j >> 6) <= (i >> 6)) ? f2bf(wsrc[e]) : (bf16_t)0; } }
    { bf16_t* d = (bf16_t*)(ws + WS_LRT); const float* cw = a.in[9];
      for (int e = gt; e < 2 * 16 * 4 * 64 * 64; e += NGT) { const int c = e & 63, j = (e >> 6) & 63, k = (e >> 12) & 3, hd = (e >> 14) & 15, which = e >> 18;
          const float* src = which ? a.in[13] : a.in[11]; d[e] = f2bf(cw[k * DM + hd * 64 + c] * src[hd * 4096 + c * 64 + j]); } }
    { float* d = (float*)(ws + WS_BIASP); const float* cb = a.in[10];
      for (int e = gt; e < 2 * DM; e += NGT) { const int which = e >> 10, ch = e & 1023, hd = ch >> 6, j = ch & 63; const float* w = (which ? a.in[13] : a.in[11]) + hd * 4096 + j;
          float acc = (which ? a.in[14] : a.in[12])[ch];
          for (int c = 0; c < 64; ++c) acc += cb[hd * 64 + c] * w[c * 64];
          d[e] = acc; }
      for (int e = gt; e < DM; e += NGT) d[2 * DM + e] = 8.0f * 1.4426950408889634f * log1pf(expf(-a.in[15][e])); }
    { const f32x4* src = (const f32x4*)a.in[1]; u32x2* d = (u32x2*)(ws + WS_PB);
      for (int e = gt; e < M * PLE / 4; e += NGT) { const f32x4 v = src[e]; u32x2 w; w.x = cvt_pk_bf16(v[0], v[1]); w.y = cvt_pk_bf16(v[2], v[3]); d[e] = w; } }
    { const float* x = a.in[0]; const float* g = a.in[2]; bf16_t* H = (bf16_t*)(ws + WS_H);
      f32x4 nx[4];
#pragma unroll
      for (int j = 0; j < 4; ++j) nx[j] = *(const f32x4*)(x + (size_t)gw * DM + 256 * j + 4 * lane);
      for (int m = gw; m < M; m += NGW) {
          f32x4 v[4]; float ss = 0.f;
#pragma unroll
          for (int j = 0; j < 4; ++j) { v[j] = nx[j]; ss += (v[j][0] * v[j][0] + v[j][1] * v[j][1]) + (v[j][2] * v[j][2] + v[j][3] * v[j][3]); }
          if (m + NGW < M) {
#pragma unroll
              for (int j = 0; j < 4; ++j) nx[j] = *(const f32x4*)(x + (size_t)(m + NGW) * DM + 256 * j + 4 * lane); }
          const float rs = rsqrtf(wave_sum(ss) * (1.f / DM) + EPS);
#pragma unroll
          for (int j = 0; j < 4; ++j) { const f32x4 gg = *(const f32x4*)(g + 256 * j + 4 * lane); u32x2 w; w.x = cvt_pk_bf16(v[j][0] * rs * gg[0], v[j][1] * rs * gg[1]); w.y = cvt_pk_bf16(v[j][2] * rs * gg[2], v[j][3] * rs * gg[3]);
              *(u32x2*)(H + (size_t)m * DM + 256 * j + 4 * lane) = w; }
      } }
}

template <bool XIN_BF16, bool XOUT_BF16>
__device__ __forceinline__ void norm_pass(const unsigned char* xin, size_t xin_pitch, const bf16_t* y, int ldy, const float* g1, unsigned char* xo, size_t xo_pitch, const float* g2, bf16_t* hn, int wave, int lane) {
    u32x4 yq[2], xb[2]; f32x4 xf[2][2];
#define NP_LOAD(r_) do { _Pragma("unroll") for (int j = 0; j < 2; ++j) { const int c0 = 512 * j + 8 * lane; yq[j] = *(const u32x4*)(y + (size_t)(r_) * ldy + c0); \
        if (XIN_BF16) xb[j] = *(const u32x4*)(xin + (size_t)(r_) * xin_pitch + 2 * c0); \
        else { xf[j][0] = *(const f32x4*)(xin + (size_t)(r_) * xin_pitch + 4 * c0); xf[j][1] = *(const f32x4*)(xin + (size_t)(r_) * xin_pitch + 4 * c0 + 16); } } } while (0)
    NP_LOAD(wave);
    for (int r = wave; r < 256; r += NWAVES) {
        float yv[16], xv[16]; float ss = 0.f;
#pragma unroll
        for (int j = 0; j < 2; ++j) { const u32x4 w = yq[j];
            yv[8 * j + 0] = bf_lo(w.x); yv[8 * j + 1] = bf_hi(w.x); yv[8 * j + 2] = bf_lo(w.y); yv[8 * j + 3] = bf_hi(w.y); yv[8 * j + 4] = bf_lo(w.z); yv[8 * j + 5] = bf_hi(w.z); yv[8 * j + 6] = bf_lo(w.w); yv[8 * j + 7] = bf_hi(w.w);
            if (XIN_BF16) { const u32x4 a = xb[j];
                xv[8 * j + 0] = bf_lo(a.x); xv[8 * j + 1] = bf_hi(a.x); xv[8 * j + 2] = bf_lo(a.y); xv[8 * j + 3] = bf_hi(a.y); xv[8 * j + 4] = bf_lo(a.z); xv[8 * j + 5] = bf_hi(a.z); xv[8 * j + 6] = bf_lo(a.w); xv[8 * j + 7] = bf_hi(a.w);
            } else {
#pragma unroll
                for (int e = 0; e < 4; ++e) { xv[8 * j + e] = xf[j][0][e]; xv[8 * j + 4 + e] = xf[j][1][e]; } } }
        if (r + NWAVES < 256) NP_LOAD(r + NWAVES);
#pragma unroll
        for (int e = 0; e < 16; ++e) ss += yv[e] * yv[e];
        const float rs = rsqrtf(wave_sum(ss) * (1.f / DM) + EPS);
        float s2 = 0.f;
#pragma unroll
        for (int j = 0; j < 2; ++j) { const int c0 = 512 * j + 8 * lane; const f32x4 ga = *(const f32x4*)(g1 + c0), gb = *(const f32x4*)(g1 + c0 + 4);
#pragma unroll
            for (int e = 0; e < 4; ++e) { xv[8 * j + e] += yv[8 * j + e] * rs * ga[e]; xv[8 * j + 4 + e] += yv[8 * j + 4 + e] * rs * gb[e]; }
            if (XOUT_BF16) { *(u32x4*)(xo + (size_t)r * xo_pitch + 2 * c0) = pack8((f32x4){xv[8 * j], xv[8 * j + 1], xv[8 * j + 2], xv[8 * j + 3]}, (f32x4){xv[8 * j + 4], xv[8 * j + 5], xv[8 * j + 6], xv[8 * j + 7]});
#pragma unroll
                for (int e = 0; e < 8; ++e) xv[8 * j + e] = bf1(f2bf(xv[8 * j + e]));
            } else { *(f32x4*)(xo + (size_t)r * xo_pitch + 4 * c0) = (f32x4){xv[8 * j], xv[8 * j + 1], xv[8 * j + 2], xv[8 * j + 3]};
                *(f32x4*)(xo + (size_t)r * xo_pitch + 4 * c0 + 16) = (f32x4){xv[8 * j + 4], xv[8 * j + 5], xv[8 * j + 6], xv[8 * j + 7]}; } }
        if (hn) {
#pragma unroll
            for (int e = 0; e < 16; ++e) s2 += xv[e] * xv[e];
            const float r2 = rsqrtf(wave_sum(s2) * (1.f / DM) + EPS);
#pragma unroll
            for (int j = 0; j < 2; ++j) { const int c0 = 512 * j + 8 * lane; const f32x4 ga = *(const f32x4*)(g2 + c0), gb = *(const f32x4*)(g2 + c0 + 4);
                f32x4 o0, o1;
#pragma unroll
                for (int e = 0; e < 4; ++e) { o0[e] = xv[8 * j + e] * r2 * ga[e]; o1[e] = xv[8 * j + 4 + e] * r2 * gb[e]; }
                *(u32x4*)(hn + (size_t)r * DM + c0) = pack8(o0, o1); }
        }
    }
#undef NP_LOAD
}
#define LDS_BARRIER() do { asm volatile("s_waitcnt lgkmcnt(0)" ::: "memory"); __builtin_amdgcn_s_barrier(); asm volatile("" ::: "memory"); } while (0)
typedef short s16x4 __attribute__((ext_vector_type(4)));
__device__ __forceinline__ void mixerA_unit(LAS unsigned char* lds, int blk, const bf16_t* Z, bf16_t* AO, const bf16_t* WSB, const float* ln_g, const float* ln_b, const float* b_s) {
    const int tid = threadIdx.x, wave = __builtin_amdgcn_readfirstlane(tid >> 6), lane = tid & 63, fr = lane & 15, fq = lane >> 4;
    LAS float* st = (LAS float*)lds;
    LAS bf16_t* Wl = (LAS bf16_t*)(lds + 1024);
    LAS bf16_t* Vn = Wl + 128 * 136;
    const size_t row0 = (size_t)blk * 128;
    const int cc = tid & 15;
    u32x4 wq[4], vq[2][4]; f32x4 lg0, lg1, lb0, lb1; u32x2 uq[2][8]; float bsv[2][8];
#define MA_LOAD_V(g, slot) do { _Pragma("unroll") for (int it = 0; it < 4; ++it) vq[slot][it] = *(const u32x4*)(Z + (row0 + (tid >> 4) + 32 * it) * ZLD + 1024 + (g) * 128 + cc * 8); } while (0)
#define MA_LOAD_W(g) do { _Pragma("unroll") for (int it = 0; it < 4; ++it) { const int q = tid + 512 * it; wq[it] = *(const u32x4*)(WSB + (g) * 16384 + (q >> 4) * 128 + (q & 15) * 8); } \
        lg0 = *(const f32x4*)(ln_g + (g) * 128 + cc * 8); lg1 = *(const f32x4*)(ln_g + (g) * 128 + cc * 8 + 4); lb0 = *(const f32x4*)(ln_b + (g) * 128 + cc * 8); lb1 = *(const f32x4*)(ln_b + (g) * 128 + cc * 8 + 4); } while (0)
#define MA_LOAD_U(g, slot) do { _Pragma("unroll") for (int it = 0; it < 8; ++it) { uq[slot][it] = *(const u32x2*)(Z + (row0 + 16 * it + fr) * ZLD + (g) * 128 + 16 * wave + 4 * fq); bsv[slot][it] = b_s[(g) * 128 + 16 * it + fr]; } } while (0)
    MA_LOAD_V(0, 0); MA_LOAD_W(0); MA_LOAD_V(1, 1); MA_LOAD_U(0, 0);
#pragma unroll 8
    for (int rr = 0; rr < 16; ++rr) {
        const int r = 16 * wave + rr; const bf16_t* vp = Z + (row0 + r) * ZLD + 1024 + lane * 16;
        const u32x4 w0 = *(const u32x4*)vp, w1 = *(const u32x4*)(vp + 8);
        float f[16] = {bf_lo(w0.x), bf_hi(w0.x), bf_lo(w0.y), bf_hi(w0.y), bf_lo(w0.z), bf_hi(w0.z), bf_lo(w0.w), bf_hi(w0.w), bf_lo(w1.x), bf_hi(w1.x), bf_lo(w1.y), bf_hi(w1.y), bf_lo(w1.z), bf_hi(w1.z), bf_lo(w1.w), bf_hi(w1.w)};
        float s = 0.f, q = 0.f;
#pragma unroll
        for (int e = 0; e < 16; ++e) { s += f[e]; q += f[e] * f[e]; }
#pragma unroll
        for (int o = 1; o < 64; o <<= 1) { s += __shfl_xor(s, o); q += __shfl_xor(q, o); }
        const float mean = s * (1.f / 1024.f); const float var = fmaxf(q * (1.f / 1024.f) - mean * mean, 0.f);
        if (lane == 0) { st[2 * r] = mean; st[2 * r + 1] = rsqrtf(var + EPS); }
    }
    LDS_BARRIER();
    const unsigned vaddr = (unsigned)(uintptr_t)(Vn + (8 * fq + (fr >> 2)) * 136 + 16 * wave + 4 * (fr & 3));
    for (int g2 = 0; g2 < 8; g2 += 2) {
        { constexpr int SLOT = 0; const int g = g2;
#pragma unroll
        for (int it = 0; it < 4; ++it) { const int q = tid + 512 * it; *(LAS u32x4*)(Wl + (q >> 4) * 136 + (q & 15) * 8) = wq[it]; }
#pragma unroll
        for (int it = 0; it < 4; ++it) { const int j = (tid >> 4) + 32 * it; const u32x4 w = vq[SLOT][it]; const float mu = st[2 * j], rs = st[2 * j + 1];
            const f32x4 o0 = (f32x4){(bf_lo(w.x) - mu) * rs * lg0[0] + lb0[0], (bf_hi(w.x) - mu) * rs * lg0[1] + lb0[1], (bf_lo(w.y) - mu) * rs * lg0[2] + lb0[2], (bf_hi(w.y) - mu) * rs * lg0[3] + lb0[3]};
            const f32x4 o1 = (f32x4){(bf_lo(w.z) - mu) * rs * lg1[0] + lb1[0], (bf_hi(w.z) - mu) * rs * lg1[1] + lb1[1], (bf_lo(w.w) - mu) * rs * lg1[2] + lb1[2], (bf_hi(w.w) - mu) * rs * lg1[3] + lb1[3]};
            *(LAS u32x4*)(Vn + j * 136 + cc * 8) = pack8(o0, o1); }
        LDS_BARRIER();
        if (g < 7) { MA_LOAD_W(g + 1); MA_LOAD_U(g + 1, 1 - SLOT); }
        if (g < 6) MA_LOAD_V(g + 2, SLOT);
        s16x4 t00, t01, t10, t11, t20, t21, t30, t31;
        asm volatile("ds_read_b64_tr_b16 %0, %8\n\tds_read_b64_tr_b16 %1, %8 offset:1088\n\tds_read_b64_tr_b16 %2, %8 offset:8704\n\tds_read_b64_tr_b16 %3, %8 offset:9792\n\t"
                     "ds_read_b64_tr_b16 %4, %8 offset:17408\n\tds_read_b64_tr_b16 %5, %8 offset:18496\n\tds_read_b64_tr_b16 %6, %8 offset:26112\n\tds_read_b64_tr_b16 %7, %8 offset:27200\n\ts_waitcnt lgkmcnt(0)"
                     : "=&v"(t00), "=&v"(t01), "=&v"(t10), "=&v"(t11), "=&v"(t20), "=&v"(t21), "=&v"(t30), "=&v"(t31) : "v"(vaddr) : "memory");
        bf16x8 avk[4];
        avk[0] = __builtin_shufflevector(t00, t01, 0, 1, 2, 3, 4, 5, 6, 7); avk[1] = __builtin_shufflevector(t10, t11, 0, 1, 2, 3, 4, 5, 6, 7);
        avk[2] = __builtin_shufflevector(t20, t21, 0, 1, 2, 3, 4, 5, 6, 7); avk[3] = __builtin_shufflevector(t30, t31, 0, 1, 2, 3, 4, 5, 6, 7);
        f32x4 acc[8];
#pragma unroll
        for (int it = 0; it < 8; ++it) acc[it] = (f32x4){0.f, 0.f, 0.f, 0.f};
#pragma unroll
        for (int k = 0; k < 4; ++k) {
#pragma unroll
            for (int it = 0; it < 8; ++it) { if (it < 4 && k >= 2) continue;
                const bf16x8 bv = *(const LAS bf16x8*)(Wl + (16 * it + fr) * 136 + 32 * k + 8 * fq);
                acc[it] = __builtin_amdgcn_mfma_f32_16x16x32_bf16(avk[k], bv, acc[it], 0, 0, 0); } }
#pragma unroll
        for (int it = 0; it < 8; ++it) { const float bs = bsv[SLOT][it]; const u32x2 uw = uq[SLOT][it];
            u32x2 o; o.x = cvt_pk_bf16(bf_lo(uw.x) * (acc[it][0] + bs), bf_hi(uw.x) * (acc[it][1] + bs)); o.y = cvt_pk_bf16(bf_lo(uw.y) * (acc[it][2] + bs), bf_hi(uw.y) * (acc[it][3] + bs));
            *(u32x2*)(AO + (row0 + 16 * it + fr) * DM + g * 128 + 16 * wave + 4 * fq) = o; }
        LDS_BARRIER();
        }
        { constexpr int SLOT = 1; const int g = g2 + 1;
#pragma unroll
        for (int it = 0; it < 4; ++it) { const int q = tid + 512 * it; *(LAS u32x4*)(Wl + (q >> 4) * 136 + (q & 15) * 8) = wq[it]; }
#pragma unroll
        for (int it = 0; it < 4; ++it) { const int j = (tid >> 4) + 32 * it; const u32x4 w = vq[SLOT][it]; const float mu = st[2 * j], rs = st[2 * j + 1];
            const f32x4 o0 = (f32x4){(bf_lo(w.x) - mu) * rs * lg0[0] + lb0[0], (bf_hi(w.x) - mu) * rs * lg0[1] + lb0[1], (bf_lo(w.y) - mu) * rs * lg0[2] + lb0[2], (bf_hi(w.y) - mu) * rs * lg0[3] + lb0[3]};
            const f32x4 o1 = (f32x4){(bf_lo(w.z) - mu) * rs * lg1[0] + lb1[0], (bf_hi(w.z) - mu) * rs * lg1[1] + lb1[1], (bf_lo(w.w) - mu) * rs * lg1[2] + lb1[2], (bf_hi(w.w) - mu) * rs * lg1[3] + lb1[3]};
            *(LAS u32x4*)(Vn + j * 136 + cc * 8) = pack8(o0, o1); }
        LDS_BARRIER();
        if (g < 7) { MA_LOAD_W(g + 1); MA_LOAD_U(g + 1, 1 - SLOT); }
        if (g < 6) MA_LOAD_V(g + 2, SLOT);
        s16x4 t00, t01, t10, t11, t20, t21, t30, t31;
        asm volatile("ds_read_b64_tr_b16 %0, %8\n\tds_read_b64_tr_b16 %1, %8 offset:1088\n\tds_read_b64_tr_b16 %2, %8 offset:8704\n\tds_read_b64_tr_b16 %3, %8 offset:9792\n\t"
                     "ds_read_b64_tr_b16 %4, %8 offset:17408\n\tds_read_b64_tr_b16 %5, %8 offset:18496\n\tds_read_b64_tr_b16 %6, %8 offset:26112\n\tds_read_b64_tr_b16 %7, %8 offset:27200\n\ts_waitcnt lgkmcnt(0)"
                     : "=&v"(t00), "=&v"(t01), "=&v"(t10), "=&v"(t11), "=&v"(t20), "=&v"(t21), "=&v"(t30), "=&v"(t31) : "v"(vaddr) : "memory");
        bf16x8 avk[4];
        avk[0] = __builtin_shufflevector(t00, t01, 0, 1, 2, 3, 4, 5, 6, 7); avk[1] = __builtin_shufflevector(t10, t11, 0, 1, 2, 3, 4, 5, 6, 7);
        avk[2] = __builtin_shufflevector(t20, t21, 0, 1, 2, 3, 4, 5, 6, 7); avk[3] = __builtin_shufflevector(t30, t31, 0, 1, 2, 3, 4, 5, 6, 7);
        f32x4 acc[8];
#pragma unroll
        for (int it = 0; it < 8; ++it) acc[it] = (f32x4){0.f, 0.f, 0.f, 0.f};
#pragma unroll
        for (int k = 0; k < 4; ++k) {
#pragma unroll
            for (int it = 0; it < 8; ++it) { if (it < 4 && k >= 2) continue;
                const bf16x8 bv = *(const LAS bf16x8*)(Wl + (16 * it + fr) * 136 + 32 * k + 8 * fq);
                acc[it] = __builtin_amdgcn_mfma_f32_16x16x32_bf16(avk[k], bv, acc[it], 0, 0, 0); } }
#pragma unroll
        for (int it = 0; it < 8; ++it) { const float bs = bsv[SLOT][it]; const u32x2 uw = uq[SLOT][it];
            u32x2 o; o.x = cvt_pk_bf16(bf_lo(uw.x) * (acc[it][0] + bs), bf_hi(uw.x) * (acc[it][1] + bs)); o.y = cvt_pk_bf16(bf_lo(uw.y) * (acc[it][2] + bs), bf_hi(uw.y) * (acc[it][3] + bs));
            *(u32x2*)(AO + (row0 + 16 * it + fr) * DM + g * 128 + 16 * wave + 4 * fq) = o; }
        LDS_BARRIER();
        }
    }
#undef MA_LOAD_V
#undef MA_LOAD_W
#undef MA_LOAD_U
}

typedef float f32x16 __attribute__((ext_vector_type(16)));
__device__ __forceinline__ void mixerB_unit(LAS unsigned char* lds, int unit, const bf16_t* Z, bf16_t* BO, const bf16_t* LRT, const float* BIASP, const float* conv_w, const float* conv_b) {
    const int tid = threadIdx.x, wave = __builtin_amdgcn_readfirstlane(tid >> 6), lane = tid & 63, l31 = lane & 31, hh = lane >> 5;
    const int b = unit >> 5, hd = (unit >> 1) & 15, half = unit & 1, ch0 = hd * 64, jo = half * 32;
    const int tt = wave & 3, which = __builtin_amdgcn_readfirstlane((wave >> 2) & 1);
    constexpr int NT = SEQ / 128;
    LAS bf16_t* xrl = (LAS bf16_t*)lds;
    LAS float* cwl = (LAS float*)(lds + 18944);
    LAS float* axb = (LAS float*)(lds + 19968);
    LAS float* sA = (LAS float*)(lds + 93696);
    LAS float* sH = sA + 512;
    LAS float* cry = sH + 512;
    LAS bf16_t* gyl = (LAS bf16_t*)(lds + 98304);
    LAS bf16_t* ol = gyl + 4096;
    if (tid < 128) cwl[tid] = conv_w[(tid >> 5) * DM + ch0 + jo + (tid & 31)];
    else if (tid < 192) { const int wq = (tid - 128) >> 5, ch = ch0 + jo + (tid & 31); cwl[128 + (tid - 128)] = BIASP[wq * DM + ch]; cwl[192 + (tid - 128)] = wq ? conv_b[ch] : BIASP[2 * DM + ch]; }
    if (tid < 64) cry[tid] = 0.f;
    bf16x8 wf[16];
#pragma unroll
    for (int ks = 0; ks < 16; ++ks) wf[ks] = *(const bf16x8*)(LRT + ((size_t)((which * 16 + hd) * 4 + (ks >> 2)) * 64 + jo + l31) * 64 + 16 * (ks & 3) + 8 * hh);
    const LAS float* bsl = cwl + 128 + which * 32; const LAS float* c2l = cwl + 192 + which * 32;
    const int sc = tid & 31, seg = tid >> 5;
    const bf16_t* xbase = Z + ((size_t)b * SEQ + (tid >> 3)) * ZLD + 2048 + ch0 + (tid & 7) * 8;
    const bf16_t* gbase = Z + ((size_t)b * SEQ + (tid >> 2)) * ZLD + 3072 + ch0 + jo + (tid & 3) * 8;
    bf16_t* obase = BO + ((size_t)b * SEQ + (tid >> 2)) * DM + ch0 + jo + (tid & 3) * 8;
    u32x4 rq0, rq1, hq, gq;
#define MB_LOAD_RAW(tile) do { const bf16_t* xp_ = xbase + (size_t)(tile) * 128 * ZLD; rq0 = *(const u32x4*)xp_; rq1 = *(const u32x4*)(xp_ + (size_t)64 * ZLD); \
        hq = (u32x4){0u, 0u, 0u, 0u}; if (tid < 24 && (tile) > 0) hq = *(const u32x4*)(xp_ - (ptrdiff_t)3 * ZLD); } while (0)
#define MB_STORE_RAW() do { *(LAS u32x4*)(xrl + (3 + (tid >> 3)) * 72 + (tid & 7) * 8) = rq0; *(LAS u32x4*)(xrl + (67 + (tid >> 3)) * 72 + (tid & 7) * 8) = rq1; \
        if (tid < 24) *(LAS u32x4*)(xrl + (tid >> 3) * 72 + (tid & 7) * 8) = hq; } while (0)
#define MB_LOAD_GY(tile) do { gq = *(const u32x4*)(gbase + (size_t)(tile) * 128 * ZLD); } while (0)
#define MB_COMPUTE(p) do { LAS float* dst_ = axb + (p) * 9216 + which * 4608; const int t_ = 32 * tt + l31; \
        f32x16 acc_; _Pragma("unroll") for (int e_ = 0; e_ < 16; ++e_) acc_[e_] = 0.f; \
        _Pragma("unroll") for (int ks = 0; ks < 16; ++ks) { const bf16x8 xb_ = *(const LAS bf16x8*)(xrl + (t_ + (ks >> 2)) * 72 + 16 * (ks & 3) + 8 * hh); \
            acc_ = __builtin_amdgcn_mfma_f32_32x32x16_bf16(wf[ks], xb_, acc_, 0, 0, 0); } \
        if (which == 0) { \
            _Pragma("unroll") for (int i = 0; i < 4; ++i) { f32x4 o_; const f32x4 bs_ = *(const LAS f32x4*)(bsl + 8 * i + 4 * hh), c2_ = *(const LAS f32x4*)(c2l + 8 * i + 4 * hh); \
                _Pragma("unroll") for (int j = 0; j < 4; ++j) o_[j] = __builtin_amdgcn_exp2f(-c2_[j] * fsigmoid(acc_[4 * i + j] + bs_[j])); \
                *(LAS f32x4*)(dst_ + t_ * 36 + 8 * i + 4 * hh) = o_; } \
        } else { \
            _Pragma("unroll") for (int i = 0; i < 4; ++i) { f32x4 xc_ = *(const LAS f32x4*)(c2l + 8 * i + 4 * hh); const f32x4 bs_ = *(const LAS f32x4*)(bsl + 8 * i + 4 * hh); \
                _Pragma("unroll") for (int k = 0; k < 4; ++k) { const u32x2 w_ = *(const LAS u32x2*)(xrl + (t_ + k) * 72 + jo + 8 * i + 4 * hh); const f32x4 cw_ = *(const LAS f32x4*)(cwl + k * 32 + 8 * i + 4 * hh); \
                    xc_[0] += cw_[0] * bf_lo(w_.x); xc_[1] += cw_[1] * bf_hi(w_.x); xc_[2] += cw_[2] * bf_lo(w_.y); xc_[3] += cw_[3] * bf_hi(w_.y); } \
                f32x4 o_; \
                _Pragma("unroll") for (int j = 0; j < 4; ++j) o_[j] = fsigmoid(acc_[4 * i + j] + bs_[j]) * xc_[j]; \
                *(LAS f32x4*)(dst_ + t_ * 36 + 8 * i + 4 * hh) = o_; } \
        } } while (0)
    MB_LOAD_RAW(0); MB_LOAD_GY(0);
    MB_STORE_RAW();
    LDS_BARRIER();
    MB_LOAD_RAW(1);
    MB_COMPUTE(0);
    LDS_BARRIER();
    for (int tile = 0; tile < NT; ++tile) {
        if (tile + 1 < NT) MB_STORE_RAW();
        *(LAS u32x4*)(gyl + (tid >> 2) * 32 + (tid & 3) * 8) = gq;
        if (tile > 0) *(u32x4*)(obase + (size_t)(tile - 1) * 128 * DM) = *(const LAS u32x4*)(ol + (tid >> 2) * 32 + (tid & 3) * 8);
        const LAS float* al = axb + (tile & 1) * 9216; const LAS float* gi = al + 4608;
        float a8[8], g8[8]; float A = 1.f, Hh = 0.f;
#pragma unroll
        for (int s = 0; s < 8; ++s) { const float av = al[(8 * seg + s) * 36 + sc]; a8[s] = av; g8[s] = __builtin_amdgcn_sqrtf(fmaxf(1.0f - av * av, 0.f)) * gi[(8 * seg + s) * 36 + sc]; A *= av; Hh = av * Hh + g8[s]; }
        sA[seg * 32 + sc] = A; sH[seg * 32 + sc] = Hh;
        LDS_BARRIER();
        if (tile + 2 < NT) MB_LOAD_RAW(tile + 2);
        if (tile + 1 < NT) { MB_LOAD_GY(tile + 1); MB_COMPUTE((tile + 1) & 1); }
        float h = cry[(tile & 1) * 32 + sc];
#pragma unroll
        for (int s = 0; s < 15; ++s) { const float As = sA[s * 32 + sc], Hs = sH[s * 32 + sc]; h = (s < seg) ? As * h + Hs : h; }
#pragma unroll
        for (int s = 0; s < 8; ++s) { h = a8[s] * h + g8[s]; ol[(8 * seg + s) * 32 + sc] = f2bf(h * bf1(gyl[(8 * seg + s) * 32 + sc])); }
        if (seg == 15) cry[((tile + 1) & 1) * 32 + sc] = h;
        LDS_BARRIER();
    }
    *(u32x4*)(obase + (size_t)(NT - 1) * 128 * DM) = *(const LAS u32x4*)(ol + (tid >> 2) * 32 + (tid & 3) * 8);
#undef MB_LOAD_RAW
#undef MB_STORE_RAW
#undef MB_LOAD_GY
#undef MB_COMPUTE
}

__device__ __forceinline__ void grid_barrier(unsigned* bar) {
    asm volatile("s_waitcnt vmcnt(0)" ::: "memory");
    __syncthreads();
    if (threadIdx.x == 0) {
        __builtin_amdgcn_fence(__ATOMIC_RELEASE, "agent");
        const unsigned G = gridDim.x;
        const unsigned old = __hip_atomic_fetch_add(bar, 1u, __ATOMIC_RELAXED, __HIP_MEMORY_SCOPE_AGENT);
        const unsigned target = (old / G + 1u) * G;
        while (__hip_atomic_load(bar, __ATOMIC_RELAXED, __HIP_MEMORY_SCOPE_AGENT) < target) __builtin_amdgcn_s_sleep(2);
        __builtin_amdgcn_fence(__ATOMIC_ACQUIRE, "agent");
        asm volatile("s_waitcnt vmcnt(0)" ::: "memory");
    }
    __syncthreads();
}
typedef const __attribute__((address_space(4))) Args* KArgs;
__device__ __forceinline__ KArgs kargs() {
#if defined(__HIP_DEVICE_COMPILE__)
    auto p0 = __builtin_amdgcn_kernarg_segment_ptr(); KArgs p = (KArgs)p0; asm volatile("" : "+s"(p)); return p;
#else
    return nullptr;
#endif
}
constexpr int NPHASE = 12;
__global__ void __launch_bounds__(NTHR, 2) fwd_kernel(Args args) {
    extern __shared__ __attribute__((aligned(16))) unsigned char lds_raw[];
    LAS unsigned char* lds = (LAS unsigned char*)lds_raw;
    const int lo = args.ph_lo, hi = args.ph_hi;
#define IN(k) (lo <= (k) && (k) < hi)
#define SEAM(k) do { if (IN(k) && IN((k) + 1)) { if ((k) == 0) cg::this_grid().sync(); else grid_barrier((unsigned*)kargs()->ws); } } while (0)
#define PH KArgs ka = kargs(); unsigned char* ws = ka->ws; bf16_t* Z = (bf16_t*)(ws + WS_Z); bf16_t* H = (bf16_t*)(ws + WS_H); const int G = gridDim.x, bx = blockIdx.x; (void)Z; (void)H; (void)G; (void)bx;
#define WV const int lane = threadIdx.x & 63, wave = __builtin_amdgcn_readfirstlane(threadIdx.x >> 6);
    typedef pg8::StaticOrder SO;
    typedef PanelOrder PO;
    if (IN(0)) { PH WV prologue(ka, lds, bx * NWAVES + wave, G * NWAVES, wave, lane); __syncthreads(); }
    SEAM(0);
    if (IN(1)) { PH pg8::Gemm g{H, (const bf16_t*)(ws + WS_WIN), M, NIN, DM, DM}; SO S; S.init(M, NIN, G, bx); EpiZ E{Z};
        pg8::gemm_phase<EpiZ, SO, true, true>(lds, g, S, E); }
    SEAM(1);
    if (IN(2)) { PH mixerB_unit(lds, ((((bx >> 4) << 3) | (bx & 7)) << 1) | ((bx >> 3) & 1), Z, (bf16_t*)ka->out + (size_t)M * DM, (const bf16_t*)(ws + WS_LRT), (const float*)(ws + WS_BIASP), ka->in[9], ka->in[10]); }
    if (IN(3)) { PH for (int u = bx; u < M / 128; u += G) mixerA_unit(lds, u, Z, (bf16_t*)ka->out, (const bf16_t*)(ws + WS_WSB), ka->in[5], ka->in[6], ka->in[8]); }
    SEAM(3);
    if (IN(4)) { PH
        { SO S; S.init(M, DM, G, bx); pg8::Gemm g{(const bf16_t*)ka->out, (const bf16_t*)(ws + WS_WA), M, DM, DM, DM}; EpiGate<false> E{Z + 1024, Z + 4096, ZLD}; pg8::gemm_phase<EpiGate<false>, SO, true, true>(lds, g, S, E); }
        __syncthreads();
        { SO S; S.init(M, DM, G, bx); pg8::Gemm g{(const bf16_t*)ka->out + (size_t)M * DM, (const bf16_t*)(ws + WS_WB), M, DM, DM, DM}; EpiGate<true> E{Z + 1024, Z + 5120, ZLD}; pg8::gemm_phase<EpiGate<true>, SO, true, true>(lds, g, S, E); }
        __syncthreads();
    }
    SEAM(4);
    if (IN(5)) { PH PO S; S.init(DM, bx); pg8::Gemm g{Z + 1024, (const bf16_t*)(ws + WS_WO), M, DM, DM, ZLD}; EpiPlain E{Z + 2048, ZLD}; pg8::gemm_phase<EpiPlain, PO, true, true>(lds, g, S, E); __syncthreads(); }
    if (IN(6)) { PH WV norm_pass<false, true>((const unsigned char*)(ka->in[0] + (size_t)bx * 256 * DM), (size_t)DM * 4, Z + (size_t)bx * 256 * ZLD + 2048, ZLD, ka->in[3], (unsigned char*)ka->out + ((size_t)bx << 20), (size_t)DM * 2, ka->in[19], H + (size_t)bx * 256 * DM, wave, lane); }
    SEAM(6);
    if (IN(7)) { PH pg8::Gemm g{H, (const bf16_t*)(ws + WS_WGU), M, NGU, DM, DM}; SO S; S.init(M, NGU, G, bx); EpiSwiglu E{(bf16_t*)(ws + WS_ACT)};
        pg8::gemm_phase<EpiSwiglu, SO, true, true>(lds, g, S, E); }
    SEAM(7);
    if (IN(8)) { PH pg8::Gemm g{(const bf16_t*)(ws + WS_ACT), (const bf16_t*)(ws + WS_WDN), M, DM, DFF, DFF}; SO S; S.init(M, DM, G, bx); EpiPlain E{(bf16_t*)(ws + WS_F), DM};
        pg8::gemm_phase<EpiPlain, SO, true, true>(lds, g, S, E); }
    SEAM(8);
    if (IN(9)) { PH WV bf16_t* F = (bf16_t*)(ws + WS_F) + (size_t)bx * 256 * DM; norm_pass<true, true>((const unsigned char*)ka->out + ((size_t)bx << 20), (size_t)DM * 2, F, DM, ka->in[20], (unsigned char*)F, (size_t)DM * 2, ka->in[24], H + (size_t)bx * 256 * DM, wave, lane); __syncthreads(); }
    if (IN(10)) { PH
        { PO S; S.init(DM, bx); pg8::Gemm g{(const bf16_t*)(ws + WS_PB), (const bf16_t*)(ws + WS_WPIN), M, DM, PLE, PLE}; EpiPlain E{(bf16_t*)(ws + WS_GE), DM}; pg8::gemm_phase<EpiPlain, PO, true, true>(lds, g, S, E); }
        __syncthreads();
        { PO S; S.init(DM, bx); pg8::Gemm g{H, (const bf16_t*)(ws + WS_WPG), M, DM, DM, DM}; EpiSigMul E{(bf16_t*)(ws + WS_GE)}; pg8::gemm_phase<EpiSigMul, PO, true, true>(lds, g, S, E); }
        __syncthreads();
    }
    if (IN(11)) { PH WV norm_pass<true, false>((const unsigned char*)(ws + WS_F) + (size_t)bx * 256 * DM * 2, (size_t)DM * 2, (const bf16_t*)(ws + WS_GE) + (size_t)bx * 256 * DM, DM, ka->in[25], (unsigned char*)(ka->out + (size_t)bx * 256 * DM), (size_t)DM * 4, nullptr, nullptr, wave, lane); }
#undef PH
#undef WV
#undef IN
#undef SEAM
}

extern "C" void kernel_launch(void* const* d_in, const int* in_sizes, int n_in, void* d_out, int out_size, void* d_ws, size_t ws_size, hipStream_t stream) {
    static int grid = 0;
    if (grid == 0) {
        if (n_in != 28 || in_sizes[0] != M * DM || out_size != M * DM || ws_size < WS_END) { fprintf(stderr, "kernel_launch: unexpected shapes (n_in %d, in0 %d, out %d, ws %zu)\n", n_in, n_in > 0 ? in_sizes[0] : -1, out_size, ws_size); grid = -1; return; }
        int dev = 0, cus = 0, per_cu = 0;
        if (hipGetDevice(&dev) != hipSuccess || hipDeviceGetAttribute(&cus, hipDeviceAttributeMultiprocessorCount, dev) != hipSuccess) { grid = -1; return; }
        if (hipFuncSetAttribute((const void*)fwd_kernel, hipFuncAttributeMaxDynamicSharedMemorySize, LDS_BYTES) != hipSuccess) { fprintf(stderr, "kernel_launch: hipFuncSetAttribute failed\n"); grid = -1; return; }
        if (hipOccupancyMaxActiveBlocksPerMultiprocessor(&per_cu, (const void*)fwd_kernel, NTHR, LDS_BYTES) != hipSuccess || per_cu < 1) { fprintf(stderr, "kernel_launch: occupancy query says %d\n", per_cu); per_cu = 1; }
        (void)hipGetLastError();
        grid = cus * 1;
        if (grid != M / 256) { fprintf(stderr, "kernel_launch: built for a 256-CU device (one workgroup per 256-row panel); got %d CUs\n", cus); grid = -1; return; }
    }
    if (grid < 0) return;
    if (hipMemsetAsync(d_ws, 0, 256, stream) != hipSuccess) { fprintf(stderr, "kernel_launch: memset failed\n"); return; }
    Args a{};
    for (int i = 0; i < 28; ++i) a.in[i] = (const float*)d_in[i];
    a.out = (float*)d_out; a.ws = (unsigned char*)d_ws;
#if MK_ONE
    a.ph_lo = 0; a.ph_hi = NPHASE;
    void* kargs[] = {&a};
    hipError_t e = hipLaunchCooperativeKernel((const void*)fwd_kernel, dim3(grid), dim3(NTHR), kargs, LDS_BYTES, stream);
    if (e != hipSuccess) fprintf(stderr, "kernel_launch: cooperative launch failed: %s (grid %d)\n", hipGetErrorString(e), grid);
#else
    for (int k = 0; k < NPHASE; ++k) for (int rep = 0; rep < 1 + ((REP_MASK >> k) & 1); ++rep) { a.ph_lo = k; a.ph_hi = k + 1; hipLaunchKernelGGL(fwd_kernel, dim3(grid), dim3(NTHR), LDS_BYTES, stream, a); }
#endif
}
```

```cpp
#include <hip/hip_runtime.h>
#include <hip/hip_cooperative_groups.h>
#include <cstdio>
#include <cstdint>
namespace cg = cooperative_groups;
#ifndef REP_MASK
#define REP_MASK 0
#endif
#ifndef MK_ONE
#define MK_ONE 1
#endif
namespace pg8 {
#define PG8_LAS __attribute__((address_space(3)))
typedef unsigned short bf16_t;
typedef short bf16x8 __attribute__((ext_vector_type(8)));
typedef float f32x4 __attribute__((ext_vector_type(4)));
typedef unsigned u32x4 __attribute__((ext_vector_type(4)));
constexpr int BM = 256, BK = 64, HALF = 128, HTB = HALF * BK * 2  , STAGE_BYTES = 8 * HTB, NXCD = 8, WGM = 8;

__host__ __device__ __forceinline__ int lds_byte(int r, int c) { const int st = (r >> 4) * 2 + (c >> 5), rr = r & 15, cc = c & 31, ob = rr * 64 + cc * 2; return st * 1024 + (ob ^ (((ob >> 9) & 1) << 5)); }
__host__ __device__ __forceinline__ void stage_rc(int b, int& R, int& C) { const int st = b / 1024, sb = b % 1024, swz = sb ^ (((sb >> 9) & 1) << 5); R = (st >> 1) * 16 + swz / 64; C = (st & 1) * 32 + (swz % 64) / 2; }
__host__ __device__ __forceinline__ int perm32(int rho) { const int n = rho >> 4, i = rho & 15; return 8 * (i >> 2) + 4 * n + (i & 3); }

struct Unit { int pm, pn; };
struct Gemm { const bf16_t* A; const bf16_t* Bt; int M, N, K, lda; };

struct StaticOrder {
    int nM, nN, nwg, G, c;
    __host__ __device__ void init(int M, int N, int G_, int c_) { nM = M / BM; nN = N / BM; nwg = nM * nN; G = G_; c = c_; }
    __host__ __device__ bool next(int i, Unit& u) const {
        const long L = (long)i * G + c; if (L >= nwg) return false;
        int wgid = (int)L; { const int q = nwg / NXCD, r = nwg % NXCD, xcd = wgid % NXCD, off = wgid / NXCD; wgid = (xcd < r ? xcd * (q + 1) : r * (q + 1) + (xcd - r) * q) + off; }
        const int nig = WGM * nN, gid = wgid / nig, fm = gid * WGM, gsz = (nM - fm) < WGM ? (nM - fm) : WGM;
        u.pm = fm + ((wgid % nig) % gsz); u.pn = (wgid % nig) / gsz; return true;
    }
    __device__ __forceinline__ void a_ready(const Unit&) const {}
    __device__ __forceinline__ void done(const Unit&) const {}
};

__device__ __forceinline__ unsigned cvt_pk_bf16(float lo, float hi) { unsigned r; asm volatile("v_cvt_pk_bf16_f32 %0, %1, %2" : "=v"(r) : "v"(lo), "v"(hi)); return r; }
typedef float f32x2 __attribute__((ext_vector_type(2)));
template <class Epi, class Sched, bool ALIGN_EPI = false, bool SP2 = false>
__device__ __forceinline__ void gemm_phase(PG8_LAS unsigned char* lds, const Gemm g, const Sched& S, const Epi& E) {
    const int tid = threadIdx.x, wid = __builtin_amdgcn_readfirstlane(tid >> 6), lane = tid & 63, wr = wid >> 2, wc = wid & 3, fr = lane & 15, fq = lane >> 4;
    const int K = g.K, nt = K / BK;
    unsigned voffA[2], voffB[2];
#pragma unroll
    for (int i = 0; i < 2; ++i) { int R, C; stage_rc(tid * 16 + i * 8192, R, C); const int Rb = Epi::PERM ? ((R & ~31) + perm32(R & 31)) : R;
        voffA[i] = (unsigned)(R * g.lda + C) * 2u; voffB[i] = (unsigned)(Rb * K + C) * 2u; }
    const size_t kstep = (size_t)(BK * 2);
    const size_t hstepA = (size_t)HALF * g.lda * 2, hstepB = (size_t)HALF * K * 2;
    const size_t tstepA = 2 * hstepA, tstepB = 2 * hstepB;
    const unsigned ldsw = (unsigned)wid * 1024u;
    const int aoff = lds_byte(wr * 64 + fr, fq * 8), boff = lds_byte(wc * 32 + fr, fq * 8);
#define PG8_SA(b, h) (((b) * 2 + (h)) * HTB)
#define PG8_SB(b, h) ((4 + (b) * 2 + (h)) * HTB)
#define PG8_STAGE(bufoff, gbase, voff) do { _Pragma("unroll") for (int _i = 0; _i < 2; ++_i) \
        __builtin_amdgcn_global_load_lds((const unsigned*)((const char*)(gbase) + (voff)[_i]), (PG8_LAS unsigned*)(lds + (bufoff) + ldsw + _i * 8192), 16, 0, 0); } while (0)
#define PG8_LDA(dst, b, h) do { _Pragma("unroll") for (int m = 0; m < 4; ++m) _Pragma("unroll") for (int k = 0; k < 2; ++k) dst[m][k] = *(const PG8_LAS bf16x8*)(lds + PG8_SA(b, h) + aoff + m * 2048 + k * 1024); } while (0)
#define PG8_LDB(dst, b, h) do { _Pragma("unroll") for (int n = 0; n < 2; ++n) _Pragma("unroll") for (int k = 0; k < 2; ++k) dst[n][k] = *(const PG8_LAS bf16x8*)(lds + PG8_SB(b, h) + boff + n * 2048 + k * 1024); } while (0)
#define PG8_MMA(ai, bj, At, Bt) do { __builtin_amdgcn_s_setprio(1); _Pragma("unroll") for (int m = 0; m < 4; ++m) _Pragma("unroll") for (int n = 0; n < 2; ++n) _Pragma("unroll") for (int k = 0; k < 2; ++k) \
        acc[ai][bj][m][n] = __builtin_amdgcn_mfma_f32_16x16x32_bf16(Bt[n][k], At[m][k], acc[ai][bj][m][n], 0, 0, 0); __builtin_amdgcn_s_setprio(0); } while (0)
#define PG8_WAIT_V(n) asm volatile("s_waitcnt vmcnt(" #n ")" ::: "memory")
#define PG8_WAIT_L(n) asm volatile("s_waitcnt lgkmcnt(" #n ")" ::: "memory")
#define PG8_BAR __builtin_amdgcn_s_barrier()
#define PG8_SCHED __builtin_amdgcn_sched_barrier(0)
    Unit cur, nxt; int ui = 0;
    if (!S.next(0, cur)) return;
    f32x4 acc[2][2][4][2];
#pragma unroll
    for (int a = 0; a < 2; ++a)
#pragma unroll
        for (int b = 0; b < 2; ++b)
#pragma unroll
            for (int m = 0; m < 4; ++m)
#pragma unroll
                for (int n = 0; n < 2; ++n) acc[a][b][m][n] = (f32x4){0.f, 0.f, 0.f, 0.f};
    bf16x8 At[4][2], B0[2][2], B1[2][2];
    const char* cA = (const char*)g.A + (size_t)cur.pm * tstepA; const char* cB = (const char*)g.Bt + (size_t)cur.pn * tstepB;
    S.a_ready(cur);
    if constexpr (SP2) {
        PG8_STAGE(PG8_SB(0, 0), cB, voffB); PG8_STAGE(PG8_SB(0, 1), cB + hstepB, voffB); PG8_STAGE(PG8_SA(0, 0), cA, voffA); PG8_STAGE(PG8_SA(0, 1), cA + hstepA, voffA);
        if (wr == 1) PG8_BAR;
        PG8_WAIT_V(2); PG8_BAR;
        PG8_STAGE(PG8_SB(1, 0), cB + kstep, voffB); PG8_STAGE(PG8_SA(1, 0), cA + kstep, voffA); PG8_STAGE(PG8_SB(1, 1), cB + hstepB + kstep, voffB);
        PG8_WAIT_V(6); PG8_BAR;
    } else {
        PG8_STAGE(PG8_SB(0, 0), cB, voffB); PG8_STAGE(PG8_SA(0, 0), cA, voffA); PG8_STAGE(PG8_SB(0, 1), cB + hstepB, voffB); PG8_STAGE(PG8_SA(0, 1), cA + hstepA, voffA);
        if (wr == 1) PG8_BAR;
        PG8_WAIT_V(4); PG8_BAR;
        PG8_STAGE(PG8_SB(1, 0), cB + kstep, voffB); PG8_STAGE(PG8_SA(1, 0), cA + kstep, voffA); PG8_STAGE(PG8_SB(1, 1), cB + hstepB + kstep, voffB);
        PG8_WAIT_V(6); PG8_BAR;
    }
    for (;;) {
        const bool has_next = S.next(ui + 1, nxt);
        const char* nA = has_next ? (const char*)g.A + (size_t)nxt.pm * tstepA : cA; const char* nB = has_next ? (const char*)g.Bt + (size_t)nxt.pn * tstepB : cB;
        for (int t = 0; t < nt; t += 2) {
            const bool last = (t == nt - 2);
            const char* a1 = cA + (size_t)(t + 1) * kstep;
            const char* a2 = last ? nA : cA + (size_t)(t + 2) * kstep; const char* b2 = last ? nB : cB + (size_t)(t + 2) * kstep;
            const char* a3 = a2 + kstep; const char* b3 = b2 + kstep;
            if (last && has_next) S.a_ready(nxt);
            if constexpr (SP2) {
            PG8_LDB(B0, 0, 0); PG8_LDB(B1, 0, 1); PG8_SCHED; PG8_LDA(At, 0, 0); PG8_STAGE(PG8_SA(1, 1), a1 + hstepA, voffA);
            PG8_WAIT_V(8); PG8_WAIT_L(0); PG8_BAR; PG8_MMA(0, 0, At, B0); PG8_MMA(0, 1, At, B1); PG8_BAR; PG8_SCHED;
            PG8_LDA(At, 0, 1); PG8_STAGE(PG8_SB(0, 0), b2, voffB); PG8_STAGE(PG8_SB(0, 1), b2 + hstepB, voffB); PG8_STAGE(PG8_SA(0, 0), a2, voffA);
            PG8_WAIT_V(8); PG8_WAIT_L(0); PG8_BAR; PG8_MMA(1, 0, At, B0); PG8_MMA(1, 1, At, B1); PG8_BAR; PG8_SCHED;
            PG8_LDB(B0, 1, 0); PG8_LDB(B1, 1, 1); PG8_SCHED; PG8_LDA(At, 1, 0); PG8_STAGE(PG8_SA(0, 1), a2 + hstepA, voffA);
            PG8_WAIT_V(8); PG8_WAIT_L(0); PG8_BAR; PG8_MMA(0, 0, At, B0); PG8_MMA(0, 1, At, B1); PG8_BAR; PG8_SCHED;
            PG8_LDA(At, 1, 1); PG8_STAGE(PG8_SB(1, 0), b3, voffB); PG8_STAGE(PG8_SB(1, 1), b3 + hstepB, voffB); PG8_STAGE(PG8_SA(1, 0), a3, voffA);
            PG8_WAIT_V(8); PG8_WAIT_L(0); PG8_BAR; PG8_MMA(1, 0, At, B0); PG8_MMA(1, 1, At, B1); PG8_BAR; PG8_SCHED;
            } else {
            PG8_LDB(B0, 0, 0); PG8_SCHED; PG8_LDA(At, 0, 0); PG8_STAGE(PG8_SA(1, 1), a1 + hstepA, voffA);
            PG8_WAIT_L(8); PG8_BAR; PG8_WAIT_L(0); PG8_MMA(0, 0, At, B0); PG8_BAR; PG8_SCHED;
            PG8_LDB(B1, 0, 1); PG8_STAGE(PG8_SB(0, 0), b2, voffB);
            PG8_BAR; PG8_WAIT_L(0); PG8_MMA(0, 1, At, B1); PG8_BAR;
            PG8_LDA(At, 0, 1); PG8_STAGE(PG8_SA(0, 0), a2, voffA);
            PG8_BAR; PG8_WAIT_L(0); PG8_MMA(1, 0, At, B0); PG8_BAR; PG8_SCHED;
            PG8_STAGE(PG8_SB(0, 1), b2 + hstepB, voffB);
            PG8_WAIT_V(6); PG8_BAR; PG8_MMA(1, 1, At, B1); PG8_BAR;
            PG8_LDB(B0, 1, 0); PG8_SCHED; PG8_LDA(At, 1, 0); PG8_STAGE(PG8_SA(0, 1), a2 + hstepA, voffA);
            PG8_WAIT_L(8); PG8_BAR; PG8_WAIT_L(0); PG8_MMA(0, 0, At, B0); PG8_BAR; PG8_SCHED;
            PG8_LDB(B1, 1, 1); PG8_STAGE(PG8_SB(1, 0), b3, voffB);
            PG8_BAR; PG8_WAIT_L(0); PG8_MMA(0, 1, At, B1); PG8_BAR;
            PG8_LDA(At, 1, 1); PG8_STAGE(PG8_SA(1, 0), a3, voffA);
            PG8_BAR; PG8_WAIT_L(0); PG8_MMA(1, 0, At, B0); PG8_BAR; PG8_SCHED;
            PG8_STAGE(PG8_SB(1, 1), b3 + hstepB, voffB);
            PG8_WAIT_V(6); PG8_BAR; PG8_MMA(1, 1, At, B1); PG8_BAR;
            }
        }
        if constexpr (ALIGN_EPI) { if (wr == 0) PG8_BAR; }
        if constexpr (!Epi::AFTER_DRAIN) { E(acc, cur, wr, wc, fr, fq); S.done(cur); }
        if (!has_next) break;
#pragma unroll
        for (int a = 0; a < 2; ++a)
#pragma unroll
            for (int b = 0; b < 2; ++b)
#pragma unroll
                for (int m = 0; m < 4; ++m)
#pragma unroll
                    for (int n = 0; n < 2; ++n) acc[a][b][m][n] = (f32x4){0.f, 0.f, 0.f, 0.f};
        cur = nxt; cA = nA; cB = nB; ++ui;
        if constexpr (ALIGN_EPI) { if (wr == 1) PG8_BAR; }
    }
    PG8_WAIT_V(0);
    if constexpr (!ALIGN_EPI) { if (wr == 0) PG8_BAR; }
    PG8_BAR;
    if constexpr (Epi::AFTER_DRAIN) { E.fused(acc, cur, wr, wc, fr, fq, lds, wid, lane); S.done(cur); }
#undef PG8_SA
#undef PG8_SB
#undef PG8_STAGE
#undef PG8_LDA
#undef PG8_LDB
#undef PG8_MMA
#undef PG8_WAIT_V
#undef PG8_WAIT_L
#undef PG8_BAR
#undef PG8_SCHED
}
}
using pg8::bf16_t; using pg8::bf16x8; using pg8::f32x4; using pg8::u32x4; using pg8::Unit; using pg8::cvt_pk_bf16;
#define LAS __attribute__((address_space(3)))
typedef unsigned u32x2 __attribute__((ext_vector_type(2)));

constexpr int DM = 1024, BATCH = 8, SEQ = 8192, M = BATCH * SEQ, NIN = 6144, DFF = 2816, NGU = 2 * DFF, PLE = 256, ZLD = 1024;
constexpr size_t ZSEC = (size_t)M * 1024;
constexpr float EPS = 1e-6f;
constexpr size_t MiB = 1u << 20;
constexpr size_t WS_WIN = 1 * MiB, WS_WA = 13 * MiB, WS_WB = 15 * MiB, WS_WO = 17 * MiB, WS_WPG = 19 * MiB, WS_WGU = 21 * MiB, WS_WDN = 32 * MiB, WS_WPIN = 38 * MiB;
constexpr size_t WS_WSB = 38 * MiB + 512 * 1024, WS_BIASP = 38 * MiB + 768 * 1024, WS_LRT = 39 * MiB;
constexpr size_t WS_PB = 40 * MiB, WS_H = 72 * MiB, WS_Z = 200 * MiB, WS_ACT = 200 * MiB, WS_F = 552 * MiB, WS_GE = 680 * MiB, WS_END = 968 * MiB;
constexpr int NWAVES = 8, NTHR = 512, LDS_BYTES = 147456;

__device__ __forceinline__ float bf_lo(unsigned w) { return __builtin_bit_cast(float, w << 16); }
__device__ __forceinline__ float bf_hi(unsigned w) { return __builtin_bit_cast(float, w & 0xffff0000u); }
__device__ __forceinline__ float bf1(unsigned short h) { return __builtin_bit_cast(float, ((unsigned)h) << 16); }
__device__ __forceinline__ unsigned short f2bf(float f) { unsigned u = __builtin_bit_cast(unsigned, f); return (unsigned short)((u + 0x7fffu + ((u >> 16) & 1u)) >> 16); }
__device__ __forceinline__ float fsigmoid(float x) { return __builtin_amdgcn_rcpf(1.0f + __builtin_amdgcn_exp2f(-1.4426950408889634f * x)); }
__device__ __forceinline__ float fgelu(float x) { const float u = x * (0.7978845608028654f + 0.035677408136300125f * x * x); return x * __builtin_amdgcn_rcpf(1.0f + __builtin_amdgcn_exp2f(-2.8853900817779268f * u)); }
__device__ __forceinline__ float wave_sum(float v) {
#pragma unroll
    for (int o = 1; o < 64; o <<= 1) v += __shfl_xor(v, o);
    return v;
}

#define EPI_LOOP_BEGIN \
    const int row0 = u.pm * 256 + wr * 64 + fr, col0 = u.pn * 256 + wc * 32 + 8 * fq; \
    _Pragma("unroll") for (int ai = 0; ai < 2; ++ai) _Pragma("unroll") for (int m = 0; m < 4; ++m) { const size_t row = (size_t)(row0 + ai * 128 + m * 16); \
    _Pragma("unroll") for (int bj = 0; bj < 2; ++bj) { const int col = col0 + bj * 128; f32x4 v0 = acc[ai][bj][m][0], v1 = acc[ai][bj][m][1];
#define EPI_LOOP_END } }
__device__ __forceinline__ u32x4 pack8(f32x4 v0, f32x4 v1) { u32x4 w; w.x = cvt_pk_bf16(v0[0], v0[1]); w.y = cvt_pk_bf16(v0[2], v0[3]); w.z = cvt_pk_bf16(v1[0], v1[1]); w.w = cvt_pk_bf16(v1[2], v1[3]); return w; }

struct EpiZ {
    static constexpr bool PERM = true, AFTER_DRAIN = false; bf16_t* Z;
    __device__ __forceinline__ void operator()(const f32x4 (&acc)[2][2][4][2], const Unit& u, int wr, int wc, int fr, int fq) const {
        const int sec = u.pn >> 2; const int mode = (sec == 2) ? 0 : (sec >= 4 ? 2 : 1); bf16_t* Zs = Z + (size_t)sec * ZSEC;
        EPI_LOOP_BEGIN
            if (mode == 1) {
#pragma unroll
                for (int e = 0; e < 4; ++e) { v0[e] = fgelu(v0[e]); v1[e] = fgelu(v1[e]); }
            } else if (mode == 2) {
#pragma unroll
                for (int e = 0; e < 4; ++e) { v0[e] = fsigmoid(v0[e]); v1[e] = fsigmoid(v1[e]); }
            }
            *(u32x4*)(Zs + row * ZLD + (col & 1023)) = pack8(v0, v1);
        EPI_LOOP_END
    }
};
struct EpiPlain {
    static constexpr bool PERM = true, AFTER_DRAIN = false; bf16_t* O; int ldc;
    __device__ __forceinline__ void operator()(const f32x4 (&acc)[2][2][4][2], const Unit& u, int wr, int wc, int fr, int fq) const {
        EPI_LOOP_BEGIN
            *(u32x4*)(O + row * ldc + col) = pack8(v0, v1);
        EPI_LOOP_END
    }
};
__device__ __forceinline__ void mul8(f32x4& v0, f32x4& v1, const u32x4 w) { v0[0] *= bf_lo(w.x); v0[1] *= bf_hi(w.x); v0[2] *= bf_lo(w.y); v0[3] *= bf_hi(w.y); v1[0] *= bf_lo(w.z); v1[1] *= bf_hi(w.z); v1[2] *= bf_lo(w.w); v1[3] *= bf_hi(w.w); }
__device__ __forceinline__ void add8(f32x4& v0, f32x4& v1, const u32x4 w) { v0[0] += bf_lo(w.x); v0[1] += bf_hi(w.x); v0[2] += bf_lo(w.y); v0[3] += bf_hi(w.y); v1[0] += bf_lo(w.z); v1[1] += bf_hi(w.z); v1[2] += bf_lo(w.w); v1[3] += bf_hi(w.w); }
template <bool ADD> struct EpiGate {
    static constexpr bool PERM = true, AFTER_DRAIN = false; bf16_t* O; const bf16_t* G; int ld;
    __device__ __forceinline__ void operator()(const f32x4 (&acc)[2][2][4][2], const Unit& u, int wr, int wc, int fr, int fq) const {
        const int row0 = u.pm * 256 + wr * 64 + fr, col0 = u.pn * 256 + wc * 32 + 8 * fq;
#pragma unroll
        for (int ai = 0; ai < 2; ++ai) {
            u32x4 gw[4][2], ow[4][2];
#pragma unroll
            for (int m = 0; m < 4; ++m)
#pragma unroll
                for (int bj = 0; bj < 2; ++bj) { const size_t off = (size_t)(row0 + ai * 128 + m * 16) * ld + col0 + bj * 128; gw[m][bj] = *(const u32x4*)(G + off); if (ADD) ow[m][bj] = *(const u32x4*)(O + off); }
#pragma unroll
            for (int m = 0; m < 4; ++m)
#pragma unroll
                for (int bj = 0; bj < 2; ++bj) { const size_t off = (size_t)(row0 + ai * 128 + m * 16) * ld + col0 + bj * 128; f32x4 v0 = acc[ai][bj][m][0], v1 = acc[ai][bj][m][1];
                    mul8(v0, v1, gw[m][bj]); if (ADD) add8(v0, v1, ow[m][bj]);
                    *(u32x4*)(O + off) = pack8(v0, v1); }
        }
    }
};
struct EpiSwiglu {
    static constexpr bool PERM = true, AFTER_DRAIN = false; bf16_t* O;
    __device__ __forceinline__ void operator()(const f32x4 (&acc)[2][2][4][2], const Unit& u, int wr, int wc, int fr, int fq) const {
        EPI_LOOP_BEGIN
            const int hid = u.pn * 128 + bj * 64 + wc * 16 + 4 * fq; (void)col;
            f32x4 o;
#pragma unroll
            for (int e = 0; e < 4; ++e) o[e] = v0[e] * fsigmoid(v0[e]) * v1[e];
            u32x2 w; w.x = cvt_pk_bf16(o[0], o[1]); w.y = cvt_pk_bf16(o[2], o[3]);
            *(u32x2*)(O + row * DFF + hid) = w;
        EPI_LOOP_END
    }
};
struct EpiSigMul {
    static constexpr bool PERM = true, AFTER_DRAIN = false; bf16_t* O;
    __device__ __forceinline__ void operator()(const f32x4 (&acc)[2][2][4][2], const Unit& u, int wr, int wc, int fr, int fq) const {
        const int row0 = u.pm * 256 + wr * 64 + fr, col0 = u.pn * 256 + wc * 32 + 8 * fq;
#pragma unroll
        for (int ai = 0; ai < 2; ++ai) {
            u32x4 ow[4][2];
#pragma unroll
            for (int m = 0; m < 4; ++m)
#pragma unroll
                for (int bj = 0; bj < 2; ++bj) ow[m][bj] = *(const u32x4*)(O + (size_t)(row0 + ai * 128 + m * 16) * DM + col0 + bj * 128);
#pragma unroll
            for (int m = 0; m < 4; ++m)
#pragma unroll
                for (int bj = 0; bj < 2; ++bj) { f32x4 v0 = acc[ai][bj][m][0], v1 = acc[ai][bj][m][1];
#pragma unroll
                    for (int e = 0; e < 4; ++e) { v0[e] = fsigmoid(v0[e]); v1[e] = fsigmoid(v1[e]); }
                    mul8(v0, v1, ow[m][bj]);
                    *(u32x4*)(O + (size_t)(row0 + ai * 128 + m * 16) * DM + col0 + bj * 128) = pack8(v0, v1); }
        }
    }
};

struct PanelOrder {
    int nN, pm;
    __device__ void init(int N, int pm_) { nN = N / 256; pm = pm_; }
    __device__ bool next(int i, Unit& u) const { if (i >= nN) return false; u.pm = pm; u.pn = i; return true; }
    __device__ __forceinline__ void a_ready(const Unit&) const {}
    __device__ __forceinline__ void done(const Unit&) const {}
};
template <int MODE> __device__ __forceinline__ void transpose_item(const float* W, int K, int N, bf16_t* WT, LAS float* scr, int item, int lane) {
    const int nblk = N / 32, kb = item / nblk, nb = item % nblk, k0 = 64 * kb, n0 = 32 * nb;
    float tv[32];
#pragma unroll
    for (int i = 0; i < 32; ++i) tv[i] = W[(size_t)(k0 + 2 * i + (lane >> 5)) * N + n0 + (lane & 31)];
#pragma unroll
    for (int i = 0; i < 32; ++i) scr[(2 * i + (lane >> 5)) * 33 + (lane & 31)] = tv[i];
    asm volatile("s_waitcnt lgkmcnt(0)" ::: "memory");
    const int c = lane & 7;
#pragma unroll
    for (int j = 0; j < 4; ++j) { const int n = (lane >> 3) + 8 * j; const LAS float* s = scr + (8 * c) * 33 + n;
        u32x4 o; o.x = cvt_pk_bf16(s[0 * 33], s[1 * 33]); o.y = cvt_pk_bf16(s[2 * 33], s[3 * 33]); o.z = cvt_pk_bf16(s[4 * 33], s[5 * 33]); o.w = cvt_pk_bf16(s[6 * 33], s[7 * 33]);
        const int ng = n0 + n; const int drow = (MODE == 0) ? ng : (256 * (ng >> 7) + 8 * ((ng & 127) >> 2) + (ng & 3) + 4 * (MODE - 1));
        *(u32x4*)(WT + (size_t)drow * K + k0 + 8 * c) = o; }
    asm volatile("s_waitcnt lgkmcnt(0)" ::: "memory");
}

struct Args { const float* in[28]; float* out; unsigned char* ws; int ph_lo, ph_hi; };

__device__ __forceinline__ void prologue(const __attribute__((address_space(4))) Args* ap, LAS unsigned char* lds, int gw, int NGW, int wave, int lane) {
    Args a;
    for (int i = 0; i < 28; ++i) a.in[i] = ap->in[i];
    a.out = ap->out; a.ws = ap->ws;
    unsigned char* ws = a.ws;
    LAS float* scr = (LAS float*)(lds + wave * 16384);
    constexpr int I_IN = 16 * (NIN / 32), I_SQ = 16 * 32, I_GU = 16 * (DFF / 32), I_DN = (DFF / 64) * 32, I_PI = 4 * 32;
    constexpr int NITEMS = I_IN + 4 * I_SQ + 2 * I_GU + I_DN + I_PI;
    for (int it = gw; it < NITEMS; it += NGW) {
        int r = it;
        if (r < I_IN) { transpose_item<0>(a.in[4], DM, NIN, (bf16_t*)(ws + WS_WIN), scr, r, lane); continue; } r -= I_IN;
        if (r < I_SQ) { transpose_item<0>(a.in[16], DM, DM, (bf16_t*)(ws + WS_WA), scr, r, lane); continue; } r -= I_SQ;
        if (r < I_SQ) { transpose_item<0>(a.in[17], DM, DM, (bf16_t*)(ws + WS_WB), scr, r, lane); continue; } r -= I_SQ;
        if (r < I_SQ) { transpose_item<0>(a.in[18], DM, DM, (bf16_t*)(ws + WS_WO), scr, r, lane); continue; } r -= I_SQ;
        if (r < I_SQ) { transpose_item<0>(a.in[27], DM, DM, (bf16_t*)(ws + WS_WPG), scr, r, lane); continue; } r -= I_SQ;
        if (r < I_GU) { transpose_item<1>(a.in[21], DM, DFF, (bf16_t*)(ws + WS_WGU), scr, r, lane); continue; } r -= I_GU;
        if (r < I_GU) { transpose_item<2>(a.in[22], DM, DFF, (bf16_t*)(ws + WS_WGU), scr, r, lane); continue; } r -= I_GU;
        if (r < I_DN) { transpose_item<0>(a.in[23], DFF, DM, (bf16_t*)(ws + WS_WDN), scr, r, lane); continue; } r -= I_DN;
        transpose_item<0>(a.in[26], PLE, DM, (bf16_t*)(ws + WS_WPIN), scr, r, lane);
    }
    const int gt = gw * 64 + lane, NGT = NGW * 64;
    { const float* wsrc = a.in[7]; bf16_t* d = (bf16_t*)(ws + WS_WSB);
      for (int e = gt; e < 8 * 128 * 128; e += NGT) { const int i = (e >> 7) & 127, j = e & 127; d[e] = ((j >> 6) <= (i >> 6)) ? f2bf(wsrc[e]) : (bf16_t)0; } }
    { bf16_t* d = (bf16_t*)(ws + WS_LRT); const float* cw = a.in[9];
      for (int e = gt; e < 2 * 16 * 4 * 64 * 64; e += NGT) { const int c = e & 63, j = (e >> 6) & 63, k = (e >> 12) & 3, hd = (e >> 14) & 15, which = e >> 18;
          const float* src = which ? a.in[13] : a.in[11]; d[e] = f2bf(cw[k * DM + hd * 64 + c] * src[hd * 4096 + c * 64 + j]); } }
    { float* d = (float*)(ws + WS_BIASP); const float* cb = a.in[10];
      for (int e = gw; e < 2 * DM; e += NGW) { const int which = e >> 10, ch = e & 1023, hd = ch >> 6, j = ch & 63; const float* w = (which ? a.in[13] : a.in[11]) + hd * 4096 + j;
          const float part = wave_sum(cb[hd * 64 + lane] * w[lane * 64]);
          if (lane == 0) d[e] = (which ? a.in[14] : a.in[12])[ch] + part; }
      for (int e = gt; e < DM; e += NGT) d[2 * DM + e] = 8.0f * 1.4426950408889634f * log1pf(expf(-a.in[15][e])); }
    { const f32x4* src = (const f32x4*)a.in[1]; u32x2* d = (u32x2*)(ws + WS_PB);
      for (int e = gt; e < M * PLE / 4; e += 4 * NGT) { f32x4 v[4];
#pragma unroll
          for (int i = 0; i < 4; ++i) v[i] = src[e + i * NGT < M * PLE / 4 ? e + i * NGT : e];
#pragma unroll
          for (int i = 0; i < 4; ++i) if (e + i * NGT < M * PLE / 4) { u32x2 w; w.x = cvt_pk_bf16(v[i][0], v[i][1]); w.y = cvt_pk_bf16(v[i][2], v[i][3]); d[e + i * NGT] = w; } } }
    { const float* x = a.in[0]; const float* g = a.in[2]; bf16_t* H = (bf16_t*)(ws + WS_H);
      f32x4 nx[4], gq[4];
#pragma unroll
      for (int j = 0; j < 4; ++j) { gq[j] = *(const f32x4*)(g + 256 * j + 4 * lane); nx[j] = *(const f32x4*)(x + (size_t)gw * DM + 256 * j + 4 * lane); }
      for (int m = gw; m < M; m += NGW) {
          f32x4 v[4]; float ss = 0.f;
#pragma unroll
          for (int j = 0; j < 4; ++j) { v[j] = nx[j]; ss += (v[j][0] * v[j][0] + v[j][1] * v[j][1]) + (v[j][2] * v[j][2] + v[j][3] * v[j][3]); }
          { const int mn = m + NGW < M ? m + NGW : m;
#pragma unroll
              for (int j = 0; j < 4; ++j) nx[j] = *(const f32x4*)(x + (size_t)mn * DM + 256 * j + 4 * lane); }
          const float rs = rsqrtf(wave_sum(ss) * (1.f / DM) + EPS);
#pragma unroll
          for (int j = 0; j < 4; ++j) { const f32x4 gg = gq[j]; u32x2 w; w.x = cvt_pk_bf16(v[j][0] * rs * gg[0], v[j][1] * rs * gg[1]); w.y = cvt_pk_bf16(v[j][2] * rs * gg[2], v[j][3] * rs * gg[3]);
              *(u32x2*)(H + (size_t)m * DM + 256 * j + 4 * lane) = w; }
      } }
}

template <bool XIN_BF16, bool XOUT_BF16>
__device__ __forceinline__ void norm_pass(const unsigned char* xin, size_t xin_pitch, const bf16_t* y, int ldy, const float* g1, unsigned char* xo, size_t xo_pitch, const float* g2, bf16_t* hn, int wave, int lane) {
    u32x4 yq[2], xb[2]; f32x4 xf[2][2];
    f32x4 G1[2][2], G2[2][2];
#pragma unroll
    for (int j = 0; j < 2; ++j) { const int c0 = 512 * j + 8 * lane; G1[j][0] = *(const f32x4*)(g1 + c0); G1[j][1] = *(const f32x4*)(g1 + c0 + 4);
        if (g2) { G2[j][0] = *(const f32x4*)(g2 + c0); G2[j][1] = *(const f32x4*)(g2 + c0 + 4); } else { G2[j][0] = G1[j][0]; G2[j][1] = G1[j][1]; } }
#define NP_LOAD(r_) do { _Pragma("unroll") for (int j = 0; j < 2; ++j) { const int c0 = 512 * j + 8 * lane; yq[j] = *(const u32x4*)(y + (size_t)(r_) * ldy + c0); \
        if (XIN_BF16) xb[j] = *(const u32x4*)(xin + (size_t)(r_) * xin_pitch + 2 * c0); \
        else { xf[j][0] = *(const f32x4*)(xin + (size_t)(r_) * xin_pitch + 4 * c0); xf[j][1] = *(const f32x4*)(xin + (size_t)(r_) * xin_pitch + 4 * c0 + 16); } } } while (0)
    NP_LOAD(wave);
    for (int r = wave; r < 256; r += NWAVES) {
        float yv[16], xv[16]; float ss = 0.f;
#pragma unroll
        for (int j = 0; j < 2; ++j) { const u32x4 w = yq[j];
            yv[8 * j + 0] = bf_lo(w.x); yv[8 * j + 1] = bf_hi(w.x); yv[8 * j + 2] = bf_lo(w.y); yv[8 * j + 3] = bf_hi(w.y); yv[8 * j + 4] = bf_lo(w.z); yv[8 * j + 5] = bf_hi(w.z); yv[8 * j + 6] = bf_lo(w.w); yv[8 * j + 7] = bf_hi(w.w);
            if (XIN_BF16) { const u32x4 a = xb[j];
                xv[8 * j + 0] = bf_lo(a.x); xv[8 * j + 1] = bf_hi(a.x); xv[8 * j + 2] = bf_lo(a.y); xv[8 * j + 3] = bf_hi(a.y); xv[8 * j + 4] = bf_lo(a.z); xv[8 * j + 5] = bf_hi(a.z); xv[8 * j + 6] = bf_lo(a.w); xv[8 * j + 7] = bf_hi(a.w);
            } else {
#pragma unroll
                for (int e = 0; e < 4; ++e) { xv[8 * j + e] = xf[j][0][e]; xv[8 * j + 4 + e] = xf[j][1][e]; } } }
        NP_LOAD(r + NWAVES < 256 ? r + NWAVES : r);
#pragma unroll
        for (int e = 0; e < 16; ++e) ss += yv[e] * yv[e];
        const float rs = rsqrtf(wave_sum(ss) * (1.f / DM) + EPS);
        float s2 = 0.f;
#pragma unroll
        for (int j = 0; j < 2; ++j) { const int c0 = 512 * j + 8 * lane; const f32x4 ga = G1[j][0], gb = G1[j][1];
#pragma unroll
            for (int e = 0; e < 4; ++e) { xv[8 * j + e] += yv[8 * j + e] * rs * ga[e]; xv[8 * j + 4 + e] += yv[8 * j + 4 + e] * rs * gb[e]; }
            if (XOUT_BF16) { *(u32x4*)(xo + (size_t)r * xo_pitch + 2 * c0) = pack8((f32x4){xv[8 * j], xv[8 * j + 1], xv[8 * j + 2], xv[8 * j + 3]}, (f32x4){xv[8 * j + 4], xv[8 * j + 5], xv[8 * j + 6], xv[8 * j + 7]});
#pragma unroll
                for (int e = 0; e < 8; ++e) xv[8 * j + e] = bf1(f2bf(xv[8 * j + e]));
            } else { *(f32x4*)(xo + (size_t)r * xo_pitch + 4 * c0) = (f32x4){xv[8 * j], xv[8 * j + 1], xv[8 * j + 2], xv[8 * j + 3]};
                *(f32x4*)(xo + (size_t)r * xo_pitch + 4 * c0 + 16) = (f32x4){xv[8 * j + 4], xv[8 * j + 5], xv[8 * j + 6], xv[8 * j + 7]}; } }
        if (hn) {
#pragma unroll
            for (int e = 0; e < 16; ++e) s2 += xv[e] * xv[e];
            const float r2 = rsqrtf(wave_sum(s2) * (1.f / DM) + EPS);
#pragma unroll
            for (int j = 0; j < 2; ++j) { const int c0 = 512 * j + 8 * lane; const f32x4 ga = G2[j][0], gb = G2[j][1];
                f32x4 o0, o1;
#pragma unroll
                for (int e = 0; e < 4; ++e) { o0[e] = xv[8 * j + e] * r2 * ga[e]; o1[e] = xv[8 * j + 4 + e] * r2 * gb[e]; }
                *(u32x4*)(hn + (size_t)r * DM + c0) = pack8(o0, o1); }
        }
    }
#undef NP_LOAD
}
#define LDS_BARRIER() do { asm volatile("s_waitcnt lgkmcnt(0)" ::: "memory"); __builtin_amdgcn_s_barrier(); asm volatile("" ::: "memory"); } while (0)
typedef short s16x4 __attribute__((ext_vector_type(4)));
__device__ __forceinline__ void mixerA_unit(LAS unsigned char* lds, int blk, const bf16_t* Z, bf16_t* AO, const bf16_t* WSB, const float* ln_g, const float* ln_b, const float* b_s) {
    const int tid = threadIdx.x, wave = __builtin_amdgcn_readfirstlane(tid >> 6), lane = tid & 63, fr = lane & 15, fq = lane >> 4;
    LAS float* st = (LAS float*)lds;
    LAS bf16_t* Wl = (LAS bf16_t*)(lds + 1024);
    LAS bf16_t* Vn = Wl + 128 * 136;
    const size_t row0 = (size_t)blk * 128;
    const int cc = tid & 15;
    u32x4 wq[4], vq[4]; f32x4 lg0, lg1, lb0, lb1;
#define MA_PREFETCH(g) do { _Pragma("unroll") for (int it = 0; it < 4; ++it) { const int q = tid + 512 * it; wq[it] = *(const u32x4*)(WSB + (g) * 16384 + (q >> 4) * 128 + (q & 15) * 8); \
        vq[it] = *(const u32x4*)(Z + (row0 + (tid >> 4) + 32 * it) * ZLD + ZSEC + (g) * 128 + cc * 8); } \
        lg0 = *(const f32x4*)(ln_g + (g) * 128 + cc * 8); lg1 = *(const f32x4*)(ln_g + (g) * 128 + cc * 8 + 4); lb0 = *(const f32x4*)(ln_b + (g) * 128 + cc * 8); lb1 = *(const f32x4*)(ln_b + (g) * 128 + cc * 8 + 4); } while (0)
    MA_PREFETCH(0);
#pragma unroll 8
    for (int rr = 0; rr < 16; ++rr) {
        const int r = 16 * wave + rr; const bf16_t* vp = Z + (row0 + r) * ZLD + ZSEC + lane * 16;
        const u32x4 w0 = *(const u32x4*)vp, w1 = *(const u32x4*)(vp + 8);
        float f[16] = {bf_lo(w0.x), bf_hi(w0.x), bf_lo(w0.y), bf_hi(w0.y), bf_lo(w0.z), bf_hi(w0.z), bf_lo(w0.w), bf_hi(w0.w), bf_lo(w1.x), bf_hi(w1.x), bf_lo(w1.y), bf_hi(w1.y), bf_lo(w1.z), bf_hi(w1.z), bf_lo(w1.w), bf_hi(w1.w)};
        float s = 0.f, q = 0.f;
#pragma unroll
        for (int e = 0; e < 16; ++e) { s += f[e]; q += f[e] * f[e]; }
#pragma unroll
        for (int o = 1; o < 64; o <<= 1) { s += __shfl_xor(s, o); q += __shfl_xor(q, o); }
        const float mean = s * (1.f / 1024.f); const float var = fmaxf(q * (1.f / 1024.f) - mean * mean, 0.f);
        if (lane == 0) { st[2 * r] = mean; st[2 * r + 1] = rsqrtf(var + EPS); }
    }
    LDS_BARRIER();
    const unsigned vaddr = (unsigned)(uintptr_t)(Vn + (8 * fq + (fr >> 2)) * 136 + 16 * wave + 4 * (fr & 3));
    for (int g = 0; g < 8; ++g) {
#pragma unroll
        for (int it = 0; it < 4; ++it) { const int q = tid + 512 * it; *(LAS u32x4*)(Wl + (q >> 4) * 136 + (q & 15) * 8) = wq[it]; }
#pragma unroll
        for (int it = 0; it < 4; ++it) { const int j = (tid >> 4) + 32 * it; const u32x4 w = vq[it]; const float mu = st[2 * j], rs = st[2 * j + 1];
            const f32x4 o0 = (f32x4){(bf_lo(w.x) - mu) * rs * lg0[0] + lb0[0], (bf_hi(w.x) - mu) * rs * lg0[1] + lb0[1], (bf_lo(w.y) - mu) * rs * lg0[2] + lb0[2], (bf_hi(w.y) - mu) * rs * lg0[3] + lb0[3]};
            const f32x4 o1 = (f32x4){(bf_lo(w.z) - mu) * rs * lg1[0] + lb1[0], (bf_hi(w.z) - mu) * rs * lg1[1] + lb1[1], (bf_lo(w.w) - mu) * rs * lg1[2] + lb1[2], (bf_hi(w.w) - mu) * rs * lg1[3] + lb1[3]};
            *(LAS u32x4*)(Vn + j * 136 + cc * 8) = pack8(o0, o1); }
        LDS_BARRIER();
        u32x2 uq[8]; float bsv[8];
#pragma unroll
        for (int it = 0; it < 8; ++it) { uq[it] = *(const u32x2*)(Z + (row0 + 16 * it + fr) * ZLD + g * 128 + 16 * wave + 4 * fq); bsv[it] = b_s[g * 128 + 16 * it + fr]; }
        asm volatile("" ::: "memory");
        MA_PREFETCH(g < 7 ? g + 1 : 7);
        s16x4 t00, t01, t10, t11, t20, t21, t30, t31;
        asm volatile("ds_read_b64_tr_b16 %0, %8\n\tds_read_b64_tr_b16 %1, %8 offset:1088\n\tds_read_b64_tr_b16 %2, %8 offset:8704\n\tds_read_b64_tr_b16 %3, %8 offset:9792\n\t"
                     "ds_read_b64_tr_b16 %4, %8 offset:17408\n\tds_read_b64_tr_b16 %5, %8 offset:18496\n\tds_read_b64_tr_b16 %6, %8 offset:26112\n\tds_read_b64_tr_b16 %7, %8 offset:27200\n\ts_waitcnt lgkmcnt(0)"
                     : "=&v"(t00), "=&v"(t01), "=&v"(t10), "=&v"(t11), "=&v"(t20), "=&v"(t21), "=&v"(t30), "=&v"(t31) : "v"(vaddr) : "memory");
        bf16x8 avk[4];
        avk[0] = __builtin_shufflevector(t00, t01, 0, 1, 2, 3, 4, 5, 6, 7); avk[1] = __builtin_shufflevector(t10, t11, 0, 1, 2, 3, 4, 5, 6, 7);
        avk[2] = __builtin_shufflevector(t20, t21, 0, 1, 2, 3, 4, 5, 6, 7); avk[3] = __builtin_shufflevector(t30, t31, 0, 1, 2, 3, 4, 5, 6, 7);
        f32x4 acc[8];
#pragma unroll
        for (int it = 0; it < 8; ++it) acc[it] = (f32x4){0.f, 0.f, 0.f, 0.f};
#pragma unroll
        for (int k = 0; k < 4; ++k) {
#pragma unroll
            for (int it = 0; it < 8; ++it) { if (it < 4 && k >= 2) continue;
                const bf16x8 bv = *(const LAS bf16x8*)(Wl + (16 * it + fr) * 136 + 32 * k + 8 * fq);
                acc[it] = __builtin_amdgcn_mfma_f32_16x16x32_bf16(avk[k], bv, acc[it], 0, 0, 0); } }
#pragma unroll
        for (int it = 0; it < 8; ++it) { const float bs = bsv[it]; const u32x2 uw = uq[it];
            u32x2 o; o.x = cvt_pk_bf16(bf_lo(uw.x) * (acc[it][0] + bs), bf_hi(uw.x) * (acc[it][1] + bs)); o.y = cvt_pk_bf16(bf_lo(uw.y) * (acc[it][2] + bs), bf_hi(uw.y) * (acc[it][3] + bs));
            *(u32x2*)(AO + (row0 + 16 * it + fr) * DM + g * 128 + 16 * wave + 4 * fq) = o; }
        LDS_BARRIER();
    }
#undef MA_PREFETCH
}

typedef float f32x16 __attribute__((ext_vector_type(16)));
__device__ __forceinline__ void mixerB_unit(LAS unsigned char* lds, int unit, const bf16_t* Z, bf16_t* BO, const bf16_t* LRT, const float* BIASP, const float* conv_w, const float* conv_b) {
    const int tid = threadIdx.x, wave = __builtin_amdgcn_readfirstlane(tid >> 6), lane = tid & 63, l31 = lane & 31, hh = lane >> 5;
    const int b = unit >> 5, hd = (unit >> 1) & 15, half = unit & 1, ch0 = hd * 64, jo = half * 32;
    const bool is_c = wave < 4;
    constexpr int NT = SEQ / 128;
    LAS bf16_t* wl = (LAS bf16_t*)lds;
    LAS bf16_t* xrl = (LAS bf16_t*)(lds + 36864);
    LAS float* cwl = (LAS float*)(lds + 74592);
    LAS float* alb = (LAS float*)(lds + 75616);
    LAS float* gil = (LAS float*)(lds + 112480);
    LAS float* sA = (LAS float*)(lds + 130912);
    LAS float* sH = sA + 256;
    LAS float* cry = sH + 256;
#pragma unroll
    for (int it = 0; it < 4; ++it) { const int q = tid + 512 * it, row = q >> 3, c8 = q & 7, gate = row >> 7, k = (row >> 5) & 3, j = row & 31;
        *(LAS u32x4*)(wl + row * 72 + c8 * 8) = *(const u32x4*)(LRT + ((size_t)((gate * 16 + hd) * 4 + k) * 64 + jo + j) * 64 + c8 * 8); }
    if (tid < 128) cwl[tid] = conv_w[(tid >> 5) * DM + ch0 + jo + (tid & 31)];
    else if (tid < 192) { const int wq = (tid - 128) >> 5, ch = ch0 + jo + (tid & 31); cwl[128 + (tid - 128)] = BIASP[wq * DM + ch]; cwl[192 + (tid - 128)] = wq ? conv_b[ch] : BIASP[2 * DM + ch]; }
    if (tid < 64) cry[tid] = 0.f;
    const int sid = tid & 255, sc = sid & 31, seg = sid >> 5;
    const bf16_t* xbase = Z + ((size_t)b * SEQ + (sid >> 3)) * ZLD + 2 * ZSEC + ch0 + (sid & 7) * 8;
    const bf16_t* xhalo = Z + ((size_t)b * SEQ + (sid < 24 ? (sid >> 3) : 0)) * ZLD + 2 * ZSEC + ch0 + (sid & 7) * 8 - (ptrdiff_t)3 * ZLD;
    const bf16_t* gbase = Z + ((size_t)b * SEQ + 16 * seg) * ZLD + 3 * ZSEC + ch0 + jo + sc;
    bf16_t* obase = BO + ((size_t)b * SEQ + 16 * seg) * DM + ch0 + jo + sc;
    u32x4 rq[4], hq; unsigned gy[16];
#define MB_LOAD_RAW(tile) do { const bf16_t* xp_ = xbase + (size_t)(tile) * 128 * ZLD; _Pragma("unroll") for (int it = 0; it < 4; ++it) rq[it] = *(const u32x4*)(xp_ + (size_t)(32 * it) * ZLD); \
        hq = *(const u32x4*)(xhalo + (size_t)((tile) > 0 ? (tile) : 1) * 128 * ZLD); } while (0)
#define MB_STORE_RAW(buf) do { LAS bf16_t* xd_ = xrl + (buf) * 9432; _Pragma("unroll") for (int it = 0; it < 4; ++it) *(LAS u32x4*)(xd_ + (3 + (sid >> 3) + 32 * it) * 72 + (sid & 7) * 8) = rq[it]; \
        if (sid < 24) *(LAS u32x4*)(xd_ + (sid >> 3) * 72 + (sid & 7) * 8) = hq; } while (0)
#define MB_LOAD_GY(tile) do { _Pragma("unroll") for (int s_ = 0; s_ < 16; ++s_) gy[s_] = (unsigned)gbase[((size_t)(tile) * 128 + s_) * ZLD]; } while (0)
#define MB_GATE(GATE, buf, dst) do { const LAS bf16_t* xs_ = xrl + (buf) * 9432; const int t_ = 32 * wave + l31; \
        f32x16 acc_; _Pragma("unroll") for (int e_ = 0; e_ < 16; ++e_) acc_[e_] = 0.f; \
        _Pragma("unroll") for (int ks = 0; ks < 16; ++ks) { const bf16x8 wv_ = *(const LAS bf16x8*)(wl + (((GATE) * 4 + (ks >> 2)) * 32 + l31) * 72 + 16 * (ks & 3) + 8 * hh); \
            const bf16x8 xb_ = *(const LAS bf16x8*)(xs_ + (t_ + (ks >> 2)) * 72 + 16 * (ks & 3) + 8 * hh); \
            acc_ = __builtin_amdgcn_mfma_f32_32x32x16_bf16(wv_, xb_, acc_, 0, 0, 0); } \
        const LAS float* bsl_ = cwl + 128 + (GATE) * 32; const LAS float* c2l_ = cwl + 192 + (GATE) * 32; \
        if ((GATE) == 0) { \
            _Pragma("unroll") for (int i = 0; i < 4; ++i) { f32x4 o_; const f32x4 bs_ = *(const LAS f32x4*)(bsl_ + 8 * i + 4 * hh), c2_ = *(const LAS f32x4*)(c2l_ + 8 * i + 4 * hh); \
                _Pragma("unroll") for (int j = 0; j < 4; ++j) o_[j] = __builtin_amdgcn_exp2f(-c2_[j] * fsigmoid(acc_[4 * i + j] + bs_[j])); \
                *(LAS f32x4*)((dst) + t_ * 36 + 8 * i + 4 * hh) = o_; } \
        } else { \
            _Pragma("unroll") for (int i = 0; i < 4; ++i) { f32x4 xc_ = *(const LAS f32x4*)(c2l_ + 8 * i + 4 * hh); const f32x4 bs_ = *(const LAS f32x4*)(bsl_ + 8 * i + 4 * hh); \
                _Pragma("unroll") for (int k = 0; k < 4; ++k) { const u32x2 w_ = *(const LAS u32x2*)(xs_ + (t_ + k) * 72 + jo + 8 * i + 4 * hh); const f32x4 cw_ = *(const LAS f32x4*)(cwl + k * 32 + 8 * i + 4 * hh); \
                    xc_[0] += cw_[0] * bf_lo(w_.x); xc_[1] += cw_[1] * bf_hi(w_.x); xc_[2] += cw_[2] * bf_lo(w_.y); xc_[3] += cw_[3] * bf_hi(w_.y); } \
                f32x4 o_; \
                _Pragma("unroll") for (int j = 0; j < 4; ++j) o_[j] = fsigmoid(acc_[4 * i + j] + bs_[j]) * xc_[j]; \
                *(LAS f32x4*)((dst) + t_ * 36 + 8 * i + 4 * hh) = o_; } \
        } } while (0)
    if (!is_c) { MB_LOAD_RAW(0); hq = (u32x4){0u, 0u, 0u, 0u}; MB_STORE_RAW(0); MB_LOAD_RAW(1); MB_STORE_RAW(1); MB_LOAD_RAW(2); MB_LOAD_GY(0); }
    LDS_BARRIER();
    if (is_c) { MB_GATE(0, 0, alb); MB_GATE(1, 0, gil); }
    LDS_BARRIER();
    float a16[16], g16[16];
    for (int tile = 0; tile < NT; ++tile) {
        if (is_c) { if (tile + 1 < NT) MB_GATE(0, (tile + 1) & 1, alb + ((tile + 1) & 1) * 4608); }
        else {
            const LAS float* al = alb + (tile & 1) * 4608; float A = 1.f, Hh = 0.f;
#pragma unroll
            for (int s = 0; s < 16; ++s) { const float av = al[(16 * seg + s) * 36 + sc]; a16[s] = av; g16[s] = __builtin_amdgcn_sqrtf(fmaxf(1.0f - av * av, 0.f)) * gil[(16 * seg + s) * 36 + sc]; A *= av; Hh = av * Hh + g16[s]; }
            sA[seg * 32 + sc] = A; sH[seg * 32 + sc] = Hh;
            MB_STORE_RAW(tile & 1);
            MB_LOAD_RAW(tile + 3 < NT ? tile + 3 : NT - 1);
        }
        LDS_BARRIER();
        if (is_c) { if (tile + 1 < NT) MB_GATE(1, (tile + 1) & 1, gil); }
        else {
            float h = cry[(tile & 1) * 32 + sc];
#pragma unroll
            for (int s = 0; s < 7; ++s) { const float As = sA[s * 32 + sc], Hs = sH[s * 32 + sc]; h = (s < seg) ? As * h + Hs : h; }
            bf16_t* op = obase + (size_t)tile * 128 * DM;
#pragma unroll
            for (int s = 0; s < 16; ++s) { h = a16[s] * h + g16[s]; op[(size_t)s * DM] = f2bf(h * __builtin_bit_cast(float, gy[s] << 16)); }
            if (seg == 7) cry[((tile + 1) & 1) * 32 + sc] = h;
            MB_LOAD_GY(tile + 1 < NT ? tile + 1 : NT - 1);
        }
        LDS_BARRIER();
    }
#undef MB_LOAD_RAW
#undef MB_STORE_RAW
#undef MB_LOAD_GY
#undef MB_GATE
}

__device__ __forceinline__ void grid_barrier(unsigned* bar) {
    asm volatile("s_waitcnt vmcnt(0)" ::: "memory");
    __syncthreads();
    if (threadIdx.x == 0) {
        __builtin_amdgcn_fence(__ATOMIC_RELEASE, "agent");
        const unsigned G = gridDim.x;
        const unsigned old = __hip_atomic_fetch_add(bar, 1u, __ATOMIC_RELAXED, __HIP_MEMORY_SCOPE_AGENT);
        const unsigned target = (old / G + 1u) * G;
        while (__hip_atomic_load(bar, __ATOMIC_RELAXED, __HIP_MEMORY_SCOPE_AGENT) < target) __builtin_amdgcn_s_sleep(2);
        __builtin_amdgcn_fence(__ATOMIC_ACQUIRE, "agent");
        asm volatile("s_waitcnt vmcnt(0)" ::: "memory");
    }
    __syncthreads();
}
typedef const __attribute__((address_space(4))) Args* KArgs;
__device__ __forceinline__ KArgs kargs() {
#if defined(__HIP_DEVICE_COMPILE__)
    auto p0 = __builtin_amdgcn_kernarg_segment_ptr(); KArgs p = (KArgs)p0; asm volatile("" : "+s"(p)); return p;
#else
    return nullptr;
#endif
}
constexpr int NPHASE = 12;
__global__ void __launch_bounds__(NTHR, 2) fwd_kernel(Args args) {
    extern __shared__ __attribute__((aligned(16))) unsigned char lds_raw[];
    LAS unsigned char* lds = (LAS unsigned char*)lds_raw;
    const int lo = args.ph_lo, hi = args.ph_hi;
#define IN(k) (lo <= (k) && (k) < hi)
#define SEAM(k) do { if (IN(k) && IN((k) + 1)) { if ((k) == 0) cg::this_grid().sync(); else grid_barrier((unsigned*)kargs()->ws); } } while (0)
#define PH KArgs ka = kargs(); unsigned char* ws = ka->ws; bf16_t* Z = (bf16_t*)(ws + WS_Z); bf16_t* H = (bf16_t*)(ws + WS_H); const int G = gridDim.x, bx = blockIdx.x; (void)Z; (void)H; (void)G; (void)bx;
#define WV const int lane = threadIdx.x & 63, wave = __builtin_amdgcn_readfirstlane(threadIdx.x >> 6);
    typedef pg8::StaticOrder SO;
    typedef PanelOrder PO;
    if (IN(0)) { PH WV prologue(ka, lds, bx * NWAVES + wave, G * NWAVES, wave, lane); __syncthreads(); }
    SEAM(0);
    if (IN(1)) { PH pg8::Gemm g{H, (const bf16_t*)(ws + WS_WIN), M, NIN, DM, DM}; SO S; S.init(M, NIN, G, bx); EpiZ E{Z};
        pg8::gemm_phase<EpiZ, SO, true, true>(lds, g, S, E); }
    SEAM(1);
    if (IN(2)) { PH mixerB_unit(lds, ((((bx >> 4) << 3) | (bx & 7)) << 1) | ((bx >> 3) & 1), Z, (bf16_t*)ka->out + (size_t)M * DM, (const bf16_t*)(ws + WS_LRT), (const float*)(ws + WS_BIASP), ka->in[9], ka->in[10]); }
    if (IN(3)) { PH for (int u = bx; u < M / 128; u += G) mixerA_unit(lds, u, Z, (bf16_t*)ka->out, (const bf16_t*)(ws + WS_WSB), ka->in[5], ka->in[6], ka->in[8]); }
    SEAM(3);
    if (IN(4)) { PH
        { SO S; S.init(M, DM, G, bx); pg8::Gemm g{(const bf16_t*)ka->out, (const bf16_t*)(ws + WS_WA), M, DM, DM, DM}; EpiGate<false> E{Z + ZSEC, Z + 4 * ZSEC, ZLD}; pg8::gemm_phase<EpiGate<false>, SO, true, true>(lds, g, S, E); }
        __syncthreads();
        { SO S; S.init(M, DM, G, bx); pg8::Gemm g{(const bf16_t*)ka->out + (size_t)M * DM, (const bf16_t*)(ws + WS_WB), M, DM, DM, DM}; EpiGate<true> E{Z + ZSEC, Z + 5 * ZSEC, ZLD}; pg8::gemm_phase<EpiGate<true>, SO, true, true>(lds, g, S, E); }
        __syncthreads();
    }
    SEAM(4);
    if (IN(5)) { PH PO S; S.init(DM, bx); pg8::Gemm g{Z + ZSEC, (const bf16_t*)(ws + WS_WO), M, DM, DM, ZLD}; EpiPlain E{Z + 2 * ZSEC, ZLD}; pg8::gemm_phase<EpiPlain, PO, true, true>(lds, g, S, E); __syncthreads(); }
    if (IN(6)) { PH WV norm_pass<false, true>((const unsigned char*)(ka->in[0] + (size_t)bx * 256 * DM), (size_t)DM * 4, Z + 2 * ZSEC + (size_t)bx * 256 * ZLD, ZLD, ka->in[3], (unsigned char*)ka->out + ((size_t)bx << 20), (size_t)DM * 2, ka->in[19], H + (size_t)bx * 256 * DM, wave, lane); }
    SEAM(6);
    if (IN(7)) { PH pg8::Gemm g{H, (const bf16_t*)(ws + WS_WGU), M, NGU, DM, DM}; SO S; S.init(M, NGU, G, bx); EpiSwiglu E{(bf16_t*)(ws + WS_ACT)};
        pg8::gemm_phase<EpiSwiglu, SO, true, true>(lds, g, S, E); }
    SEAM(7);
    if (IN(8)) { PH pg8::Gemm g{(const bf16_t*)(ws + WS_ACT), (const bf16_t*)(ws + WS_WDN), M, DM, DFF, DFF}; SO S; S.init(M, DM, G, bx); EpiPlain E{(bf16_t*)(ws + WS_F), DM};
        pg8::gemm_phase<EpiPlain, SO, true, true>(lds, g, S, E); }
    SEAM(8);
    if (IN(9)) { PH WV bf16_t* F = (bf16_t*)(ws + WS_F) + (size_t)bx * 256 * DM; norm_pass<true, true>((const unsigned char*)ka->out + ((size_t)bx << 20), (size_t)DM * 2, F, DM, ka->in[20], (unsigned char*)F, (size_t)DM * 2, ka->in[24], H + (size_t)bx * 256 * DM, wave, lane); __syncthreads(); }
    if (IN(10)) { PH
        { PO S; S.init(DM, bx); pg8::Gemm g{(const bf16_t*)(ws + WS_PB), (const bf16_t*)(ws + WS_WPIN), M, DM, PLE, PLE}; EpiPlain E{(bf16_t*)(ws + WS_GE), DM}; pg8::gemm_phase<EpiPlain, PO, true, true>(lds, g, S, E); }
        __syncthreads();
        { PO S; S.init(DM, bx); pg8::Gemm g{H, (const bf16_t*)(ws + WS_WPG), M, DM, DM, DM}; EpiSigMul E{(bf16_t*)(ws + WS_GE)}; pg8::gemm_phase<EpiSigMul, PO, true, true>(lds, g, S, E); }
        __syncthreads();
    }
    if (IN(11)) { PH WV norm_pass<true, false>((const unsigned char*)(ws + WS_F) + (size_t)bx * 256 * DM * 2, (size_t)DM * 2, (const bf16_t*)(ws + WS_GE) + (size_t)bx * 256 * DM, DM, ka->in[25], (unsigned char*)(ka->out + (size_t)bx * 256 * DM), (size_t)DM * 4, nullptr, nullptr, wave, lane); }
#undef PH
#undef WV
#undef IN
#undef SEAM
}

extern "C" void kernel_launch(void* const* d_in, const int* in_sizes, int n_in, void* d_out, int out_size, void* d_ws, size_t ws_size, hipStream_t stream) {
    static int grid = 0;
    if (grid == 0) {
        if (n_in != 28 || in_sizes[0] != M * DM || out_size != M * DM || ws_size < WS_END) { fprintf(stderr, "kernel_launch: unexpected shapes (n_in %d, in0 %d, out %d, ws %zu)\n", n_in, n_in > 0 ? in_sizes[0] : -1, out_size, ws_size); grid = -1; return; }
        int dev = 0, cus = 0, per_cu = 0;
        if (hipGetDevice(&dev) != hipSuccess || hipDeviceGetAttribute(&cus, hipDeviceAttributeMultiprocessorCount, dev) != hipSuccess) { grid = -1; return; }
        if (hipFuncSetAttribute((const void*)fwd_kernel, hipFuncAttributeMaxDynamicSharedMemorySize, LDS_BYTES) != hipSuccess) { fprintf(stderr, "kernel_launch: hipFuncSetAttribute failed\n"); grid = -1; return; }
        if (hipOccupancyMaxActiveBlocksPerMultiprocessor(&per_cu, (const void*)fwd_kernel, NTHR, LDS_BYTES) != hipSuccess || per_cu < 1) { fprintf(stderr, "kernel_launch: occupancy query says %d\n", per_cu); per_cu = 1; }
        (void)hipGetLastError();
        grid = cus * 1;
        if (grid != M / 256) { fprintf(stderr, "kernel_launch: built for a 256-CU device (one workgroup per 256-row panel); got %d CUs\n", cus); grid = -1; return; }
    }
    if (grid < 0) return;
    if (hipMemsetAsync(d_ws, 0, 256, stream) != hipSuccess) { fprintf(stderr, "kernel_launch: memset failed\n"); return; }
    Args a{};
    for (int i = 0; i < 28; ++i) a.in[i] = (const float*)d_in[i];
    a.out = (float*)d_out; a.ws = (unsigned char*)d_ws;
#if MK_ONE
    a.ph_lo = 0; a.ph_hi = NPHASE;
    void* kargs[] = {&a};
    hipError_t e = hipLaunchCooperativeKernel((const void*)fwd_kernel, dim3(grid), dim3(NTHR), kargs, LDS_BYTES, stream);
    if (e != hipSuccess) fprintf(stderr, "kernel_launch: cooperative launch failed: %s (grid %d)\n", hipGetErrorString(e), grid);
#else
    for (int k = 0; k < NPHASE; ++k) for (int rep = 0; rep < 1 + ((REP_MASK >> k) & 1); ++rep) { a.ph_lo = k; a.ph_hi = k + 1; hipLaunchKernelGGL(fwd_kernel, dim3(grid), dim3(NTHR), LDS_BYTES, stream, a); }
#endif
}
```

```cpp
#include <hip/hip_runtime.h>
#include <hip/hip_cooperative_groups.h>
#include <cstdio>
#include <cstdint>
namespace cg = cooperative_groups;
#ifndef REP_MASK
#define REP_MASK 0
#endif
#ifndef MK_ONE
#define MK_ONE 1
#endif
namespace pg8 {
#define PG8_LAS __attribute__((address_space(3)))
typedef unsigned short bf16_t;
typedef short bf16x8 __attribute__((ext_vector_type(8)));
typedef float f32x4 __attribute__((ext_vector_type(4)));
typedef unsigned u32x4 __attribute__((ext_vector_type(4)));
constexpr int BM = 256, BK = 64, HALF = 128, HTB = HALF * BK * 2  , STAGE_BYTES = 8 * HTB, NXCD = 8, WGM = 8;

__host__ __device__ __forceinline__ int lds_byte(int r, int c) { const int st = (r >> 4) * 2 + (c >> 5), rr = r & 15, cc = c & 31, ob = rr * 64 + cc * 2; return st * 1024 + (ob ^ (((ob >> 9) & 1) << 5)); }
__host__ __device__ __forceinline__ void stage_rc(int b, int& R, int& C) { const int st = b / 1024, sb = b % 1024, swz = sb ^ (((sb >> 9) & 1) << 5); R = (st >> 1) * 16 + swz / 64; C = (st & 1) * 32 + (swz % 64) / 2; }
__host__ __device__ __forceinline__ int perm32(int rho) { const int n = rho >> 4, i = rho & 15; return 8 * (i >> 2) + 4 * n + (i & 3); }

struct Unit { int pm, pn; };
struct Gemm { const bf16_t* A; const bf16_t* Bt; int M, N, K, lda; };

struct StaticOrder {
    int nM, nN, nwg, G, c;
    __host__ __device__ void init(int M, int N, int G_, int c_) { nM = M / BM; nN = N / BM; nwg = nM * nN; G = G_; c = c_; }
    __host__ __device__ bool next(int i, Unit& u) const {
        const long L = (long)i * G + c; if (L >= nwg) return false;
        int wgid = (int)L; { const int q = nwg / NXCD, r = nwg % NXCD, xcd = wgid % NXCD, off = wgid / NXCD; wgid = (xcd < r ? xcd * (q + 1) : r * (q + 1) + (xcd - r) * q) + off; }
        const int nig = WGM * nN, gid = wgid / nig, fm = gid * WGM, gsz = (nM - fm) < WGM ? (nM - fm) : WGM;
        u.pm = fm + ((wgid % nig) % gsz); u.pn = (wgid % nig) / gsz; return true;
    }
    __device__ __forceinline__ void a_ready(const Unit&) const {}
    __device__ __forceinline__ void done(const Unit&) const {}
};

__device__ __forceinline__ unsigned cvt_pk_bf16(float lo, float hi) { unsigned r; asm volatile("v_cvt_pk_bf16_f32 %0, %1, %2" : "=v"(r) : "v"(lo), "v"(hi)); return r; }
typedef float f32x2 __attribute__((ext_vector_type(2)));
template <class Epi, class Sched, bool ALIGN_EPI = false, bool SP2 = false>
__device__ __forceinline__ void gemm_phase(PG8_LAS unsigned char* lds, const Gemm g, const Sched& S, const Epi& E) {
    const int tid = threadIdx.x, wid = __builtin_amdgcn_readfirstlane(tid >> 6), lane = tid & 63, wr = wid >> 2, wc = wid & 3, fr = lane & 15, fq = lane >> 4;
    const int K = g.K, nt = K / BK;
    unsigned voffA[2], voffB[2];
#pragma unroll
    for (int i = 0; i < 2; ++i) { int R, C; stage_rc(tid * 16 + i * 8192, R, C); const int Rb = Epi::PERM ? ((R & ~31) + perm32(R & 31)) : R;
        voffA[i] = (unsigned)(R * g.lda + C) * 2u; voffB[i] = (unsigned)(Rb * K + C) * 2u; }
    const size_t kstep = (size_t)(BK * 2);
    const size_t hstepA = (size_t)HALF * g.lda * 2, hstepB = (size_t)HALF * K * 2;
    const size_t tstepA = 2 * hstepA, tstepB = 2 * hstepB;
    const unsigned ldsw = (unsigned)wid * 1024u;
    const int aoff = lds_byte(wr * 64 + fr, fq * 8), boff = lds_byte(wc * 32 + fr, fq * 8);
#define PG8_SA(b, h) (((b) * 2 + (h)) * HTB)
#define PG8_SB(b, h) ((4 + (b) * 2 + (h)) * HTB)
#define PG8_STAGE(bufoff, gbase, voff) do { _Pragma("unroll") for (int _i = 0; _i < 2; ++_i) \
        __builtin_amdgcn_global_load_lds((const unsigned*)((const char*)(gbase) + (voff)[_i]), (PG8_LAS unsigned*)(lds + (bufoff) + ldsw + _i * 8192), 16, 0, 0); } while (0)
#define PG8_LDA(dst, b, h) do { _Pragma("unroll") for (int m = 0; m < 4; ++m) _Pragma("unroll") for (int k = 0; k < 2; ++k) dst[m][k] = *(const PG8_LAS bf16x8*)(lds + PG8_SA(b, h) + aoff + m * 2048 + k * 1024); } while (0)
#define PG8_LDB(dst, b, h) do { _Pragma("unroll") for (int n = 0; n < 2; ++n) _Pragma("unroll") for (int k = 0; k < 2; ++k) dst[n][k] = *(const PG8_LAS bf16x8*)(lds + PG8_SB(b, h) + boff + n * 2048 + k * 1024); } while (0)
#define PG8_MMA(ai, bj, At, Bt) do { __builtin_amdgcn_s_setprio(1); _Pragma("unroll") for (int m = 0; m < 4; ++m) _Pragma("unroll") for (int n = 0; n < 2; ++n) _Pragma("unroll") for (int k = 0; k < 2; ++k) \
        acc[ai][bj][m][n] = __builtin_amdgcn_mfma_f32_16x16x32_bf16(Bt[n][k], At[m][k], acc[ai][bj][m][n], 0, 0, 0); __builtin_amdgcn_s_setprio(0); } while (0)
#define PG8_WAIT_V(n) asm volatile("s_waitcnt vmcnt(" #n ")" ::: "memory")
#define PG8_WAIT_L(n) asm volatile("s_waitcnt lgkmcnt(" #n ")" ::: "memory")
#define PG8_BAR __builtin_amdgcn_s_barrier()
#define PG8_SCHED __builtin_amdgcn_sched_barrier(0)
    Unit cur, nxt; int ui = 0;
    if (!S.next(0, cur)) return;
    f32x4 acc[2][2][4][2];
#pragma unroll
    for (int a = 0; a < 2; ++a)
#pragma unroll
        for (int b = 0; b < 2; ++b)
#pragma unroll
            for (int m = 0; m < 4; ++m)
#pragma unroll
                for (int n = 0; n < 2; ++n) acc[a][b][m][n] = (f32x4){0.f, 0.f, 0.f, 0.f};
    bf16x8 At[4][2], B0[2][2], B1[2][2];
    const char* cA = (const char*)g.A + (size_t)cur.pm * tstepA; const char* cB = (const char*)g.Bt + (size_t)cur.pn * tstepB;
    S.a_ready(cur);
    if constexpr (SP2) {
        PG8_STAGE(PG8_SB(0, 0), cB, voffB); PG8_STAGE(PG8_SB(0, 1), cB + hstepB, voffB); PG8_STAGE(PG8_SA(0, 0), cA, voffA); PG8_STAGE(PG8_SA(0, 1), cA + hstepA, voffA);
        if (wr == 1) PG8_BAR;
        PG8_WAIT_V(2); PG8_BAR;
        PG8_STAGE(PG8_SB(1, 0), cB + kstep, voffB); PG8_STAGE(PG8_SA(1, 0), cA + kstep, voffA); PG8_STAGE(PG8_SB(1, 1), cB + hstepB + kstep, voffB);
        PG8_WAIT_V(6); PG8_BAR;
    } else {
        PG8_STAGE(PG8_SB(0, 0), cB, voffB); PG8_STAGE(PG8_SA(0, 0), cA, voffA); PG8_STAGE(PG8_SB(0, 1), cB + hstepB, voffB); PG8_STAGE(PG8_SA(0, 1), cA + hstepA, voffA);
        if (wr == 1) PG8_BAR;
        PG8_WAIT_V(4); PG8_BAR;
        PG8_STAGE(PG8_SB(1, 0), cB + kstep, voffB); PG8_STAGE(PG8_SA(1, 0), cA + kstep, voffA); PG8_STAGE(PG8_SB(1, 1), cB + hstepB + kstep, voffB);
        PG8_WAIT_V(6); PG8_BAR;
    }
    for (;;) {
        const bool has_next = S.next(ui + 1, nxt);
        const char* nA = has_next ? (const char*)g.A + (size_t)nxt.pm * tstepA : cA; const char* nB = has_next ? (const char*)g.Bt + (size_t)nxt.pn * tstepB : cB;
        for (int t = 0; t < nt; t += 2) {
            const bool last = (t == nt - 2);
            const char* a1 = cA + (size_t)(t + 1) * kstep;
            const char* a2 = last ? nA : cA + (size_t)(t + 2) * kstep; const char* b2 = last ? nB : cB + (size_t)(t + 2) * kstep;
            const char* a3 = a2 + kstep; const char* b3 = b2 + kstep;
            if (last && has_next) S.a_ready(nxt);
            if constexpr (SP2) {
            PG8_LDB(B0, 0, 0); PG8_LDB(B1, 0, 1); PG8_SCHED; PG8_LDA(At, 0, 0); PG8_STAGE(PG8_SA(1, 1), a1 + hstepA, voffA);
            PG8_WAIT_V(8); PG8_WAIT_L(0); PG8_BAR; PG8_MMA(0, 0, At, B0); PG8_MMA(0, 1, At, B1); PG8_BAR; PG8_SCHED;
            PG8_LDA(At, 0, 1); PG8_STAGE(PG8_SB(0, 0), b2, voffB); PG8_STAGE(PG8_SB(0, 1), b2 + hstepB, voffB); PG8_STAGE(PG8_SA(0, 0), a2, voffA);
            PG8_WAIT_V(8); PG8_WAIT_L(0); PG8_BAR; PG8_MMA(1, 0, At, B0); PG8_MMA(1, 1, At, B1); PG8_BAR; PG8_SCHED;
            PG8_LDB(B0, 1, 0); PG8_LDB(B1, 1, 1); PG8_SCHED; PG8_LDA(At, 1, 0); PG8_STAGE(PG8_SA(0, 1), a2 + hstepA, voffA);
            PG8_WAIT_V(8); PG8_WAIT_L(0); PG8_BAR; PG8_MMA(0, 0, At, B0); PG8_MMA(0, 1, At, B1); PG8_BAR; PG8_SCHED;
            PG8_LDA(At, 1, 1); PG8_STAGE(PG8_SB(1, 0), b3, voffB); PG8_STAGE(PG8_SB(1, 1), b3 + hstepB, voffB); PG8_STAGE(PG8_SA(1, 0), a3, voffA);
            PG8_WAIT_V(8); PG8_WAIT_L(0); PG8_BAR; PG8_MMA(1, 0, At, B0); PG8_MMA(1, 1, At, B1); PG8_BAR; PG8_SCHED;
            } else {
            PG8_LDB(B0, 0, 0); PG8_SCHED; PG8_LDA(At, 0, 0); PG8_STAGE(PG8_SA(1, 1), a1 + hstepA, voffA);
            PG8_WAIT_L(8); PG8_BAR; PG8_WAIT_L(0); PG8_MMA(0, 0, At, B0); PG8_BAR; PG8_SCHED;
            PG8_LDB(B1, 0, 1); PG8_STAGE(PG8_SB(0, 0), b2, voffB);
            PG8_BAR; PG8_WAIT_L(0); PG8_MMA(0, 1, At, B1); PG8_BAR;
            PG8_LDA(At, 0, 1); PG8_STAGE(PG8_SA(0, 0), a2, voffA);
            PG8_BAR; PG8_WAIT_L(0); PG8_MMA(1, 0, At, B0); PG8_BAR; PG8_SCHED;
            PG8_STAGE(PG8_SB(0, 1), b2 + hstepB, voffB);
            PG8_WAIT_V(6); PG8_BAR; PG8_MMA(1, 1, At, B1); PG8_BAR;
            PG8_LDB(B0, 1, 0); PG8_SCHED; PG8_LDA(At, 1, 0); PG8_STAGE(PG8_SA(0, 1), a2 + hstepA, voffA);
            PG8_WAIT_L(8); PG8_BAR; PG8_WAIT_L(0); PG8_MMA(0, 0, At, B0); PG8_BAR; PG8_SCHED;
            PG8_LDB(B1, 1, 1); PG8_STAGE(PG8_SB(1, 0), b3, voffB);
            PG8_BAR; PG8_WAIT_L(0); PG8_MMA(0, 1, At, B1); PG8_BAR;
            PG8_LDA(At, 1, 1); PG8_STAGE(PG8_SA(1, 0), a3, voffA);
            PG8_BAR; PG8_WAIT_L(0); PG8_MMA(1, 0, At, B0); PG8_BAR; PG8_SCHED;
            PG8_STAGE(PG8_SB(1, 1), b3 + hstepB, voffB);
            PG8_WAIT_V(6); PG8_BAR; PG8_MMA(1, 1, At, B1); PG8_BAR;
            }
        }
        if constexpr (ALIGN_EPI) { if (wr == 0) PG8_BAR; }
        if constexpr (!Epi::AFTER_DRAIN) { E(acc, cur, wr, wc, fr, fq); S.done(cur); }
        if (!has_next) break;
#pragma unroll
        for (int a = 0; a < 2; ++a)
#pragma unroll
            for (int b = 0; b < 2; ++b)
#pragma unroll
                for (int m = 0; m < 4; ++m)
#pragma unroll
                    for (int n = 0; n < 2; ++n) acc[a][b][m][n] = (f32x4){0.f, 0.f, 0.f, 0.f};
        cur = nxt; cA = nA; cB = nB; ++ui;
        if constexpr (ALIGN_EPI) { if (wr == 1) PG8_BAR; }
    }
    PG8_WAIT_V(0);
    if constexpr (!ALIGN_EPI) { if (wr == 0) PG8_BAR; }
    PG8_BAR;
    if constexpr (Epi::AFTER_DRAIN) { E.fused(acc, cur, wr, wc, fr, fq, lds, wid, lane); S.done(cur); }
#undef PG8_SA
#undef PG8_SB
#undef PG8_STAGE
#undef PG8_LDA
#undef PG8_LDB
#undef PG8_MMA
#undef PG8_WAIT_V
#undef PG8_WAIT_L
#undef PG8_BAR
#undef PG8_SCHED
}
}
using pg8::bf16_t; using pg8::bf16x8; using pg8::f32x4; using pg8::u32x4; using pg8::Unit; using pg8::cvt_pk_bf16;
#define LAS __attribute__((address_space(3)))
typedef unsigned u32x2 __attribute__((ext_vector_type(2)));

constexpr int DM = 1024, BATCH = 8, SEQ = 8192, M = BATCH * SEQ, NIN = 6144, DFF = 2816, NGU = 2 * DFF, PLE = 256, ZLD = 1024;
constexpr size_t ZSEC = (size_t)M * 1024;
constexpr float EPS = 1e-6f;
constexpr size_t MiB = 1u << 20;
constexpr size_t WS_WIN = 1 * MiB, WS_WA = 13 * MiB, WS_WB = 15 * MiB, WS_WO = 17 * MiB, WS_WPG = 19 * MiB, WS_WGU = 21 * MiB, WS_WDN = 32 * MiB, WS_WPIN = 38 * MiB;
constexpr size_t WS_WSB = 38 * MiB + 512 * 1024, WS_BIASP = 38 * MiB + 768 * 1024, WS_LRT = 39 * MiB;
constexpr size_t WS_PB = 40 * MiB, WS_H = 72 * MiB, WS_Z = 200 * MiB, WS_ACT = 200 * MiB, WS_F = 552 * MiB, WS_GE = 680 * MiB, WS_END = 968 * MiB;
constexpr int NWAVES = 8, NTHR = 512, LDS_BYTES = 147456;

__device__ __forceinline__ float bf_lo(unsigned w) { return __builtin_bit_cast(float, w << 16); }
__device__ __forceinline__ float bf_hi(unsigned w) { return __builtin_bit_cast(float, w & 0xffff0000u); }
__device__ __forceinline__ float bf1(unsigned short h) { return __builtin_bit_cast(float, ((unsigned)h) << 16); }
__device__ __forceinline__ unsigned short f2bf(float f) { unsigned u = __builtin_bit_cast(unsigned, f); return (unsigned short)((u + 0x7fffu + ((u >> 16) & 1u)) >> 16); }
__device__ __forceinline__ float fsigmoid(float x) { return __builtin_amdgcn_rcpf(1.0f + __builtin_amdgcn_exp2f(-1.4426950408889634f * x)); }
__device__ __forceinline__ float fgelu(float x) { const float u = x * (0.7978845608028654f + 0.035677408136300125f * x * x); return x * __builtin_amdgcn_rcpf(1.0f + __builtin_amdgcn_exp2f(-2.8853900817779268f * u)); }
__device__ __forceinline__ float wave_sum(float v) {
#pragma unroll
    for (int o = 1; o < 64; o <<= 1) v += __shfl_xor(v, o);
    return v;
}

#define EPI_LOOP_BEGIN \
    const int row0 = u.pm * 256 + wr * 64 + fr, col0 = u.pn * 256 + wc * 32 + 8 * fq; \
    _Pragma("unroll") for (int ai = 0; ai < 2; ++ai) _Pragma("unroll") for (int m = 0; m < 4; ++m) { const size_t row = (size_t)(row0 + ai * 128 + m * 16); \
    _Pragma("unroll") for (int bj = 0; bj < 2; ++bj) { const int col = col0 + bj * 128; f32x4 v0 = acc[ai][bj][m][0], v1 = acc[ai][bj][m][1];
#define EPI_LOOP_END } }
__device__ __forceinline__ u32x4 pack8(f32x4 v0, f32x4 v1) { u32x4 w; w.x = cvt_pk_bf16(v0[0], v0[1]); w.y = cvt_pk_bf16(v0[2], v0[3]); w.z = cvt_pk_bf16(v1[0], v1[1]); w.w = cvt_pk_bf16(v1[2], v1[3]); return w; }

struct EpiZ {
    static constexpr bool PERM = true, AFTER_DRAIN = false; bf16_t* Z;
    __device__ __forceinline__ void operator()(const f32x4 (&acc)[2][2][4][2], const Unit& u, int wr, int wc, int fr, int fq) const {
        const int sec = u.pn >> 2; const int mode = (sec == 2) ? 0 : (sec >= 4 ? 2 : 1); bf16_t* Zs = Z + (size_t)sec * ZSEC;
        EPI_LOOP_BEGIN
            if (mode == 1) {
#pragma unroll
                for (int e = 0; e < 4; ++e) { v0[e] = fgelu(v0[e]); v1[e] = fgelu(v1[e]); }
            } else if (mode == 2) {
#pragma unroll
                for (int e = 0; e < 4; ++e) { v0[e] = fsigmoid(v0[e]); v1[e] = fsigmoid(v1[e]); }
            }
            *(u32x4*)(Zs + row * ZLD + (col & 1023)) = pack8(v0, v1);
        EPI_LOOP_END
    }
};
struct EpiPlain {
    static constexpr bool PERM = true, AFTER_DRAIN = false; bf16_t* O; int ldc;
    __device__ __forceinline__ void operator()(const f32x4 (&acc)[2][2][4][2], const Unit& u, int wr, int wc, int fr, int fq) const {
        EPI_LOOP_BEGIN
            *(u32x4*)(O + row * ldc + col) = pack8(v0, v1);
        EPI_LOOP_END
    }
};
__device__ __forceinline__ void mul8(f32x4& v0, f32x4& v1, const u32x4 w) { v0[0] *= bf_lo(w.x); v0[1] *= bf_hi(w.x); v0[2] *= bf_lo(w.y); v0[3] *= bf_hi(w.y); v1[0] *= bf_lo(w.z); v1[1] *= bf_hi(w.z); v1[2] *= bf_lo(w.w); v1[3] *= bf_hi(w.w); }
__device__ __forceinline__ void add8(f32x4& v0, f32x4& v1, const u32x4 w) { v0[0] += bf_lo(w.x); v0[1] += bf_hi(w.x); v0[2] += bf_lo(w.y); v0[3] += bf_hi(w.y); v1[0] += bf_lo(w.z); v1[1] += bf_hi(w.z); v1[2] += bf_lo(w.w); v1[3] += bf_hi(w.w); }
template <bool ADD> struct EpiGate {
    static constexpr bool PERM = true, AFTER_DRAIN = false; bf16_t* O; const bf16_t* G; int ld;
    __device__ __forceinline__ void operator()(const f32x4 (&acc)[2][2][4][2], const Unit& u, int wr, int wc, int fr, int fq) const {
        const int row0 = u.pm * 256 + wr * 64 + fr, col0 = u.pn * 256 + wc * 32 + 8 * fq;
#pragma unroll
        for (int ai = 0; ai < 2; ++ai) {
            u32x4 gw[4][2], ow[4][2];
#pragma unroll
            for (int m = 0; m < 4; ++m)
#pragma unroll
                for (int bj = 0; bj < 2; ++bj) { const size_t off = (size_t)(row0 + ai * 128 + m * 16) * ld + col0 + bj * 128; gw[m][bj] = *(const u32x4*)(G + off); if (ADD) ow[m][bj] = *(const u32x4*)(O + off); }
#pragma unroll
            for (int m = 0; m < 4; ++m)
#pragma unroll
                for (int bj = 0; bj < 2; ++bj) { const size_t off = (size_t)(row0 + ai * 128 + m * 16) * ld + col0 + bj * 128; f32x4 v0 = acc[ai][bj][m][0], v1 = acc[ai][bj][m][1];
                    mul8(v0, v1, gw[m][bj]); if (ADD) add8(v0, v1, ow[m][bj]);
                    *(u32x4*)(O + off) = pack8(v0, v1); }
        }
    }
};
struct EpiSwiglu {
    static constexpr bool PERM = true, AFTER_DRAIN = false; bf16_t* O;
    __device__ __forceinline__ void operator()(const f32x4 (&acc)[2][2][4][2], const Unit& u, int wr, int wc, int fr, int fq) const {
        EPI_LOOP_BEGIN
            const int hid = u.pn * 128 + bj * 64 + wc * 16 + 4 * fq; (void)col;
            f32x4 o;
#pragma unroll
            for (int e = 0; e < 4; ++e) o[e] = v0[e] * fsigmoid(v0[e]) * v1[e];
            u32x2 w; w.x = cvt_pk_bf16(o[0], o[1]); w.y = cvt_pk_bf16(o[2], o[3]);
            *(u32x2*)(O + row * DFF + hid) = w;
        EPI_LOOP_END
    }
};
struct EpiSigMul {
    static constexpr bool PERM = true, AFTER_DRAIN = false; bf16_t* O;
    __device__ __forceinline__ void operator()(const f32x4 (&acc)[2][2][4][2], const Unit& u, int wr, int wc, int fr, int fq) const {
        const int row0 = u.pm * 256 + wr * 64 + fr, col0 = u.pn * 256 + wc * 32 + 8 * fq;
#pragma unroll
        for (int ai = 0; ai < 2; ++ai) {
            u32x4 ow[4][2];
#pragma unroll
            for (int m = 0; m < 4; ++m)
#pragma unroll
                for (int bj = 0; bj < 2; ++bj) ow[m][bj] = *(const u32x4*)(O + (size_t)(row0 + ai * 128 + m * 16) * DM + col0 + bj * 128);
#pragma unroll
            for (int m = 0; m < 4; ++m)
#pragma unroll
                for (int bj = 0; bj < 2; ++bj) { f32x4 v0 = acc[ai][bj][m][0], v1 = acc[ai][bj][m][1];
#pragma unroll
                    for (int e = 0; e < 4; ++e) { v0[e] = fsigmoid(v0[e]); v1[e] = fsigmoid(v1[e]); }
                    mul8(v0, v1, ow[m][bj]);
                    *(u32x4*)(O + (size_t)(row0 + ai * 128 + m * 16) * DM + col0 + bj * 128) = pack8(v0, v1); }
        }
    }
};

struct PanelOrder {
    int nN, pm;
    __device__ void init(int N, int pm_) { nN = N / 256; pm = pm_; }
    __device__ bool next(int i, Unit& u) const { if (i >= nN) return false; u.pm = pm; u.pn = i; return true; }
    __device__ __forceinline__ void a_ready(const Unit&) const {}
    __device__ __forceinline__ void done(const Unit&) const {}
};
template <int MODE> __device__ __forceinline__ void transpose_item(const float* W, int K, int N, bf16_t* WT, LAS float* scr, int item, int lane) {
    const int nblk = N / 32, kb = item / nblk, nb = item % nblk, k0 = 64 * kb, n0 = 32 * nb;
    float tv[32];
#pragma unroll
    for (int i = 0; i < 32; ++i) tv[i] = W[(size_t)(k0 + 2 * i + (lane >> 5)) * N + n0 + (lane & 31)];
#pragma unroll
    for (int i = 0; i < 32; ++i) scr[(2 * i + (lane >> 5)) * 33 + (lane & 31)] = tv[i];
    asm volatile("s_waitcnt lgkmcnt(0)" ::: "memory");
    const int c = lane & 7;
#pragma unroll
    for (int j = 0; j < 4; ++j) { const int n = (lane >> 3) + 8 * j; const LAS float* s = scr + (8 * c) * 33 + n;
        u32x4 o; o.x = cvt_pk_bf16(s[0 * 33], s[1 * 33]); o.y = cvt_pk_bf16(s[2 * 33], s[3 * 33]); o.z = cvt_pk_bf16(s[4 * 33], s[5 * 33]); o.w = cvt_pk_bf16(s[6 * 33], s[7 * 33]);
        const int ng = n0 + n; const int drow = (MODE == 0) ? ng : (256 * (ng >> 7) + 8 * ((ng & 127) >> 2) + (ng & 3) + 4 * (MODE - 1));
        *(u32x4*)(WT + (size_t)drow * K + k0 + 8 * c) = o; }
    asm volatile("s_waitcnt lgkmcnt(0)" ::: "memory");
}

struct Args { const float* in[28]; float* out; unsigned char* ws; int ph_lo, ph_hi; };

__device__ __forceinline__ void prologue(const __attribute__((address_space(4))) Args* ap, LAS unsigned char* lds, int gw, int NGW, int wave, int lane) {
    Args a;
    for (int i = 0; i < 28; ++i) a.in[i] = ap->in[i];
    a.out = ap->out; a.ws = ap->ws;
    unsigned char* ws = a.ws;
    LAS float* scr = (LAS float*)(lds + wave * 16384);
    constexpr int I_IN = 16 * (NIN / 32), I_SQ = 16 * 32, I_GU = 16 * (DFF / 32), I_DN = (DFF / 64) * 32, I_PI = 4 * 32;
    constexpr int NITEMS = I_IN + 4 * I_SQ + 2 * I_GU + I_DN + I_PI;
    for (int it = gw; it < NITEMS; it += NGW) {
        int r = it;
        if (r < I_IN) { transpose_item<0>(a.in[4], DM, NIN, (bf16_t*)(ws + WS_WIN), scr, r, lane); continue; } r -= I_IN;
        if (r < I_SQ) { transpose_item<0>(a.in[16], DM, DM, (bf16_t*)(ws + WS_WA), scr, r, lane); continue; } r -= I_SQ;
        if (r < I_SQ) { transpose_item<0>(a.in[17], DM, DM, (bf16_t*)(ws + WS_WB), scr, r, lane); continue; } r -= I_SQ;
        if (r < I_SQ) { transpose_item<0>(a.in[18], DM, DM, (bf16_t*)(ws + WS_WO), scr, r, lane); continue; } r -= I_SQ;
        if (r < I_SQ) { transpose_item<0>(a.in[27], DM, DM, (bf16_t*)(ws + WS_WPG), scr, r, lane); continue; } r -= I_SQ;
        if (r < I_GU) { transpose_item<1>(a.in[21], DM, DFF, (bf16_t*)(ws + WS_WGU), scr, r, lane); continue; } r -= I_GU;
        if (r < I_GU) { transpose_item<2>(a.in[22], DM, DFF, (bf16_t*)(ws + WS_WGU), scr, r, lane); continue; } r -= I_GU;
        if (r < I_DN) { transpose_item<0>(a.in[23], DFF, DM, (bf16_t*)(ws + WS_WDN), scr, r, lane); continue; } r -= I_DN;
        transpose_item<0>(a.in[26], PLE, DM, (bf16_t*)(ws + WS_WPIN), scr, r, lane);
    }
    const int gt = gw * 64 + lane, NGT = NGW * 64;
    { const float* wsrc = a.in[7]; bf16_t* d = (bf16_t*)(ws + WS_WSB);
      for (int e = gt; e < 8 * 128 * 128; e += NGT) { const int i = (e >> 7) & 127, j = e & 127; d[e] = ((j >> 6) <= (i >> 6)) ? f2bf(wsrc[e]) : (bf16_t)0; } }
    { bf16_t* d = (bf16_t*)(ws + WS_LRT); const float* cw = a.in[9];
      for (int e = gt; e < 2 * 16 * 4 * 64 * 64; e += NGT) { const int c = e & 63, j = (e >> 6) & 63, k = (e >> 12) & 3, hd = (e >> 14) & 15, which = e >> 18;
          const float* src = which ? a.in[13] : a.in[11]; d[e] = f2bf(cw[k * DM + hd * 64 + c] * src[hd * 4096 + c * 64 + j]); } }
    { float* d = (float*)(ws + WS_BIASP); const float* cb = a.in[10];
      for (int e = gw; e < 2 * DM; e += NGW) { const int which = e >> 10, ch = e & 1023, hd = ch >> 6, j = ch & 63; const float* w = (which ? a.in[13] : a.in[11]) + hd * 4096 + j;
          const float part = wave_sum(cb[hd * 64 + lane] * w[lane * 64]);
          if (lane == 0) d[e] = (which ? a.in[14] : a.in[12])[ch] + part; }
      for (int e = gt; e < DM; e += NGT) d[2 * DM + e] = 8.0f * 1.4426950408889634f * log1pf(expf(-a.in[15][e])); }
    { const f32x4* src = (const f32x4*)a.in[1]; u32x2* d = (u32x2*)(ws + WS_PB);
      for (int e = gt; e < M * PLE / 4; e += 4 * NGT) { f32x4 v[4];
#pragma unroll
          for (int i = 0; i < 4; ++i) v[i] = src[e + i * NGT < M * PLE / 4 ? e + i * NGT : e];
#pragma unroll
          for (int i = 0; i < 4; ++i) if (e + i * NGT < M * PLE / 4) { u32x2 w; w.x = cvt_pk_bf16(v[i][0], v[i][1]); w.y = cvt_pk_bf16(v[i][2], v[i][3]); d[e + i * NGT] = w; } } }
    { const float* x = a.in[0]; const float* g = a.in[2]; bf16_t* H = (bf16_t*)(ws + WS_H);
      f32x4 nx[4], gq[4];
#pragma unroll
      for (int j = 0; j < 4; ++j) { gq[j] = *(const f32x4*)(g + 256 * j + 4 * lane); nx[j] = *(const f32x4*)(x + (size_t)gw * DM + 256 * j + 4 * lane); }
      for (int m = gw; m < M; m += NGW) {
          f32x4 v[4]; float ss = 0.f;
#pragma unroll
          for (int j = 0; j < 4; ++j) { v[j] = nx[j]; ss += (v[j][0] * v[j][0] + v[j][1] * v[j][1]) + (v[j][2] * v[j][2] + v[j][3] * v[j][3]); }
          { const int mn = m + NGW < M ? m + NGW : m;
#pragma unroll
              for (int j = 0; j < 4; ++j) nx[j] = *(const f32x4*)(x + (size_t)mn * DM + 256 * j + 4 * lane); }
          const float rs = rsqrtf(wave_sum(ss) * (1.f / DM) + EPS);
#pragma unroll
          for (int j = 0; j < 4; ++j) { const f32x4 gg = gq[j]; u32x2 w; w.x = cvt_pk_bf16(v[j][0] * rs * gg[0], v[j][1] * rs * gg[1]); w.y = cvt_pk_bf16(v[j][2] * rs * gg[2], v[j][3] * rs * gg[3]);
              *(u32x2*)(H + (size_t)m * DM + 256 * j + 4 * lane) = w; }
      } }
}

template <bool XIN_BF16, bool XOUT_BF16>
__device__ __forceinline__ void norm_pass(const unsigned char* xin, size_t xin_pitch, const bf16_t* y, int ldy, const float* g1, unsigned char* xo, size_t xo_pitch, const float* g2, bf16_t* hn, int wave, int lane) {
    u32x4 yq[2], xb[2]; f32x4 xf[2][2];
    f32x4 G1[2][2], G2[2][2];
#pragma unroll
    for (int j = 0; j < 2; ++j) { const int c0 = 512 * j + 8 * lane; G1[j][0] = *(const f32x4*)(g1 + c0); G1[j][1] = *(const f32x4*)(g1 + c0 + 4);
        if (g2) { G2[j][0] = *(const f32x4*)(g2 + c0); G2[j][1] = *(const f32x4*)(g2 + c0 + 4); } else { G2[j][0] = G1[j][0]; G2[j][1] = G1[j][1]; } }
#define NP_LOAD(r_) do { _Pragma("unroll") for (int j = 0; j < 2; ++j) { const int c0 = 512 * j + 8 * lane; yq[j] = *(const u32x4*)(y + (size_t)(r_) * ldy + c0); \
        if (XIN_BF16) xb[j] = *(const u32x4*)(xin + (size_t)(r_) * xin_pitch + 2 * c0); \
        else { xf[j][0] = *(const f32x4*)(xin + (size_t)(r_) * xin_pitch + 4 * c0); xf[j][1] = *(const f32x4*)(xin + (size_t)(r_) * xin_pitch + 4 * c0 + 16); } } } while (0)
    NP_LOAD(wave);
    for (int r = wave; r < 256; r += NWAVES) {
        float yv[16], xv[16]; float ss = 0.f;
#pragma unroll
        for (int j = 0; j < 2; ++j) { const u32x4 w = yq[j];
            yv[8 * j + 0] = bf_lo(w.x); yv[8 * j + 1] = bf_hi(w.x); yv[8 * j + 2] = bf_lo(w.y); yv[8 * j + 3] = bf_hi(w.y); yv[8 * j + 4] = bf_lo(w.z); yv[8 * j + 5] = bf_hi(w.z); yv[8 * j + 6] = bf_lo(w.w); yv[8 * j + 7] = bf_hi(w.w);
            if (XIN_BF16) { const u32x4 a = xb[j];
                xv[8 * j + 0] = bf_lo(a.x); xv[8 * j + 1] = bf_hi(a.x); xv[8 * j + 2] = bf_lo(a.y); xv[8 * j + 3] = bf_hi(a.y); xv[8 * j + 4] = bf_lo(a.z); xv[8 * j + 5] = bf_hi(a.z); xv[8 * j + 6] = bf_lo(a.w); xv[8 * j + 7] = bf_hi(a.w);
            } else {
#pragma unroll
                for (int e = 0; e < 4; ++e) { xv[8 * j + e] = xf[j][0][e]; xv[8 * j + 4 + e] = xf[j][1][e]; } } }
        NP_LOAD(r + NWAVES < 256 ? r + NWAVES : r);
#pragma unroll
        for (int e = 0; e < 16; ++e) ss += yv[e] * yv[e];
        const float rs = rsqrtf(wave_sum(ss) * (1.f / DM) + EPS);
        float s2 = 0.f;
#pragma unroll
        for (int j = 0; j < 2; ++j) { const int c0 = 512 * j + 8 * lane; const f32x4 ga = G1[j][0], gb = G1[j][1];
#pragma unroll
            for (int e = 0; e < 4; ++e) { xv[8 * j + e] += yv[8 * j + e] * rs * ga[e]; xv[8 * j + 4 + e] += yv[8 * j + 4 + e] * rs * gb[e]; }
            if (XOUT_BF16) { *(u32x4*)(xo + (size_t)r * xo_pitch + 2 * c0) = pack8((f32x4){xv[8 * j], xv[8 * j + 1], xv[8 * j + 2], xv[8 * j + 3]}, (f32x4){xv[8 * j + 4], xv[8 * j + 5], xv[8 * j + 6], xv[8 * j + 7]});
#pragma unroll
                for (int e = 0; e < 8; ++e) xv[8 * j + e] = bf1(f2bf(xv[8 * j + e]));
            } else { *(f32x4*)(xo + (size_t)r * xo_pitch + 4 * c0) = (f32x4){xv[8 * j], xv[8 * j + 1], xv[8 * j + 2], xv[8 * j + 3]};
                *(f32x4*)(xo + (size_t)r * xo_pitch + 4 * c0 + 16) = (f32x4){xv[8 * j + 4], xv[8 * j + 5], xv[8 * j + 6], xv[8 * j + 7]}; } }
        if (hn) {
#pragma unroll
            for (int e = 0; e < 16; ++e) s2 += xv[e] * xv[e];
            const float r2 = rsqrtf(wave_sum(s2) * (1.f / DM) + EPS);
#pragma unroll
            for (int j = 0; j < 2; ++j) { const int c0 = 512 * j + 8 * lane; const f32x4 ga = G2[j][0], gb = G2[j][1];
                f32x4 o0, o1;
#pragma unroll
                for (int e = 0; e < 4; ++e) { o0[e] = xv[8 * j + e] * r2 * ga[e]; o1[e] = xv[8 * j + 4 + e] * r2 * gb[e]; }
                *(u32x4*)(hn + (size_t)r * DM + c0) = pack8(o0, o1); }
        }
    }
#undef NP_LOAD
}
#define LDS_BARRIER() do { asm volatile("s_waitcnt lgkmcnt(0)" ::: "memory"); __builtin_amdgcn_s_barrier(); asm volatile("" ::: "memory"); } while (0)
typedef short s16x4 __attribute__((ext_vector_type(4)));
__device__ __forceinline__ void mixerA_unit(LAS unsigned char* lds, int blk, const bf16_t* Z, bf16_t* AO, const bf16_t* WSB, const float* ln_g, const float* ln_b, const float* b_s) {
    const int tid = threadIdx.x, wave = __builtin_amdgcn_readfirstlane(tid >> 6), lane = tid & 63, fr = lane & 15, fq = lane >> 4;
    LAS float* st = (LAS float*)lds;
    LAS bf16_t* Wl = (LAS bf16_t*)(lds + 1024);
    LAS bf16_t* Vn = Wl + 128 * 136;
    const size_t row0 = (size_t)blk * 128;
    const int cc = tid & 15;
    u32x4 wq[4], vq[4]; f32x4 lg0, lg1, lb0, lb1;
#define MA_PREFETCH(g) do { _Pragma("unroll") for (int it = 0; it < 4; ++it) { const int q = tid + 512 * it; wq[it] = *(const u32x4*)(WSB + (g) * 16384 + (q >> 4) * 128 + (q & 15) * 8); \
        vq[it] = *(const u32x4*)(Z + (row0 + (tid >> 4) + 32 * it) * ZLD + ZSEC + (g) * 128 + cc * 8); } \
        lg0 = *(const f32x4*)(ln_g + (g) * 128 + cc * 8); lg1 = *(const f32x4*)(ln_g + (g) * 128 + cc * 8 + 4); lb0 = *(const f32x4*)(ln_b + (g) * 128 + cc * 8); lb1 = *(const f32x4*)(ln_b + (g) * 128 + cc * 8 + 4); } while (0)
    MA_PREFETCH(0);
#pragma unroll 8
    for (int rr = 0; rr < 16; ++rr) {
        const int r = 16 * wave + rr; const bf16_t* vp = Z + (row0 + r) * ZLD + ZSEC + lane * 16;
        const u32x4 w0 = *(const u32x4*)vp, w1 = *(const u32x4*)(vp + 8);
        float f[16] = {bf_lo(w0.x), bf_hi(w0.x), bf_lo(w0.y), bf_hi(w0.y), bf_lo(w0.z), bf_hi(w0.z), bf_lo(w0.w), bf_hi(w0.w), bf_lo(w1.x), bf_hi(w1.x), bf_lo(w1.y), bf_hi(w1.y), bf_lo(w1.z), bf_hi(w1.z), bf_lo(w1.w), bf_hi(w1.w)};
        float s = 0.f, q = 0.f;
#pragma unroll
        for (int e = 0; e < 16; ++e) { s += f[e]; q += f[e] * f[e]; }
#pragma unroll
        for (int o = 1; o < 64; o <<= 1) { s += __shfl_xor(s, o); q += __shfl_xor(q, o); }
        const float mean = s * (1.f / 1024.f); const float var = fmaxf(q * (1.f / 1024.f) - mean * mean, 0.f);
        if (lane == 0) { st[2 * r] = mean; st[2 * r + 1] = rsqrtf(var + EPS); }
    }
    LDS_BARRIER();
    const unsigned vaddr = (unsigned)(uintptr_t)(Vn + (8 * fq + (fr >> 2)) * 136 + 16 * wave + 4 * (fr & 3));
    for (int g = 0; g < 8; ++g) {
#pragma unroll
        for (int it = 0; it < 4; ++it) { const int q = tid + 512 * it; *(LAS u32x4*)(Wl + (q >> 4) * 136 + (q & 15) * 8) = wq[it]; }
#pragma unroll
        for (int it = 0; it < 4; ++it) { const int j = (tid >> 4) + 32 * it; const u32x4 w = vq[it]; const float mu = st[2 * j], rs = st[2 * j + 1];
            const f32x4 o0 = (f32x4){(bf_lo(w.x) - mu) * rs * lg0[0] + lb0[0], (bf_hi(w.x) - mu) * rs * lg0[1] + lb0[1], (bf_lo(w.y) - mu) * rs * lg0[2] + lb0[2], (bf_hi(w.y) - mu) * rs * lg0[3] + lb0[3]};
            const f32x4 o1 = (f32x4){(bf_lo(w.z) - mu) * rs * lg1[0] + lb1[0], (bf_hi(w.z) - mu) * rs * lg1[1] + lb1[1], (bf_lo(w.w) - mu) * rs * lg1[2] + lb1[2], (bf_hi(w.w) - mu) * rs * lg1[3] + lb1[3]};
            *(LAS u32x4*)(Vn + j * 136 + cc * 8) = pack8(o0, o1); }
        LDS_BARRIER();
        u32x2 uq[8]; float bsv[8];
#pragma unroll
        for (int it = 0; it < 8; ++it) { uq[it] = *(const u32x2*)(Z + (row0 + 16 * it + fr) * ZLD + g * 128 + 16 * wave + 4 * fq); bsv[it] = b_s[g * 128 + 16 * it + fr]; }
        asm volatile("" ::: "memory");
        MA_PREFETCH(g < 7 ? g + 1 : 7);
        s16x4 t00, t01, t10, t11, t20, t21, t30, t31;
        asm volatile("ds_read_b64_tr_b16 %0, %8\n\tds_read_b64_tr_b16 %1, %8 offset:1088\n\tds_read_b64_tr_b16 %2, %8 offset:8704\n\tds_read_b64_tr_b16 %3, %8 offset:9792\n\t"
                     "ds_read_b64_tr_b16 %4, %8 offset:17408\n\tds_read_b64_tr_b16 %5, %8 offset:18496\n\tds_read_b64_tr_b16 %6, %8 offset:26112\n\tds_read_b64_tr_b16 %7, %8 offset:27200\n\ts_waitcnt lgkmcnt(0)"
                     : "=&v"(t00), "=&v"(t01), "=&v"(t10), "=&v"(t11), "=&v"(t20), "=&v"(t21), "=&v"(t30), "=&v"(t31) : "v"(vaddr) : "memory");
        bf16x8 avk[4];
        avk[0] = __builtin_shufflevector(t00, t01, 0, 1, 2, 3, 4, 5, 6, 7); avk[1] = __builtin_shufflevector(t10, t11, 0, 1, 2, 3, 4, 5, 6, 7);
        avk[2] = __builtin_shufflevector(t20, t21, 0, 1, 2, 3, 4, 5, 6, 7); avk[3] = __builtin_shufflevector(t30, t31, 0, 1, 2, 3, 4, 5, 6, 7);
        f32x4 acc[8];
#pragma unroll
        for (int it = 0; it < 8; ++it) acc[it] = (f32x4){0.f, 0.f, 0.f, 0.f};
#pragma unroll
        for (int k = 0; k < 4; ++k) {
#pragma unroll
            for (int it = 0; it < 8; ++it) { if (it < 4 && k >= 2) continue;
                const bf16x8 bv = *(const LAS bf16x8*)(Wl + (16 * it + fr) * 136 + 32 * k + 8 * fq);
                acc[it] = __builtin_amdgcn_mfma_f32_16x16x32_bf16(avk[k], bv, acc[it], 0, 0, 0); } }
#pragma unroll
        for (int it = 0; it < 8; ++it) { const float bs = bsv[it]; const u32x2 uw = uq[it];
            u32x2 o; o.x = cvt_pk_bf16(bf_lo(uw.x) * (acc[it][0] + bs), bf_hi(uw.x) * (acc[it][1] + bs)); o.y = cvt_pk_bf16(bf_lo(uw.y) * (acc[it][2] + bs), bf_hi(uw.y) * (acc[it][3] + bs));
            *(u32x2*)(AO + (row0 + 16 * it + fr) * DM + g * 128 + 16 * wave + 4 * fq) = o; }
        LDS_BARRIER();
    }
#undef MA_PREFETCH
}

typedef float f32x16 __attribute__((ext_vector_type(16)));
__device__ __forceinline__ void mixerB_unit(LAS unsigned char* lds, int unit, const bf16_t* Z, bf16_t* BO, const bf16_t* LRT, const float* BIASP, const float* conv_w, const float* conv_b) {
    const int tid = threadIdx.x, wave = __builtin_amdgcn_readfirstlane(tid >> 6), lane = tid & 63, l31 = lane & 31, hh = lane >> 5;
    const int b = unit >> 5, hd = (unit >> 1) & 15, half = unit & 1, ch0 = hd * 64, jo = half * 32;
    const bool is_c = wave < 4;
    constexpr int NT = SEQ / 128;
    LAS bf16_t* wl = (LAS bf16_t*)lds;
    LAS bf16_t* xrl = (LAS bf16_t*)(lds + 36864);
    LAS float* cwl = (LAS float*)(lds + 74592);
    LAS float* alb = (LAS float*)(lds + 75616);
    LAS float* gil = (LAS float*)(lds + 112480);
    LAS float* sA = (LAS float*)(lds + 130912);
    LAS float* sH = sA + 256;
    LAS float* cry = sH + 256;
#pragma unroll
    for (int it = 0; it < 4; ++it) { const int q = tid + 512 * it, row = q >> 3, c8 = q & 7, gate = row >> 7, k = (row >> 5) & 3, j = row & 31;
        *(LAS u32x4*)(wl + row * 72 + c8 * 8) = *(const u32x4*)(LRT + ((size_t)((gate * 16 + hd) * 4 + k) * 64 + jo + j) * 64 + c8 * 8); }
    if (tid < 128) cwl[tid] = conv_w[(tid >> 5) * DM + ch0 + jo + (tid & 31)];
    else if (tid < 192) { const int wq = (tid - 128) >> 5, ch = ch0 + jo + (tid & 31); cwl[128 + (tid - 128)] = BIASP[wq * DM + ch]; cwl[192 + (tid - 128)] = wq ? conv_b[ch] : BIASP[2 * DM + ch]; }
    if (tid < 64) cry[tid] = 0.f;
    const int sid = tid & 255, sc = sid & 31, seg = sid >> 5;
    const bf16_t* xbase = Z + ((size_t)b * SEQ + (sid >> 3)) * ZLD + 2 * ZSEC + ch0 + (sid & 7) * 8;
    const bf16_t* xhalo = Z + ((size_t)b * SEQ + (sid < 24 ? (sid >> 3) : 0)) * ZLD + 2 * ZSEC + ch0 + (sid & 7) * 8 - (ptrdiff_t)3 * ZLD;
    const bf16_t* gbase = Z + ((size_t)b * SEQ + 16 * seg) * ZLD + 3 * ZSEC + ch0 + jo + sc;
    bf16_t* obase = BO + ((size_t)b * SEQ + 16 * seg) * DM + ch0 + jo + sc;
    u32x4 rq[4], hq; unsigned gy[16];
#define MB_LOAD_RAW(tile) do { const bf16_t* xp_ = xbase + (size_t)(tile) * 128 * ZLD; _Pragma("unroll") for (int it = 0; it < 4; ++it) rq[it] = *(const u32x4*)(xp_ + (size_t)(32 * it) * ZLD); \
        hq = *(const u32x4*)(xhalo + (size_t)((tile) > 0 ? (tile) : 1) * 128 * ZLD); } while (0)
#define MB_STORE_RAW(buf) do { LAS bf16_t* xd_ = xrl + (buf) * 9432; _Pragma("unroll") for (int it = 0; it < 4; ++it) *(LAS u32x4*)(xd_ + (3 + (sid >> 3) + 32 * it) * 72 + (sid & 7) * 8) = rq[it]; \
        if (sid < 24) *(LAS u32x4*)(xd_ + (sid >> 3) * 72 + (sid & 7) * 8) = hq; } while (0)
#define MB_LOAD_GY(tile) do { _Pragma("unroll") for (int s_ = 0; s_ < 16; ++s_) gy[s_] = (unsigned)gbase[((size_t)(tile) * 128 + s_) * ZLD]; } while (0)
    const int t_ = 32 * wave + l31;
#define MB_MFMA(GATE, buf, a0_, a1_) do { const LAS bf16_t* xs_ = xrl + (buf) * 9432; _Pragma("unroll") for (int e_ = 0; e_ < 16; ++e_) { a0_[e_] = 0.f; a1_[e_] = 0.f; } \
        _Pragma("unroll") for (int ks = 0; ks < 16; ks += 2) { \
            const bf16x8 w0_ = *(const LAS bf16x8*)(wl + (((GATE) * 4 + (ks >> 2)) * 32 + l31) * 72 + 16 * (ks & 3) + 8 * hh), x0_ = *(const LAS bf16x8*)(xs_ + (t_ + (ks >> 2)) * 72 + 16 * (ks & 3) + 8 * hh); \
            const bf16x8 w1_ = *(const LAS bf16x8*)(wl + (((GATE) * 4 + ((ks + 1) >> 2)) * 32 + l31) * 72 + 16 * ((ks + 1) & 3) + 8 * hh), x1_ = *(const LAS bf16x8*)(xs_ + (t_ + ((ks + 1) >> 2)) * 72 + 16 * ((ks + 1) & 3) + 8 * hh); \
            a0_ = __builtin_amdgcn_mfma_f32_32x32x16_bf16(w0_, x0_, a0_, 0, 0, 0); a1_ = __builtin_amdgcn_mfma_f32_32x32x16_bf16(w1_, x1_, a1_, 0, 0, 0); \
            if ((ks & 2) != 0) __builtin_amdgcn_sched_barrier(0); } \
        } while (0)
#define MB_EW_R(accA, accB, dst) do { const LAS float* bsl_ = cwl + 128; const LAS float* c2l_ = cwl + 192; \
        _Pragma("unroll") for (int i = 0; i < 4; ++i) { f32x4 o_; const f32x4 bs_ = *(const LAS f32x4*)(bsl_ + 8 * i + 4 * hh), c2_ = *(const LAS f32x4*)(c2l_ + 8 * i + 4 * hh); \
            _Pragma("unroll") for (int j = 0; j < 4; ++j) o_[j] = __builtin_amdgcn_exp2f(-c2_[j] * fsigmoid(((accA)[4 * i + j] + (accB)[4 * i + j]) + bs_[j])); \
            *(LAS f32x4*)((dst) + t_ * 36 + 8 * i + 4 * hh) = o_; } } while (0)
#define MB_EW_I(accA, accB, buf, dst) do { const LAS bf16_t* xs_ = xrl + (buf) * 9432; const LAS float* bsl_ = cwl + 160; const LAS float* c2l_ = cwl + 224; \
        _Pragma("unroll") for (int i = 0; i < 4; ++i) { f32x4 xc_ = *(const LAS f32x4*)(c2l_ + 8 * i + 4 * hh); const f32x4 bs_ = *(const LAS f32x4*)(bsl_ + 8 * i + 4 * hh); \
            _Pragma("unroll") for (int k = 0; k < 4; ++k) { const u32x2 w_ = *(const LAS u32x2*)(xs_ + (t_ + k) * 72 + jo + 8 * i + 4 * hh); const f32x4 cw_ = *(const LAS f32x4*)(cwl + k * 32 + 8 * i + 4 * hh); \
                xc_[0] += cw_[0] * bf_lo(w_.x); xc_[1] += cw_[1] * bf_hi(w_.x); xc_[2] += cw_[2] * bf_lo(w_.y); xc_[3] += cw_[3] * bf_hi(w_.y); } \
            f32x4 o_; \
            _Pragma("unroll") for (int j = 0; j < 4; ++j) o_[j] = fsigmoid(((accA)[4 * i + j] + (accB)[4 * i + j]) + bs_[j]) * xc_[j]; \
            *(LAS f32x4*)((dst) + t_ * 36 + 8 * i + 4 * hh) = o_; } } while (0)
    if (!is_c) { MB_LOAD_RAW(0); hq = (u32x4){0u, 0u, 0u, 0u}; MB_STORE_RAW(0); MB_LOAD_RAW(1); MB_STORE_RAW(1); MB_LOAD_RAW(2); MB_LOAD_GY(0); }
    LDS_BARRIER();
    f32x16 accR0, accR1, accI0, accI1;
    if (is_c) { MB_MFMA(0, 0, accR0, accR1); MB_MFMA(1, 0, accI0, accI1); MB_EW_R(accR0, accR1, alb); MB_EW_I(accI0, accI1, 0, gil); MB_MFMA(0, 1, accR0, accR1); }
    LDS_BARRIER();
    float a16[16], g16[16];
    for (int tile = 0; tile < NT; ++tile) {
        if (is_c) { MB_MFMA(1, (tile + 1) & 1, accI0, accI1); MB_EW_R(accR0, accR1, alb + ((tile + 1) & 1) * 4608); }
        else {
            const LAS float* al = alb + (tile & 1) * 4608; float A = 1.f, Hh = 0.f;
#pragma unroll
            for (int s = 0; s < 16; ++s) { const float av = al[(16 * seg + s) * 36 + sc]; a16[s] = av; g16[s] = __builtin_amdgcn_sqrtf(fmaxf(1.0f - av * av, 0.f)) * gil[(16 * seg + s) * 36 + sc]; A *= av; Hh = av * Hh + g16[s]; }
            sA[seg * 32 + sc] = A; sH[seg * 32 + sc] = Hh;
            MB_STORE_RAW(tile & 1);
            MB_LOAD_RAW(tile + 3 < NT ? tile + 3 : NT - 1);
        }
        LDS_BARRIER();
        if (is_c) { MB_MFMA(0, tile & 1, accR0, accR1); MB_EW_I(accI0, accI1, (tile + 1) & 1, gil); }
        else {
            float h = cry[(tile & 1) * 32 + sc];
#pragma unroll
            for (int s = 0; s < 7; ++s) { const float As = sA[s * 32 + sc], Hs = sH[s * 32 + sc]; h = (s < seg) ? As * h + Hs : h; }
            bf16_t* op = obase + (size_t)tile * 128 * DM;
#pragma unroll
            for (int s = 0; s < 16; ++s) { h = a16[s] * h + g16[s]; op[(size_t)s * DM] = f2bf(h * __builtin_bit_cast(float, gy[s] << 16)); }
            if (seg == 7) cry[((tile + 1) & 1) * 32 + sc] = h;
            MB_LOAD_GY(tile + 1 < NT ? tile + 1 : NT - 1);
        }
        LDS_BARRIER();
    }
#undef MB_LOAD_RAW
#undef MB_STORE_RAW
#undef MB_LOAD_GY
#undef MB_MFMA
#undef MB_EW_R
#undef MB_EW_I
}

__device__ __forceinline__ void grid_barrier(unsigned* bar) {
    asm volatile("s_waitcnt vmcnt(0)" ::: "memory");
    __syncthreads();
    if (threadIdx.x == 0) {
        __builtin_amdgcn_fence(__ATOMIC_RELEASE, "agent");
        const unsigned G = gridDim.x;
        const unsigned old = __hip_atomic_fetch_add(bar, 1u, __ATOMIC_RELAXED, __HIP_MEMORY_SCOPE_AGENT);
        const unsigned target = (old / G + 1u) * G;
        while (__hip_atomic_load(bar, __ATOMIC_RELAXED, __HIP_MEMORY_SCOPE_AGENT) < target) __builtin_amdgcn_s_sleep(2);
        __builtin_amdgcn_fence(__ATOMIC_ACQUIRE, "agent");
        asm volatile("s_waitcnt vmcnt(0)" ::: "memory");
    }
    __syncthreads();
}
typedef const __attribute__((address_space(4))) Args* KArgs;
__device__ __forceinline__ KArgs kargs() {
#if defined(__HIP_DEVICE_COMPILE__)
    auto p0 = __builtin_amdgcn_kernarg_segment_ptr(); KArgs p = (KArgs)p0; asm volatile("" : "+s"(p)); return p;
#else
    return nullptr;
#endif
}
constexpr int NPHASE = 12;
__global__ void __launch_bounds__(NTHR, 2) fwd_kernel(Args args) {
    extern __shared__ __attribute__((aligned(16))) unsigned char lds_raw[];
    LAS unsigned char* lds = (LAS unsigned char*)lds_raw;
    const int lo = args.ph_lo, hi = args.ph_hi;
#define IN(k) (lo <= (k) && (k) < hi)
#define SEAM(k) do { if (IN(k) && IN((k) + 1)) { if ((k) == 0) cg::this_grid().sync(); else grid_barrier((unsigned*)kargs()->ws); } } while (0)
#define PH KArgs ka = kargs(); unsigned char* ws = ka->ws; bf16_t* Z = (bf16_t*)(ws + WS_Z); bf16_t* H = (bf16_t*)(ws + WS_H); const int G = gridDim.x, bx = blockIdx.x; (void)Z; (void)H; (void)G; (void)bx;
#define WV const int lane = threadIdx.x & 63, wave = __builtin_amdgcn_readfirstlane(threadIdx.x >> 6);
    typedef pg8::StaticOrder SO;
    typedef PanelOrder PO;
    if (IN(0)) { PH WV prologue(ka, lds, bx * NWAVES + wave, G * NWAVES, wave, lane); __syncthreads(); }
    SEAM(0);
    if (IN(1)) { PH pg8::Gemm g{H, (const bf16_t*)(ws + WS_WIN), M, NIN, DM, DM}; SO S; S.init(M, NIN, G, bx); EpiZ E{Z};
        pg8::gemm_phase<EpiZ, SO, true, true>(lds, g, S, E); }
    SEAM(1);
    if (IN(2)) { PH mixerB_unit(lds, ((((bx >> 4) << 3) | (bx & 7)) << 1) | ((bx >> 3) & 1), Z, (bf16_t*)ka->out + (size_t)M * DM, (const bf16_t*)(ws + WS_LRT), (const float*)(ws + WS_BIASP), ka->in[9], ka->in[10]); }
    if (IN(3)) { PH for (int u = bx; u < M / 128; u += G) mixerA_unit(lds, u, Z, (bf16_t*)ka->out, (const bf16_t*)(ws + WS_WSB), ka->in[5], ka->in[6], ka->in[8]); }
    SEAM(3);
    if (IN(4)) { PH
        { SO S; S.init(M, DM, G, bx); pg8::Gemm g{(const bf16_t*)ka->out, (const bf16_t*)(ws + WS_WA), M, DM, DM, DM}; EpiGate<false> E{Z + ZSEC, Z + 4 * ZSEC, ZLD}; pg8::gemm_phase<EpiGate<false>, SO, true, true>(lds, g, S, E); }
        __syncthreads();
        { SO S; S.init(M, DM, G, bx); pg8::Gemm g{(const bf16_t*)ka->out + (size_t)M * DM, (const bf16_t*)(ws + WS_WB), M, DM, DM, DM}; EpiGate<true> E{Z + ZSEC, Z + 5 * ZSEC, ZLD}; pg8::gemm_phase<EpiGate<true>, SO, true, true>(lds, g, S, E); }
        __syncthreads();
    }
    SEAM(4);
    if (IN(5)) { PH PO S; S.init(DM, bx); pg8::Gemm g{Z + ZSEC, (const bf16_t*)(ws + WS_WO), M, DM, DM, ZLD}; EpiPlain E{Z + 2 * ZSEC, ZLD}; pg8::gemm_phase<EpiPlain, PO, true, true>(lds, g, S, E); __syncthreads(); }
    if (IN(6)) { PH WV norm_pass<false, true>((const unsigned char*)(ka->in[0] + (size_t)bx * 256 * DM), (size_t)DM * 4, Z + 2 * ZSEC + (size_t)bx * 256 * ZLD, ZLD, ka->in[3], (unsigned char*)ka->out + ((size_t)bx << 20), (size_t)DM * 2, ka->in[19], H + (size_t)bx * 256 * DM, wave, lane); }
    SEAM(6);
    if (IN(7)) { PH pg8::Gemm g{H, (const bf16_t*)(ws + WS_WGU), M, NGU, DM, DM}; SO S; S.init(M, NGU, G, bx); EpiSwiglu E{(bf16_t*)(ws + WS_ACT)};
        pg8::gemm_phase<EpiSwiglu, SO, true, true>(lds, g, S, E); }
    SEAM(7);
    if (IN(8)) { PH pg8::Gemm g{(const bf16_t*)(ws + WS_ACT), (const bf16_t*)(ws + WS_WDN), M, DM, DFF, DFF}; SO S; S.init(M, DM, G, bx); EpiPlain E{(bf16_t*)(ws + WS_F), DM};
        pg8::gemm_phase<EpiPlain, SO, true, true>(lds, g, S, E); }
    SEAM(8);
    if (IN(9)) { PH WV bf16_t* F = (bf16_t*)(ws + WS_F) + (size_t)bx * 256 * DM; norm_pass<true, true>((const unsigned char*)ka->out + ((size_t)bx << 20), (size_t)DM * 2, F, DM, ka->in[20], (unsigned char*)F, (size_t)DM * 2, ka->in[24], H + (size_t)bx * 256 * DM, wave, lane); __syncthreads(); }
    if (IN(10)) { PH
        { PO S; S.init(DM, bx); pg8::Gemm g{(const bf16_t*)(ws + WS_PB), (const bf16_t*)(ws + WS_WPIN), M, DM, PLE, PLE}; EpiPlain E{(bf16_t*)(ws + WS_GE), DM}; pg8::gemm_phase<EpiPlain, PO, true, true>(lds, g, S, E); }
        __syncthreads();
        { PO S; S.init(DM, bx); pg8::Gemm g{H, (const bf16_t*)(ws + WS_WPG), M, DM, DM, DM}; EpiSigMul E{(bf16_t*)(ws + WS_GE)}; pg8::gemm_phase<EpiSigMul, PO, true, true>(lds, g, S, E); }
        __syncthreads();
    }
    if (IN(11)) { PH WV norm_pass<true, false>((const unsigned char*)(ws + WS_F) + (size_t)bx * 256 * DM * 2, (size_t)DM * 2, (const bf16_t*)(ws + WS_GE) + (size_t)bx * 256 * DM, DM, ka->in[25], (unsigned char*)(ka->out + (size_t)bx * 256 * DM), (size_t)DM * 4, nullptr, nullptr, wave, lane); }
#undef PH
#undef WV
#undef IN
#undef SEAM
}

extern "C" void kernel_launch(void* const* d_in, const int* in_sizes, int n_in, void* d_out, int out_size, void* d_ws, size_t ws_size, hipStream_t stream) {
    static int grid = 0;
    if (grid == 0) {
        if (n_in != 28 || in_sizes[0] != M * DM || out_size != M * DM || ws_size < WS_END) { fprintf(stderr, "kernel_launch: unexpected shapes (n_in %d, in0 %d, out %d, ws %zu)\n", n_in, n_in > 0 ? in_sizes[0] : -1, out_size, ws_size); grid = -1; return; }
        int dev = 0, cus = 0, per_cu = 0;
        if (hipGetDevice(&dev) != hipSuccess || hipDeviceGetAttribute(&cus, hipDeviceAttributeMultiprocessorCount, dev) != hipSuccess) { grid = -1; return; }
        if (hipFuncSetAttribute((const void*)fwd_kernel, hipFuncAttributeMaxDynamicSharedMemorySize, LDS_BYTES) != hipSuccess) { fprintf(stderr, "kernel_launch: hipFuncSetAttribute failed\n"); grid = -1; return; }
        if (hipOccupancyMaxActiveBlocksPerMultiprocessor(&per_cu, (const void*)fwd_kernel, NTHR, LDS_BYTES) != hipSuccess || per_cu < 1) { fprintf(stderr, "kernel_launch: occupancy query says %d\n", per_cu); per_cu = 1; }
        (void)hipGetLastError();
        grid = cus * 1;
        if (grid != M / 256) { fprintf(stderr, "kernel_launch: built for a 256-CU device (one workgroup per 256-row panel); got %d CUs\n", cus); grid = -1; return; }
    }
    if (grid < 0) return;
    if (hipMemsetAsync(d_ws, 0, 256, stream) != hipSuccess) { fprintf(stderr, "kernel_launch: memset failed\n"); return; }
    Args a{};
    for (int i = 0; i < 28; ++i) a.in[i] = (const float*)d_in[i];
    a.out = (float*)d_out; a.ws = (unsigned char*)d_ws;
#if MK_ONE
    a.ph_lo = 0; a.ph_hi = NPHASE;
    void* kargs[] = {&a};
    hipError_t e = hipLaunchCooperativeKernel((const void*)fwd_kernel, dim3(grid), dim3(NTHR), kargs, LDS_BYTES, stream);
    if (e != hipSuccess) fprintf(stderr, "kernel_launch: cooperative launch failed: %s (grid %d)\n", hipGetErrorString(e), grid);
#else
    for (int k = 0; k < NPHASE; ++k) for (int rep = 0; rep < 1 + ((REP_MASK >> k) & 1); ++rep) { a.ph_lo = k; a.ph_hi = k + 1; hipLaunchKernelGGL(fwd_kernel, dim3(grid), dim3(NTHR), LDS_BYTES, stream, a); }
#endif
}
```

```cpp
#include <hip/hip_runtime.h>
#include <hip/hip_cooperative_groups.h>
#include <cstdio>
#include <cstdint>
namespace cg = cooperative_groups;
#ifndef REP_MASK
#define REP_MASK 0
#endif
#ifndef MK_ONE
#define MK_ONE 1
#endif
namespace pg8 {
#define PG8_LAS __attribute__((address_space(3)))
typedef unsigned short bf16_t;
typedef short bf16x8 __attribute__((ext_vector_type(8)));
typedef float f32x4 __attribute__((ext_vector_type(4)));
typedef unsigned u32x4 __attribute__((ext_vector_type(4)));
constexpr int BM = 256, BK = 64, HALF = 128, HTB = HALF * BK * 2  , STAGE_BYTES = 8 * HTB, NXCD = 8, WGM = 8;

__host__ __device__ __forceinline__ int lds_byte(int r, int c) { const int st = (r >> 4) * 2 + (c >> 5), rr = r & 15, cc = c & 31, ob = rr * 64 + cc * 2; return st * 1024 + (ob ^ (((ob >> 9) & 1) << 5)); }
__host__ __device__ __forceinline__ void stage_rc(int b, int& R, int& C) { const int st = b / 1024, sb = b % 1024, swz = sb ^ (((sb >> 9) & 1) << 5); R = (st >> 1) * 16 + swz / 64; C = (st & 1) * 32 + (swz % 64) / 2; }
__host__ __device__ __forceinline__ int perm32(int rho) { const int n = rho >> 4, i = rho & 15; return 8 * (i >> 2) + 4 * n + (i & 3); }

struct Unit { int pm, pn; };
struct Gemm { const bf16_t* A; const bf16_t* Bt; int M, N, K, lda; };

struct StaticOrder {
    int nM, nN, nwg, G, c;
    __host__ __device__ void init(int M, int N, int G_, int c_) { nM = M / BM; nN = N / BM; nwg = nM * nN; G = G_; c = c_; }
    __host__ __device__ bool next(int i, Unit& u) const {
        const long L = (long)i * G + c; if (L >= nwg) return false;
        int wgid = (int)L; { const int q = nwg / NXCD, r = nwg % NXCD, xcd = wgid % NXCD, off = wgid / NXCD; wgid = (xcd < r ? xcd * (q + 1) : r * (q + 1) + (xcd - r) * q) + off; }
        const int nig = WGM * nN, gid = wgid / nig, fm = gid * WGM, gsz = (nM - fm) < WGM ? (nM - fm) : WGM;
        u.pm = fm + ((wgid % nig) % gsz); u.pn = (wgid % nig) / gsz; return true;
    }
    __device__ __forceinline__ void a_ready(const Unit&) const {}
    __device__ __forceinline__ void done(const Unit&) const {}
};

__device__ __forceinline__ unsigned cvt_pk_bf16(float lo, float hi) { unsigned r; asm volatile("v_cvt_pk_bf16_f32 %0, %1, %2" : "=v"(r) : "v"(lo), "v"(hi)); return r; }
typedef float f32x2 __attribute__((ext_vector_type(2)));
template <class Epi, class Sched, bool ALIGN_EPI = false, bool SP2 = false>
__device__ __forceinline__ void gemm_phase(PG8_LAS unsigned char* lds, const Gemm g, const Sched& S, const Epi& E) {
    const int tid = threadIdx.x, wid = __builtin_amdgcn_readfirstlane(tid >> 6), lane = tid & 63, wr = wid >> 2, wc = wid & 3, fr = lane & 15, fq = lane >> 4;
    const int K = g.K, nt = K / BK;
    unsigned voffA[2], voffB[2];
#pragma unroll
    for (int i = 0; i < 2; ++i) { int R, C; stage_rc(tid * 16 + i * 8192, R, C); const int Rb = Epi::PERM ? ((R & ~31) + perm32(R & 31)) : R;
        voffA[i] = (unsigned)(R * g.lda + C) * 2u; voffB[i] = (unsigned)(Rb * K + C) * 2u; }
    const size_t kstep = (size_t)(BK * 2);
    const size_t hstepA = (size_t)HALF * g.lda * 2, hstepB = (size_t)HALF * K * 2;
    const size_t tstepA = 2 * hstepA, tstepB = 2 * hstepB;
    const unsigned ldsw = (unsigned)wid * 1024u;
    const int aoff = lds_byte(wr * 64 + fr, fq * 8), boff = lds_byte(wc * 32 + fr, fq * 8);
#define PG8_SA(b, h) (((b) * 2 + (h)) * HTB)
#define PG8_SB(b, h) ((4 + (b) * 2 + (h)) * HTB)
#define PG8_STAGE(bufoff, gbase, voff) do { _Pragma("unroll") for (int _i = 0; _i < 2; ++_i) \
        __builtin_amdgcn_global_load_lds((const unsigned*)((const char*)(gbase) + (voff)[_i]), (PG8_LAS unsigned*)(lds + (bufoff) + ldsw + _i * 8192), 16, 0, 0); } while (0)
#define PG8_LDA(dst, b, h) do { _Pragma("unroll") for (int m = 0; m < 4; ++m) _Pragma("unroll") for (int k = 0; k < 2; ++k) dst[m][k] = *(const PG8_LAS bf16x8*)(lds + PG8_SA(b, h) + aoff + m * 2048 + k * 1024); } while (0)
#define PG8_LDB(dst, b, h) do { _Pragma("unroll") for (int n = 0; n < 2; ++n) _Pragma("unroll") for (int k = 0; k < 2; ++k) dst[n][k] = *(const PG8_LAS bf16x8*)(lds + PG8_SB(b, h) + boff + n * 2048 + k * 1024); } while (0)
#define PG8_MMA(ai, bj, At, Bt) do { __builtin_amdgcn_s_setprio(1); _Pragma("unroll") for (int m = 0; m < 4; ++m) _Pragma("unroll") for (int n = 0; n < 2; ++n) _Pragma("unroll") for (int k = 0; k < 2; ++k) \
        acc[ai][bj][m][n] = __builtin_amdgcn_mfma_f32_16x16x32_bf16(Bt[n][k], At[m][k], acc[ai][bj][m][n], 0, 0, 0); __builtin_amdgcn_s_setprio(0); } while (0)
#define PG8_WAIT_V(n) asm volatile("s_waitcnt vmcnt(" #n ")" ::: "memory")
#define PG8_WAIT_L(n) asm volatile("s_waitcnt lgkmcnt(" #n ")" ::: "memory")
#define PG8_BAR __builtin_amdgcn_s_barrier()
#define PG8_SCHED __builtin_amdgcn_sched_barrier(0)
    Unit cur, nxt; int ui = 0;
    if (!S.next(0, cur)) return;
    f32x4 acc[2][2][4][2];
#pragma unroll
    for (int a = 0; a < 2; ++a)
#pragma unroll
        for (int b = 0; b < 2; ++b)
#pragma unroll
            for (int m = 0; m < 4; ++m)
#pragma unroll
                for (int n = 0; n < 2; ++n) acc[a][b][m][n] = (f32x4){0.f, 0.f, 0.f, 0.f};
    bf16x8 At[4][2], B0[2][2], B1[2][2];
    const char* cA = (const char*)g.A + (size_t)cur.pm * tstepA; const char* cB = (const char*)g.Bt + (size_t)cur.pn * tstepB;
    S.a_ready(cur);
    if constexpr (SP2) {
        PG8_STAGE(PG8_SB(0, 0), cB, voffB); PG8_STAGE(PG8_SB(0, 1), cB + hstepB, voffB); PG8_STAGE(PG8_SA(0, 0), cA, voffA); PG8_STAGE(PG8_SA(0, 1), cA + hstepA, voffA);
        if (wr == 1) PG8_BAR;
        PG8_WAIT_V(2); PG8_BAR;
        PG8_STAGE(PG8_SB(1, 0), cB + kstep, voffB); PG8_STAGE(PG8_SA(1, 0), cA + kstep, voffA); PG8_STAGE(PG8_SB(1, 1), cB + hstepB + kstep, voffB);
        PG8_WAIT_V(6); PG8_BAR;
    } else {
        PG8_STAGE(PG8_SB(0, 0), cB, voffB); PG8_STAGE(PG8_SA(0, 0), cA, voffA); PG8_STAGE(PG8_SB(0, 1), cB + hstepB, voffB); PG8_STAGE(PG8_SA(0, 1), cA + hstepA, voffA);
        if (wr == 1) PG8_BAR;
        PG8_WAIT_V(4); PG8_BAR;
        PG8_STAGE(PG8_SB(1, 0), cB + kstep, voffB); PG8_STAGE(PG8_SA(1, 0), cA + kstep, voffA); PG8_STAGE(PG8_SB(1, 1), cB + hstepB + kstep, voffB);
        PG8_WAIT_V(6); PG8_BAR;
    }
    for (;;) {
        const bool has_next = S.next(ui + 1, nxt);
        const char* nA = has_next ? (const char*)g.A + (size_t)nxt.pm * tstepA : cA; const char* nB = has_next ? (const char*)g.Bt + (size_t)nxt.pn * tstepB : cB;
        for (int t = 0; t < nt; t += 2) {
            const bool last = (t == nt - 2);
            const char* a1 = cA + (size_t)(t + 1) * kstep;
            const char* a2 = last ? nA : cA + (size_t)(t + 2) * kstep; const char* b2 = last ? nB : cB + (size_t)(t + 2) * kstep;
            const char* a3 = a2 + kstep; const char* b3 = b2 + kstep;
            if (last && has_next) S.a_ready(nxt);
            if constexpr (SP2) {
            PG8_LDB(B0, 0, 0); PG8_LDB(B1, 0, 1); PG8_SCHED; PG8_LDA(At, 0, 0); PG8_STAGE(PG8_SA(1, 1), a1 + hstepA, voffA);
            PG8_WAIT_V(8); PG8_WAIT_L(0); PG8_BAR; PG8_MMA(0, 0, At, B0); PG8_MMA(0, 1, At, B1); PG8_BAR; PG8_SCHED;
            PG8_LDA(At, 0, 1); PG8_STAGE(PG8_SB(0, 0), b2, voffB); PG8_STAGE(PG8_SB(0, 1), b2 + hstepB, voffB); PG8_STAGE(PG8_SA(0, 0), a2, voffA);
            PG8_WAIT_V(8); PG8_WAIT_L(0); PG8_BAR; PG8_MMA(1, 0, At, B0); PG8_MMA(1, 1, At, B1); PG8_BAR; PG8_SCHED;
            PG8_LDB(B0, 1, 0); PG8_LDB(B1, 1, 1); PG8_SCHED; PG8_LDA(At, 1, 0); PG8_STAGE(PG8_SA(0, 1), a2 + hstepA, voffA);
            PG8_WAIT_V(8); PG8_WAIT_L(0); PG8_BAR; PG8_MMA(0, 0, At, B0); PG8_MMA(0, 1, At, B1); PG8_BAR; PG8_SCHED;
            PG8_LDA(At, 1, 1); PG8_STAGE(PG8_SB(1, 0), b3, voffB); PG8_STAGE(PG8_SB(1, 1), b3 + hstepB, voffB); PG8_STAGE(PG8_SA(1, 0), a3, voffA);
            PG8_WAIT_V(8); PG8_WAIT_L(0); PG8_BAR; PG8_MMA(1, 0, At, B0); PG8_MMA(1, 1, At, B1); PG8_BAR; PG8_SCHED;
            } else {
            PG8_LDB(B0, 0, 0); PG8_SCHED; PG8_LDA(At, 0, 0); PG8_STAGE(PG8_SA(1, 1), a1 + hstepA, voffA);
            PG8_WAIT_L(8); PG8_BAR; PG8_WAIT_L(0); PG8_MMA(0, 0, At, B0); PG8_BAR; PG8_SCHED;
            PG8_LDB(B1, 0, 1); PG8_STAGE(PG8_SB(0, 0), b2, voffB);
            PG8_BAR; PG8_WAIT_L(0); PG8_MMA(0, 1, At, B1); PG8_BAR;
            PG8_LDA(At, 0, 1); PG8_STAGE(PG8_SA(0, 0), a2, voffA);
            PG8_BAR; PG8_WAIT_L(0); PG8_MMA(1, 0, At, B0); PG8_BAR; PG8_SCHED;
            PG8_STAGE(PG8_SB(0, 1), b2 + hstepB, voffB);
            PG8_WAIT_V(6); PG8_BAR; PG8_MMA(1, 1, At, B1); PG8_BAR;
            PG8_LDB(B0, 1, 0); PG8_SCHED; PG8_LDA(At, 1, 0); PG8_STAGE(PG8_SA(0, 1), a2 + hstepA, voffA);
            PG8_WAIT_L(8); PG8_BAR; PG8_WAIT_L(0); PG8_MMA(0, 0, At, B0); PG8_BAR; PG8_SCHED;
            PG8_LDB(B1, 1, 1); PG8_STAGE(PG8_SB(1, 0), b3, voffB);
            PG8_BAR; PG8_WAIT_L(0); PG8_MMA(0, 1, At, B1); PG8_BAR;
            PG8_LDA(At, 1, 1); PG8_STAGE(PG8_SA(1, 0), a3, voffA);
            PG8_BAR; PG8_WAIT_L(0); PG8_MMA(1, 0, At, B0); PG8_BAR; PG8_SCHED;
            PG8_STAGE(PG8_SB(1, 1), b3 + hstepB, voffB);
            PG8_WAIT_V(6); PG8_BAR; PG8_MMA(1, 1, At, B1); PG8_BAR;
            }
        }
        if constexpr (ALIGN_EPI) { if (wr == 0) PG8_BAR; }
        if constexpr (!Epi::AFTER_DRAIN) { E(acc, cur, wr, wc, fr, fq); S.done(cur); }
        if (!has_next) break;
#pragma unroll
        for (int a = 0; a < 2; ++a)
#pragma unroll
            for (int b = 0; b < 2; ++b)
#pragma unroll
                for (int m = 0; m < 4; ++m)
#pragma unroll
                    for (int n = 0; n < 2; ++n) acc[a][b][m][n] = (f32x4){0.f, 0.f, 0.f, 0.f};
        cur = nxt; cA = nA; cB = nB; ++ui;
        if constexpr (ALIGN_EPI) { if (wr == 1) PG8_BAR; }
    }
    PG8_WAIT_V(0);
    if constexpr (!ALIGN_EPI) { if (wr == 0) PG8_BAR; }
    PG8_BAR;
    if constexpr (Epi::AFTER_DRAIN) { E.fused(acc, cur, wr, wc, fr, fq, lds, wid, lane); S.done(cur); }
#undef PG8_SA
#undef PG8_SB
#undef PG8_STAGE
#undef PG8_LDA
#undef PG8_LDB
#undef PG8_MMA
#undef PG8_WAIT_V
#undef PG8_WAIT_L
#undef PG8_BAR
#undef PG8_SCHED
}
}
using pg8::bf16_t; using pg8::bf16x8; using pg8::f32x4; using pg8::u32x4; using pg8::Unit; using pg8::cvt_pk_bf16;
#define LAS __attribute__((address_space(3)))
typedef unsigned u32x2 __attribute__((ext_vector_type(2)));

constexpr int DM = 1024, BATCH = 8, SEQ = 8192, M = BATCH * SEQ, NIN = 6144, DFF = 2816, NGU = 2 * DFF, PLE = 256, ZLD = 1024;
constexpr size_t ZSEC = (size_t)M * 1024;
constexpr float EPS = 1e-6f;
constexpr size_t MiB = 1u << 20;
constexpr size_t WS_WIN = 1 * MiB, WS_WA = 13 * MiB, WS_WB = 15 * MiB, WS_WO = 17 * MiB, WS_WPG = 19 * MiB, WS_WGU = 21 * MiB, WS_WDN = 32 * MiB, WS_WPIN = 38 * MiB;
constexpr size_t WS_WSB = 38 * MiB + 512 * 1024, WS_BIASP = 38 * MiB + 768 * 1024, WS_LRT = 39 * MiB;
constexpr size_t WS_PB = 40 * MiB, WS_H = 72 * MiB, WS_Z = 200 * MiB, WS_ACT = 200 * MiB, WS_F = 552 * MiB, WS_GE = 680 * MiB, WS_END = 968 * MiB;
constexpr int NWAVES = 8, NTHR = 512, LDS_BYTES = 147456;

__device__ __forceinline__ float bf_lo(unsigned w) { return __builtin_bit_cast(float, w << 16); }
__device__ __forceinline__ float bf_hi(unsigned w) { return __builtin_bit_cast(float, w & 0xffff0000u); }
__device__ __forceinline__ float bf1(unsigned short h) { return __builtin_bit_cast(float, ((unsigned)h) << 16); }
__device__ __forceinline__ unsigned short f2bf(float f) { unsigned u = __builtin_bit_cast(unsigned, f); return (unsigned short)((u + 0x7fffu + ((u >> 16) & 1u)) >> 16); }
__device__ __forceinline__ float fsigmoid(float x) { return __builtin_amdgcn_rcpf(1.0f + __builtin_amdgcn_exp2f(-1.4426950408889634f * x)); }
__device__ __forceinline__ float fgelu(float x) { const float u = x * (0.7978845608028654f + 0.035677408136300125f * x * x); return x * __builtin_amdgcn_rcpf(1.0f + __builtin_amdgcn_exp2f(-2.8853900817779268f * u)); }
__device__ __forceinline__ float wave_sum(float v) {
#pragma unroll
    for (int o = 1; o < 64; o <<= 1) v += __shfl_xor(v, o);
    return v;
}

#define EPI_LOOP_BEGIN \
    const int row0 = u.pm * 256 + wr * 64 + fr, col0 = u.pn * 256 + wc * 32 + 8 * fq; \
    _Pragma("unroll") for (int ai = 0; ai < 2; ++ai) _Pragma("unroll") for (int m = 0; m < 4; ++m) { const size_t row = (size_t)(row0 + ai * 128 + m * 16); \
    _Pragma("unroll") for (int bj = 0; bj < 2; ++bj) { const int col = col0 + bj * 128; f32x4 v0 = acc[ai][bj][m][0], v1 = acc[ai][bj][m][1];
#define EPI_LOOP_END } }
__device__ __forceinline__ u32x4 pack8(f32x4 v0, f32x4 v1) { u32x4 w; w.x = cvt_pk_bf16(v0[0], v0[1]); w.y = cvt_pk_bf16(v0[2], v0[3]); w.z = cvt_pk_bf16(v1[0], v1[1]); w.w = cvt_pk_bf16(v1[2], v1[3]); return w; }

struct EpiZ {
    static constexpr bool PERM = true, AFTER_DRAIN = false; bf16_t* Z;
    __device__ __forceinline__ void operator()(const f32x4 (&acc)[2][2][4][2], const Unit& u, int wr, int wc, int fr, int fq) const {
        const int sec = u.pn >> 2; const int mode = (sec == 2) ? 0 : (sec >= 4 ? 2 : 1); bf16_t* Zs = Z + (size_t)sec * ZSEC;
        EPI_LOOP_BEGIN
            if (mode == 1) {
#pragma unroll
                for (int e = 0; e < 4; ++e) { v0[e] = fgelu(v0[e]); v1[e] = fgelu(v1[e]); }
            } else if (mode == 2) {
#pragma unroll
                for (int e = 0; e < 4; ++e) { v0[e] = fsigmoid(v0[e]); v1[e] = fsigmoid(v1[e]); }
            }
            *(u32x4*)(Zs + row * ZLD + (col & 1023)) = pack8(v0, v1);
        EPI_LOOP_END
    }
};
struct EpiPlain {
    static constexpr bool PERM = true, AFTER_DRAIN = false; bf16_t* O; int ldc;
    __device__ __forceinline__ void operator()(const f32x4 (&acc)[2][2][4][2], const Unit& u, int wr, int wc, int fr, int fq) const {
        EPI_LOOP_BEGIN
            *(u32x4*)(O + row * ldc + col) = pack8(v0, v1);
        EPI_LOOP_END
    }
};
__device__ __forceinline__ void mul8(f32x4& v0, f32x4& v1, const u32x4 w) { v0[0] *= bf_lo(w.x); v0[1] *= bf_hi(w.x); v0[2] *= bf_lo(w.y); v0[3] *= bf_hi(w.y); v1[0] *= bf_lo(w.z); v1[1] *= bf_hi(w.z); v1[2] *= bf_lo(w.w); v1[3] *= bf_hi(w.w); }
__device__ __forceinline__ void add8(f32x4& v0, f32x4& v1, const u32x4 w) { v0[0] += bf_lo(w.x); v0[1] += bf_hi(w.x); v0[2] += bf_lo(w.y); v0[3] += bf_hi(w.y); v1[0] += bf_lo(w.z); v1[1] += bf_hi(w.z); v1[2] += bf_lo(w.w); v1[3] += bf_hi(w.w); }
template <bool ADD> struct EpiGate {
    static constexpr bool PERM = true, AFTER_DRAIN = false; bf16_t* O; const bf16_t* G; int ld;
    __device__ __forceinline__ void operator()(const f32x4 (&acc)[2][2][4][2], const Unit& u, int wr, int wc, int fr, int fq) const {
        const int row0 = u.pm * 256 + wr * 64 + fr, col0 = u.pn * 256 + wc * 32 + 8 * fq;
#pragma unroll
        for (int ai = 0; ai < 2; ++ai) {
            u32x4 gw[4][2], ow[4][2];
#pragma unroll
            for (int m = 0; m < 4; ++m)
#pragma unroll
                for (int bj = 0; bj < 2; ++bj) { const size_t off = (size_t)(row0 + ai * 128 + m * 16) * ld + col0 + bj * 128; gw[m][bj] = *(const u32x4*)(G + off); if (ADD) ow[m][bj] = *(const u32x4*)(O + off); }
#pragma unroll
            for (int m = 0; m < 4; ++m)
#pragma unroll
                for (int bj = 0; bj < 2; ++bj) { const size_t off = (size_t)(row0 + ai * 128 + m * 16) * ld + col0 + bj * 128; f32x4 v0 = acc[ai][bj][m][0], v1 = acc[ai][bj][m][1];
                    mul8(v0, v1, gw[m][bj]); if (ADD) add8(v0, v1, ow[m][bj]);
                    *(u32x4*)(O + off) = pack8(v0, v1); }
        }
    }
};
struct EpiSwiglu {
    static constexpr bool PERM = true, AFTER_DRAIN = false; bf16_t* O;
    __device__ __forceinline__ void operator()(const f32x4 (&acc)[2][2][4][2], const Unit& u, int wr, int wc, int fr, int fq) const {
        EPI_LOOP_BEGIN
            const int hid = u.pn * 128 + bj * 64 + wc * 16 + 4 * fq; (void)col;
            f32x4 o;
#pragma unroll
            for (int e = 0; e < 4; ++e) o[e] = v0[e] * fsigmoid(v0[e]) * v1[e];
            u32x2 w; w.x = cvt_pk_bf16(o[0], o[1]); w.y = cvt_pk_bf16(o[2], o[3]);
            *(u32x2*)(O + row * DFF + hid) = w;
        EPI_LOOP_END
    }
};
struct EpiSigMul {
    static constexpr bool PERM = true, AFTER_DRAIN = false; bf16_t* O;
    __device__ __forceinline__ void operator()(const f32x4 (&acc)[2][2][4][2], const Unit& u, int wr, int wc, int fr, int fq) const {
        const int row0 = u.pm * 256 + wr * 64 + fr, col0 = u.pn * 256 + wc * 32 + 8 * fq;
#pragma unroll
        for (int ai = 0; ai < 2; ++ai) {
            u32x4 ow[4][2];
#pragma unroll
            for (int m = 0; m < 4; ++m)
#pragma unroll
                for (int bj = 0; bj < 2; ++bj) ow[m][bj] = *(const u32x4*)(O + (size_t)(row0 + ai * 128 + m * 16) * DM + col0 + bj * 128);
#pragma unroll
            for (int m = 0; m < 4; ++m)
#pragma unroll
                for (int bj = 0; bj < 2; ++bj) { f32x4 v0 = acc[ai][bj][m][0], v1 = acc[ai][bj][m][1];
#pragma unroll
                    for (int e = 0; e < 4; ++e) { v0[e] = fsigmoid(v0[e]); v1[e] = fsigmoid(v1[e]); }
                    mul8(v0, v1, ow[m][bj]);
                    *(u32x4*)(O + (size_t)(row0 + ai * 128 + m * 16) * DM + col0 + bj * 128) = pack8(v0, v1); }
        }
    }
};

struct PanelOrder {
    int nN, pm;
    __device__ void init(int N, int pm_) { nN = N / 256; pm = pm_; }
    __device__ bool next(int i, Unit& u) const { if (i >= nN) return false; u.pm = pm; u.pn = i; return true; }
    __device__ __forceinline__ void a_ready(const Unit&) const {}
    __device__ __forceinline__ void done(const Unit&) const {}
};
template <int MODE> __device__ __forceinline__ void transpose_item(const float* W, int K, int N, bf16_t* WT, LAS float* scr, int item, int lane) {
    const int nblk = N / 32, kb = item / nblk, nb = item % nblk, k0 = 64 * kb, n0 = 32 * nb;
    float tv[32];
#pragma unroll
    for (int i = 0; i < 32; ++i) tv[i] = W[(size_t)(k0 + 2 * i + (lane >> 5)) * N + n0 + (lane & 31)];
#pragma unroll
    for (int i = 0; i < 32; ++i) scr[(2 * i + (lane >> 5)) * 33 + (lane & 31)] = tv[i];
    asm volatile("s_waitcnt lgkmcnt(0)" ::: "memory");
    const int c = lane & 7;
#pragma unroll
    for (int j = 0; j < 4; ++j) { const int n = (lane >> 3) + 8 * j; const LAS float* s = scr + (8 * c) * 33 + n;
        u32x4 o; o.x = cvt_pk_bf16(s[0 * 33], s[1 * 33]); o.y = cvt_pk_bf16(s[2 * 33], s[3 * 33]); o.z = cvt_pk_bf16(s[4 * 33], s[5 * 33]); o.w = cvt_pk_bf16(s[6 * 33], s[7 * 33]);
        const int ng = n0 + n; const int drow = (MODE == 0) ? ng : (256 * (ng >> 7) + 8 * ((ng & 127) >> 2) + (ng & 3) + 4 * (MODE - 1));
        *(u32x4*)(WT + (size_t)drow * K + k0 + 8 * c) = o; }
    asm volatile("s_waitcnt lgkmcnt(0)" ::: "memory");
}

struct Args { const float* in[28]; float* out; unsigned char* ws; int ph_lo, ph_hi; };

__device__ __forceinline__ void prologue(const __attribute__((address_space(4))) Args* ap, LAS unsigned char* lds, int gw, int NGW, int wave, int lane) {
    Args a;
    for (int i = 0; i < 28; ++i) a.in[i] = ap->in[i];
    a.out = ap->out; a.ws = ap->ws;
    unsigned char* ws = a.ws;
    LAS float* scr = (LAS float*)(lds + wave * 16384);
    constexpr int I_IN = 16 * (NIN / 32), I_SQ = 16 * 32, I_GU = 16 * (DFF / 32), I_DN = (DFF / 64) * 32, I_PI = 4 * 32;
    constexpr int NITEMS = I_IN + 4 * I_SQ + 2 * I_GU + I_DN + I_PI;
    for (int it = gw; it < NITEMS; it += NGW) {
        int r = it;
        if (r < I_IN) { transpose_item<0>(a.in[4], DM, NIN, (bf16_t*)(ws + WS_WIN), scr, r, lane); continue; } r -= I_IN;
        if (r < I_SQ) { transpose_item<0>(a.in[16], DM, DM, (bf16_t*)(ws + WS_WA), scr, r, lane); continue; } r -= I_SQ;
        if (r < I_SQ) { transpose_item<0>(a.in[17], DM, DM, (bf16_t*)(ws + WS_WB), scr, r, lane); continue; } r -= I_SQ;
        if (r < I_SQ) { transpose_item<0>(a.in[18], DM, DM, (bf16_t*)(ws + WS_WO), scr, r, lane); continue; } r -= I_SQ;
        if (r < I_SQ) { transpose_item<0>(a.in[27], DM, DM, (bf16_t*)(ws + WS_WPG), scr, r, lane); continue; } r -= I_SQ;
        if (r < I_GU) { transpose_item<1>(a.in[21], DM, DFF, (bf16_t*)(ws + WS_WGU), scr, r, lane); continue; } r -= I_GU;
        if (r < I_GU) { transpose_item<2>(a.in[22], DM, DFF, (bf16_t*)(ws + WS_WGU), scr, r, lane); continue; } r -= I_GU;
        if (r < I_DN) { transpose_item<0>(a.in[23], DFF, DM, (bf16_t*)(ws + WS_WDN), scr, r, lane); continue; } r -= I_DN;
        transpose_item<0>(a.in[26], PLE, DM, (bf16_t*)(ws + WS_WPIN), scr, r, lane);
    }
    const int gt = gw * 64 + lane, NGT = NGW * 64;
    { const float* wsrc = a.in[7]; bf16_t* d = (bf16_t*)(ws + WS_WSB);
      for (int e = gt; e < 8 * 128 * 128; e += NGT) { const int i = (e >> 7) & 127, j = e & 127; d[e] = ((j >> 6) <= (i >> 6)) ? f2bf(wsrc[e]) : (bf16_t)0; } }
    { bf16_t* d = (bf16_t*)(ws + WS_LRT); const float* cw = a.in[9];
      for (int e = gt; e < 2 * 16 * 4 * 64 * 64; e += NGT) { const int c = e & 63, j = (e >> 6) & 63, k = (e >> 12) & 3, hd = (e >> 14) & 15, which = e >> 18;
          const float* src = which ? a.in[13] : a.in[11]; d[e] = f2bf(cw[k * DM + hd * 64 + c] * src[hd * 4096 + c * 64 + j]); } }
    { float* d = (float*)(ws + WS_BIASP); const float* cb = a.in[10];
      for (int e = gw; e < 2 * DM; e += NGW) { const int which = e >> 10, ch = e & 1023, hd = ch >> 6, j = ch & 63; const float* w = (which ? a.in[13] : a.in[11]) + hd * 4096 + j;
          const float part = wave_sum(cb[hd * 64 + lane] * w[lane * 64]);
          if (lane == 0) d[e] = (which ? a.in[14] : a.in[12])[ch] + part; }
      for (int e = gt; e < DM; e += NGT) d[2 * DM + e] = 8.0f * 1.4426950408889634f * log1pf(expf(-a.in[15][e])); }
    { const f32x4* src = (const f32x4*)a.in[1]; u32x2* d = (u32x2*)(ws + WS_PB);
      for (int e = gt; e < M * PLE / 4; e += 4 * NGT) { f32x4 v[4];
#pragma unroll
          for (int i = 0; i < 4; ++i) v[i] = src[e + i * NGT < M * PLE / 4 ? e + i * NGT : e];
#pragma unroll
          for (int i = 0; i < 4; ++i) if (e + i * NGT < M * PLE / 4) { u32x2 w; w.x = cvt_pk_bf16(v[i][0], v[i][1]); w.y = cvt_pk_bf16(v[i][2], v[i][3]); d[e + i * NGT] = w; } } }
    { const float* x = a.in[0]; const float* g = a.in[2]; bf16_t* H = (bf16_t*)(ws + WS_H);
      f32x4 nx[4], gq[4];
#pragma unroll
      for (int j = 0; j < 4; ++j) { gq[j] = *(const f32x4*)(g + 256 * j + 4 * lane); nx[j] = *(const f32x4*)(x + (size_t)gw * DM + 256 * j + 4 * lane); }
      for (int m = gw; m < M; m += NGW) {
          f32x4 v[4]; float ss = 0.f;
#pragma unroll
          for (int j = 0; j < 4; ++j) { v[j] = nx[j]; ss += (v[j][0] * v[j][0] + v[j][1] * v[j][1]) + (v[j][2] * v[j][2] + v[j][3] * v[j][3]); }
          { const int mn = m + NGW < M ? m + NGW : m;
#pragma unroll
              for (int j = 0; j < 4; ++j) nx[j] = *(const f32x4*)(x + (size_t)mn * DM + 256 * j + 4 * lane); }
          const float rs = rsqrtf(wave_sum(ss) * (1.f / DM) + EPS);
#pragma unroll
          for (int j = 0; j < 4; ++j) { const f32x4 gg = gq[j]; u32x2 w; w.x = cvt_pk_bf16(v[j][0] * rs * gg[0], v[j][1] * rs * gg[1]); w.y = cvt_pk_bf16(v[j][2] * rs * gg[2], v[j][3] * rs * gg[3]);
              *(u32x2*)(H + (size_t)m * DM + 256 * j + 4 * lane) = w; }
      } }
}

template <bool XIN_BF16, bool XOUT_BF16>
__device__ __forceinline__ void norm_pass(const unsigned char* xin, size_t xin_pitch, const bf16_t* y, int ldy, const float* g1, unsigned char* xo, size_t xo_pitch, const float* g2, bf16_t* hn, int wave, int lane) {
    u32x4 yq[2], xb[2]; f32x4 xf[2][2];
    f32x4 G1[2][2], G2[2][2];
#pragma unroll
    for (int j = 0; j < 2; ++j) { const int c0 = 512 * j + 8 * lane; G1[j][0] = *(const f32x4*)(g1 + c0); G1[j][1] = *(const f32x4*)(g1 + c0 + 4);
        if (g2) { G2[j][0] = *(const f32x4*)(g2 + c0); G2[j][1] = *(const f32x4*)(g2 + c0 + 4); } else { G2[j][0] = G1[j][0]; G2[j][1] = G1[j][1]; } }
#define NP_LOAD(r_) do { _Pragma("unroll") for (int j = 0; j < 2; ++j) { const int c0 = 512 * j + 8 * lane; yq[j] = *(const u32x4*)(y + (size_t)(r_) * ldy + c0); \
        if (XIN_BF16) xb[j] = *(const u32x4*)(xin + (size_t)(r_) * xin_pitch + 2 * c0); \
        else { xf[j][0] = *(const f32x4*)(xin + (size_t)(r_) * xin_pitch + 4 * c0); xf[j][1] = *(const f32x4*)(xin + (size_t)(r_) * xin_pitch + 4 * c0 + 16); } } } while (0)
    NP_LOAD(wave);
    for (int r = wave; r < 256; r += NWAVES) {
        float yv[16], xv[16]; float ss = 0.f;
#pragma unroll
        for (int j = 0; j < 2; ++j) { const u32x4 w = yq[j];
            yv[8 * j + 0] = bf_lo(w.x); yv[8 * j + 1] = bf_hi(w.x); yv[8 * j + 2] = bf_lo(w.y); yv[8 * j + 3] = bf_hi(w.y); yv[8 * j + 4] = bf_lo(w.z); yv[8 * j + 5] = bf_hi(w.z); yv[8 * j + 6] = bf_lo(w.w); yv[8 * j + 7] = bf_hi(w.w);
            if (XIN_BF16) { const u32x4 a = xb[j];
                xv[8 * j + 0] = bf_lo(a.x); xv[8 * j + 1] = bf_hi(a.x); xv[8 * j + 2] = bf_lo(a.y); xv[8 * j + 3] = bf_hi(a.y); xv[8 * j + 4] = bf_lo(a.z); xv[8 * j + 5] = bf_hi(a.z); xv[8 * j + 6] = bf_lo(a.w); xv[8 * j + 7] = bf_hi(a.w);
            } else {
#pragma unroll
                for (int e = 0; e < 4; ++e) { xv[8 * j + e] = xf[j][0][e]; xv[8 * j + 4 + e] = xf[j][1][e]; } } }
        NP_LOAD(r + NWAVES < 256 ? r + NWAVES : r);
#pragma unroll
        for (int e = 0; e < 16; ++e) ss += yv[e] * yv[e];
        const float rs = rsqrtf(wave_sum(ss) * (1.f / DM) + EPS);
        float s2 = 0.f;
#pragma unroll
        for (int j = 0; j < 2; ++j) { const int c0 = 512 * j + 8 * lane; const f32x4 ga = G1[j][0], gb = G1[j][1];
#pragma unroll
            for (int e = 0; e < 4; ++e) { xv[8 * j + e] += yv[8 * j + e] * rs * ga[e]; xv[8 * j + 4 + e] += yv[8 * j + 4 + e] * rs * gb[e]; }
            if (XOUT_BF16) { *(u32x4*)(xo + (size_t)r * xo_pitch + 2 * c0) = pack8((f32x4){xv[8 * j], xv[8 * j + 1], xv[8 * j + 2], xv[8 * j + 3]}, (f32x4){xv[8 * j + 4], xv[8 * j + 5], xv[8 * j + 6], xv[8 * j + 7]});
#pragma unroll
                for (int e = 0; e < 8; ++e) xv[8 * j + e] = bf1(f2bf(xv[8 * j + e]));
            } else { *(f32x4*)(xo + (size_t)r * xo_pitch + 4 * c0) = (f32x4){xv[8 * j], xv[8 * j + 1], xv[8 * j + 2], xv[8 * j + 3]};
                *(f32x4*)(xo + (size_t)r * xo_pitch + 4 * c0 + 16) = (f32x4){xv[8 * j + 4], xv[8 * j + 5], xv[8 * j + 6], xv[8 * j + 7]}; } }
        if (hn) {
#pragma unroll
            for (int e = 0; e < 16; ++e) s2 += xv[e] * xv[e];
            const float r2 = rsqrtf(wave_sum(s2) * (1.f / DM) + EPS);
#pragma unroll
            for (int j = 0; j < 2; ++j) { const int c0 = 512 * j + 8 * lane; const f32x4 ga = G2[j][0], gb = G2[j][1];
                f32x4 o0, o1;
#pragma unroll
                for (int e = 0; e < 4; ++e) { o0[e] = xv[8 * j + e] * r2 * ga[e]; o1[e] = xv[8 * j + 4 + e] * r2 * gb[e]; }
                *(u32x4*)(hn + (size_t)r * DM + c0) = pack8(o0, o1); }
        }
    }
#undef NP_LOAD
}
#define LDS_BARRIER() do { asm volatile("s_waitcnt lgkmcnt(0)" ::: "memory"); __builtin_amdgcn_s_barrier(); asm volatile("" ::: "memory"); } while (0)
typedef short s16x4 __attribute__((ext_vector_type(4)));
__device__ __forceinline__ void mixerA_unit(LAS unsigned char* lds, int blk, const bf16_t* Z, bf16_t* AO, const bf16_t* WSB, const float* ln_g, const float* ln_b, const float* b_s) {
    const int tid = threadIdx.x, wave = __builtin_amdgcn_readfirstlane(tid >> 6), lane = tid & 63, fr = lane & 15, fq = lane >> 4;
    LAS float* st = (LAS float*)lds;
    LAS bf16_t* Wl = (LAS bf16_t*)(lds + 1024);
    LAS bf16_t* Vn = Wl + 128 * 136;
    LAS float* bsl = (LAS float*)(Vn + 128 * 136);
    const size_t row0 = (size_t)blk * 128;
    const int cc = tid & 15;
    u32x4 wq[4], vq[4]; f32x4 lg0, lg1, lb0, lb1;
#define MA_PREFETCH(g) do { _Pragma("unroll") for (int it = 0; it < 4; ++it) { const int q = tid + 512 * it; wq[it] = *(const u32x4*)(WSB + (g) * 16384 + (q >> 4) * 128 + (q & 15) * 8); \
        vq[it] = *(const u32x4*)(Z + (row0 + (tid >> 4) + 32 * it) * ZLD + ZSEC + (g) * 128 + cc * 8); } \
        lg0 = *(const f32x4*)(ln_g + (g) * 128 + cc * 8); lg1 = *(const f32x4*)(ln_g + (g) * 128 + cc * 8 + 4); lb0 = *(const f32x4*)(ln_b + (g) * 128 + cc * 8); lb1 = *(const f32x4*)(ln_b + (g) * 128 + cc * 8 + 4); } while (0)
    MA_PREFETCH(0);
    u32x2 un[8];
#define MA_LOAD_U(g) do { _Pragma("unroll") for (int it = 0; it < 8; ++it) un[it] = *(const u32x2*)(Z + (row0 + 16 * it + fr) * ZLD + (g) * 128 + 16 * wave + 4 * fq); } while (0)
    MA_LOAD_U(0);
    bsl[tid] = b_s[tid]; bsl[512 + tid] = b_s[512 + tid];
#pragma unroll 8
    for (int rr = 0; rr < 16; ++rr) {
        const int r = 16 * wave + rr; const bf16_t* vp = Z + (row0 + r) * ZLD + ZSEC + lane * 16;
        const u32x4 w0 = *(const u32x4*)vp, w1 = *(const u32x4*)(vp + 8);
        float f[16] = {bf_lo(w0.x), bf_hi(w0.x), bf_lo(w0.y), bf_hi(w0.y), bf_lo(w0.z), bf_hi(w0.z), bf_lo(w0.w), bf_hi(w0.w), bf_lo(w1.x), bf_hi(w1.x), bf_lo(w1.y), bf_hi(w1.y), bf_lo(w1.z), bf_hi(w1.z), bf_lo(w1.w), bf_hi(w1.w)};
        float s = 0.f, q = 0.f;
#pragma unroll
        for (int e = 0; e < 16; ++e) { s += f[e]; q += f[e] * f[e]; }
#pragma unroll
        for (int o = 1; o < 64; o <<= 1) { s += __shfl_xor(s, o); q += __shfl_xor(q, o); }
        const float mean = s * (1.f / 1024.f); const float var = fmaxf(q * (1.f / 1024.f) - mean * mean, 0.f);
        if (lane == 0) { st[2 * r] = mean; st[2 * r + 1] = rsqrtf(var + EPS); }
    }
    LDS_BARRIER();
    const unsigned vaddr = (unsigned)(uintptr_t)(Vn + (8 * fq + (fr >> 2)) * 136 + 16 * wave + 4 * (fr & 3));
    for (int g = 0; g < 8; ++g) {
#pragma unroll
        for (int it = 0; it < 4; ++it) { const int q = tid + 512 * it; *(LAS u32x4*)(Wl + (q >> 4) * 136 + (q & 15) * 8) = wq[it]; }
#pragma unroll
        for (int it = 0; it < 4; ++it) { const int j = (tid >> 4) + 32 * it; const u32x4 w = vq[it]; const float mu = st[2 * j], rs = st[2 * j + 1];
            const f32x4 o0 = (f32x4){(bf_lo(w.x) - mu) * rs * lg0[0] + lb0[0], (bf_hi(w.x) - mu) * rs * lg0[1] + lb0[1], (bf_lo(w.y) - mu) * rs * lg0[2] + lb0[2], (bf_hi(w.y) - mu) * rs * lg0[3] + lb0[3]};
            const f32x4 o1 = (f32x4){(bf_lo(w.z) - mu) * rs * lg1[0] + lb1[0], (bf_hi(w.z) - mu) * rs * lg1[1] + lb1[1], (bf_lo(w.w) - mu) * rs * lg1[2] + lb1[2], (bf_hi(w.w) - mu) * rs * lg1[3] + lb1[3]};
            *(LAS u32x4*)(Vn + j * 136 + cc * 8) = pack8(o0, o1); }
        LDS_BARRIER();
        u32x2 uq[8]; float bsv[8];
#pragma unroll
        for (int it = 0; it < 8; ++it) { uq[it] = un[it]; bsv[it] = bsl[g * 128 + 16 * it + fr]; }
        MA_LOAD_U(g < 7 ? g + 1 : 7);
        MA_PREFETCH(g < 7 ? g + 1 : 7);
        s16x4 t00, t01, t10, t11, t20, t21, t30, t31;
        asm volatile("ds_read_b64_tr_b16 %0, %8\n\tds_read_b64_tr_b16 %1, %8 offset:1088\n\tds_read_b64_tr_b16 %2, %8 offset:8704\n\tds_read_b64_tr_b16 %3, %8 offset:9792\n\t"
                     "ds_read_b64_tr_b16 %4, %8 offset:17408\n\tds_read_b64_tr_b16 %5, %8 offset:18496\n\tds_read_b64_tr_b16 %6, %8 offset:26112\n\tds_read_b64_tr_b16 %7, %8 offset:27200\n\ts_waitcnt lgkmcnt(0)"
                     : "=&v"(t00), "=&v"(t01), "=&v"(t10), "=&v"(t11), "=&v"(t20), "=&v"(t21), "=&v"(t30), "=&v"(t31) : "v"(vaddr) : "memory");
        bf16x8 avk[4];
        avk[0] = __builtin_shufflevector(t00, t01, 0, 1, 2, 3, 4, 5, 6, 7); avk[1] = __builtin_shufflevector(t10, t11, 0, 1, 2, 3, 4, 5, 6, 7);
        avk[2] = __builtin_shufflevector(t20, t21, 0, 1, 2, 3, 4, 5, 6, 7); avk[3] = __builtin_shufflevector(t30, t31, 0, 1, 2, 3, 4, 5, 6, 7);
        f32x4 acc[8];
#pragma unroll
        for (int it = 0; it < 8; ++it) acc[it] = (f32x4){0.f, 0.f, 0.f, 0.f};
#pragma unroll
        for (int k = 0; k < 4; ++k) {
#pragma unroll
            for (int it = 0; it < 8; ++it) { if (it < 4 && k >= 2) continue;
                const bf16x8 bv = *(const LAS bf16x8*)(Wl + (16 * it + fr) * 136 + 32 * k + 8 * fq);
                acc[it] = __builtin_amdgcn_mfma_f32_16x16x32_bf16(avk[k], bv, acc[it], 0, 0, 0); } }
#pragma unroll
        for (int it = 0; it < 8; ++it) { const float bs = bsv[it]; const u32x2 uw = uq[it];
            u32x2 o; o.x = cvt_pk_bf16(bf_lo(uw.x) * (acc[it][0] + bs), bf_hi(uw.x) * (acc[it][1] + bs)); o.y = cvt_pk_bf16(bf_lo(uw.y) * (acc[it][2] + bs), bf_hi(uw.y) * (acc[it][3] + bs));
            *(u32x2*)(AO + (row0 + 16 * it + fr) * DM + g * 128 + 16 * wave + 4 * fq) = o; }
        LDS_BARRIER();
    }
#undef MA_PREFETCH
#undef MA_LOAD_U
}

typedef float f32x16 __attribute__((ext_vector_type(16)));
__device__ __forceinline__ void mixerB_unit(LAS unsigned char* lds, int unit, const bf16_t* Z, bf16_t* BO, const bf16_t* LRT, const float* BIASP, const float* conv_w, const float* conv_b) {
    const int tid = threadIdx.x, wave = __builtin_amdgcn_readfirstlane(tid >> 6), lane = tid & 63, l31 = lane & 31, hh = lane >> 5;
    const int b = unit >> 5, hd = (unit >> 1) & 15, half = unit & 1, ch0 = hd * 64, jo = half * 32;
    const bool is_c = wave < 4;
    constexpr int NT = SEQ / 128;
    LAS bf16_t* wl = (LAS bf16_t*)lds;
    LAS bf16_t* xrl = (LAS bf16_t*)(lds + 36864);
    LAS float* cwl = (LAS float*)(lds + 74592);
    LAS float* alb = (LAS float*)(lds + 75616);
    LAS float* gil = (LAS float*)(lds + 112480);
    LAS float* sA = (LAS float*)(lds + 130912);
    LAS float* sH = sA + 256;
    LAS float* cry = sH + 256;
#pragma unroll
    for (int it = 0; it < 4; ++it) { const int q = tid + 512 * it, row = q >> 3, c8 = q & 7, gate = row >> 7, k = (row >> 5) & 3, j = row & 31;
        *(LAS u32x4*)(wl + row * 72 + c8 * 8) = *(const u32x4*)(LRT + ((size_t)((gate * 16 + hd) * 4 + k) * 64 + jo + j) * 64 + c8 * 8); }
    if (tid < 128) cwl[tid] = conv_w[(tid >> 5) * DM + ch0 + jo + (tid & 31)];
    else if (tid < 192) { const int wq = (tid - 128) >> 5, ch = ch0 + jo + (tid & 31); cwl[128 + (tid - 128)] = BIASP[wq * DM + ch]; cwl[192 + (tid - 128)] = wq ? conv_b[ch] : BIASP[2 * DM + ch]; }
    if (tid < 64) cry[tid] = 0.f;
    const int sid = tid & 255, sc = sid & 31, seg = sid >> 5;
    const bf16_t* xbase = Z + ((size_t)b * SEQ + (sid >> 3)) * ZLD + 2 * ZSEC + ch0 + (sid & 7) * 8;
    const bf16_t* xhalo = Z + ((size_t)b * SEQ + (sid < 24 ? (sid >> 3) : 0)) * ZLD + 2 * ZSEC + ch0 + (sid & 7) * 8 - (ptrdiff_t)3 * ZLD;
    const bf16_t* gbase = Z + ((size_t)b * SEQ + 16 * seg) * ZLD + 3 * ZSEC + ch0 + jo + sc;
    bf16_t* obase = BO + ((size_t)b * SEQ + 16 * seg) * DM + ch0 + jo + sc;
    u32x4 rq[4], hq; unsigned gy[16];
#define MB_LOAD_RAW(tile) do { const bf16_t* xp_ = xbase + (size_t)(tile) * 128 * ZLD; _Pragma("unroll") for (int it = 0; it < 4; ++it) rq[it] = *(const u32x4*)(xp_ + (size_t)(32 * it) * ZLD); \
        hq = *(const u32x4*)(xhalo + (size_t)((tile) > 0 ? (tile) : 1) * 128 * ZLD); } while (0)
#define MB_STORE_RAW(buf) do { LAS bf16_t* xd_ = xrl + (buf) * 9432; _Pragma("unroll") for (int it = 0; it < 4; ++it) *(LAS u32x4*)(xd_ + (3 + (sid >> 3) + 32 * it) * 72 + (sid & 7) * 8) = rq[it]; \
        if (sid < 24) *(LAS u32x4*)(xd_ + (sid >> 3) * 72 + (sid & 7) * 8) = hq; } while (0)
#define MB_LOAD_GY(tile) do { _Pragma("unroll") for (int s_ = 0; s_ < 16; ++s_) gy[s_] = (unsigned)gbase[((size_t)(tile) * 128 + s_) * ZLD]; } while (0)
    const int t_ = 32 * wave + l31;
#define MB_MFMA(GATE, buf, a0_, a1_) do { const LAS bf16_t* xs_ = xrl + (buf) * 9432; _Pragma("unroll") for (int e_ = 0; e_ < 16; ++e_) { a0_[e_] = 0.f; a1_[e_] = 0.f; } \
        _Pragma("unroll") for (int ks = 0; ks < 16; ks += 2) { \
            const bf16x8 w0_ = *(const LAS bf16x8*)(wl + (((GATE) * 4 + (ks >> 2)) * 32 + l31) * 72 + 16 * (ks & 3) + 8 * hh), x0_ = *(const LAS bf16x8*)(xs_ + (t_ + (ks >> 2)) * 72 + 16 * (ks & 3) + 8 * hh); \
            const bf16x8 w1_ = *(const LAS bf16x8*)(wl + (((GATE) * 4 + ((ks + 1) >> 2)) * 32 + l31) * 72 + 16 * ((ks + 1) & 3) + 8 * hh), x1_ = *(const LAS bf16x8*)(xs_ + (t_ + ((ks + 1) >> 2)) * 72 + 16 * ((ks + 1) & 3) + 8 * hh); \
            a0_ = __builtin_amdgcn_mfma_f32_32x32x16_bf16(w0_, x0_, a0_, 0, 0, 0); a1_ = __builtin_amdgcn_mfma_f32_32x32x16_bf16(w1_, x1_, a1_, 0, 0, 0); \
            if ((ks & 2) != 0) __builtin_amdgcn_sched_barrier(0); } \
        } while (0)
#define MB_EW_R(accA, accB, dst) do { const LAS float* bsl_ = cwl + 128; const LAS float* c2l_ = cwl + 192; \
        _Pragma("unroll") for (int i = 0; i < 4; ++i) { f32x4 o_; const f32x4 bs_ = *(const LAS f32x4*)(bsl_ + 8 * i + 4 * hh), c2_ = *(const LAS f32x4*)(c2l_ + 8 * i + 4 * hh); \
            _Pragma("unroll") for (int j = 0; j < 4; ++j) o_[j] = __builtin_amdgcn_exp2f(-c2_[j] * fsigmoid(((accA)[4 * i + j] + (accB)[4 * i + j]) + bs_[j])); \
            *(LAS f32x4*)((dst) + t_ * 36 + 8 * i + 4 * hh) = o_; } } while (0)
#define MB_EW_I(accA, accB, buf, dst) do { const LAS bf16_t* xs_ = xrl + (buf) * 9432; const LAS float* bsl_ = cwl + 160; const LAS float* c2l_ = cwl + 224; \
        _Pragma("unroll") for (int i = 0; i < 4; ++i) { f32x4 xc_ = *(const LAS f32x4*)(c2l_ + 8 * i + 4 * hh); const f32x4 bs_ = *(const LAS f32x4*)(bsl_ + 8 * i + 4 * hh); \
            _Pragma("unroll") for (int k = 0; k < 4; ++k) { const u32x2 w_ = *(const LAS u32x2*)(xs_ + (t_ + k) * 72 + jo + 8 * i + 4 * hh); const f32x4 cw_ = *(const LAS f32x4*)(cwl + k * 32 + 8 * i + 4 * hh); \
                xc_[0] += cw_[0] * bf_lo(w_.x); xc_[1] += cw_[1] * bf_hi(w_.x); xc_[2] += cw_[2] * bf_lo(w_.y); xc_[3] += cw_[3] * bf_hi(w_.y); } \
            f32x4 o_; \
            _Pragma("unroll") for (int j = 0; j < 4; ++j) o_[j] = fsigmoid(((accA)[4 * i + j] + (accB)[4 * i + j]) + bs_[j]) * xc_[j]; \
            *(LAS f32x4*)((dst) + t_ * 36 + 8 * i + 4 * hh) = o_; } } while (0)
    if (!is_c) { MB_LOAD_RAW(0); hq = (u32x4){0u, 0u, 0u, 0u}; MB_STORE_RAW(0); MB_LOAD_RAW(1); MB_STORE_RAW(1); MB_LOAD_RAW(2); MB_LOAD_GY(0); }
    LDS_BARRIER();
    f32x16 accR0, accR1, accI0, accI1;
    if (is_c) { MB_MFMA(0, 0, accR0, accR1); MB_MFMA(1, 0, accI0, accI1); MB_EW_R(accR0, accR1, alb); MB_EW_I(accI0, accI1, 0, gil); MB_MFMA(0, 1, accR0, accR1); }
    LDS_BARRIER();
    float a16[16], g16[16];
    for (int tile = 0; tile < NT; ++tile) {
        if (is_c) { MB_MFMA(1, (tile + 1) & 1, accI0, accI1); MB_EW_R(accR0, accR1, alb + ((tile + 1) & 1) * 4608); }
        else {
            const LAS float* al = alb + (tile & 1) * 4608; float A = 1.f, Hh = 0.f;
#pragma unroll
            for (int s = 0; s < 16; ++s) { const float av = al[(16 * seg + s) * 36 + sc]; a16[s] = av; g16[s] = __builtin_amdgcn_sqrtf(fmaxf(1.0f - av * av, 0.f)) * gil[(16 * seg + s) * 36 + sc]; A *= av; Hh = av * Hh + g16[s]; }
            sA[seg * 32 + sc] = A; sH[seg * 32 + sc] = Hh;
            MB_STORE_RAW(tile & 1);
            MB_LOAD_RAW(tile + 3 < NT ? tile + 3 : NT - 1);
        }
        LDS_BARRIER();
        if (is_c) { MB_MFMA(0, tile & 1, accR0, accR1); MB_EW_I(accI0, accI1, (tile + 1) & 1, gil); }
        else {
            float h = cry[(tile & 1) * 32 + sc];
#pragma unroll
            for (int s = 0; s < 7; ++s) { const float As = sA[s * 32 + sc], Hs = sH[s * 32 + sc]; h = (s < seg) ? As * h + Hs : h; }
            bf16_t* op = obase + (size_t)tile * 128 * DM;
#pragma unroll
            for (int s = 0; s < 16; ++s) { h = a16[s] * h + g16[s]; op[(size_t)s * DM] = f2bf(h * __builtin_bit_cast(float, gy[s] << 16)); }
            if (seg == 7) cry[((tile + 1) & 1) * 32 + sc] = h;
            MB_LOAD_GY(tile + 1 < NT ? tile + 1 : NT - 1);
        }
        LDS_BARRIER();
    }
#undef MB_LOAD_RAW
#undef MB_STORE_RAW
#undef MB_LOAD_GY
#undef MB_MFMA
#undef MB_EW_R
#undef MB_EW_I
}

__device__ __forceinline__ void grid_barrier(unsigned* bar) {
    asm volatile("s_waitcnt vmcnt(0)" ::: "memory");
    __syncthreads();
    if (threadIdx.x == 0) {
        __builtin_amdgcn_fence(__ATOMIC_RELEASE, "agent");
        const unsigned G = gridDim.x;
        const unsigned old = __hip_atomic_fetch_add(bar, 1u, __ATOMIC_RELAXED, __HIP_MEMORY_SCOPE_AGENT);
        const unsigned target = (old / G + 1u) * G;
        while (__hip_atomic_load(bar, __ATOMIC_RELAXED, __HIP_MEMORY_SCOPE_AGENT) < target) __builtin_amdgcn_s_sleep(2);
        __builtin_amdgcn_fence(__ATOMIC_ACQUIRE, "agent");
        asm volatile("s_waitcnt vmcnt(0)" ::: "memory");
    }
    __syncthreads();
}
typedef const __attribute__((address_space(4))) Args* KArgs;
__device__ __forceinline__ KArgs kargs() {
#if defined(__HIP_DEVICE_COMPILE__)
    auto p0 = __builtin_amdgcn_kernarg_segment_ptr(); KArgs p = (KArgs)p0; asm volatile("" : "+s"(p)); return p;
#else
    return nullptr;
#endif
}
constexpr int NPHASE = 12;
__global__ void __launch_bounds__(NTHR, 2) fwd_kernel(Args args) {
    extern __shared__ __attribute__((aligned(16))) unsigned char lds_raw[];
    LAS unsigned char* lds = (LAS unsigned char*)lds_raw;
    const int lo = args.ph_lo, hi = args.ph_hi;
#define IN(k) (lo <= (k) && (k) < hi)
#define SEAM(k) do { if (IN(k) && IN((k) + 1)) { if ((k) == 0) cg::this_grid().sync(); else grid_barrier((unsigned*)kargs()->ws); } } while (0)
#define PH KArgs ka = kargs(); unsigned char* ws = ka->ws; bf16_t* Z = (bf16_t*)(ws + WS_Z); bf16_t* H = (bf16_t*)(ws + WS_H); const int G = gridDim.x, bx = blockIdx.x; (void)Z; (void)H; (void)G; (void)bx;
#define WV const int lane = threadIdx.x & 63, wave = __builtin_amdgcn_readfirstlane(threadIdx.x >> 6);
    typedef pg8::StaticOrder SO;
    typedef PanelOrder PO;
    if (IN(0)) { PH WV prologue(ka, lds, bx * NWAVES + wave, G * NWAVES, wave, lane); __syncthreads(); }
    SEAM(0);
    if (IN(1)) { PH pg8::Gemm g{H, (const bf16_t*)(ws + WS_WIN), M, NIN, DM, DM}; SO S; S.init(M, NIN, G, bx); EpiZ E{Z};
        pg8::gemm_phase<EpiZ, SO, true, true>(lds, g, S, E); }
    SEAM(1);
    if (IN(2)) { PH mixerB_unit(lds, ((((bx >> 4) << 3) | (bx & 7)) << 1) | ((bx >> 3) & 1), Z, (bf16_t*)ka->out + (size_t)M * DM, (const bf16_t*)(ws + WS_LRT), (const float*)(ws + WS_BIASP), ka->in[9], ka->in[10]); }
    if (IN(3)) { PH for (int u = bx; u < M / 128; u += G) mixerA_unit(lds, u, Z, (bf16_t*)ka->out, (const bf16_t*)(ws + WS_WSB), ka->in[5], ka->in[6], ka->in[8]); }
    SEAM(3);
    if (IN(4)) { PH
        { SO S; S.init(M, DM, G, bx); pg8::Gemm g{(const bf16_t*)ka->out, (const bf16_t*)(ws + WS_WA), M, DM, DM, DM}; EpiGate<false> E{Z + ZSEC, Z + 4 * ZSEC, ZLD}; pg8::gemm_phase<EpiGate<false>, SO, true, true>(lds, g, S, E); }
        __syncthreads();
        { SO S; S.init(M, DM, G, bx); pg8::Gemm g{(const bf16_t*)ka->out + (size_t)M * DM, (const bf16_t*)(ws + WS_WB), M, DM, DM, DM}; EpiGate<true> E{Z + ZSEC, Z + 5 * ZSEC, ZLD}; pg8::gemm_phase<EpiGate<true>, SO, true, true>(lds, g, S, E); }
        __syncthreads();
    }
    SEAM(4);
    if (IN(5)) { PH PO S; S.init(DM, bx); pg8::Gemm g{Z + ZSEC, (const bf16_t*)(ws + WS_WO), M, DM, DM, ZLD}; EpiPlain E{Z + 2 * ZSEC, ZLD}; pg8::gemm_phase<EpiPlain, PO, true, true>(lds, g, S, E); __syncthreads(); }
    if (IN(6)) { PH WV norm_pass<false, true>((const unsigned char*)(ka->in[0] + (size_t)bx * 256 * DM), (size_t)DM * 4, Z + 2 * ZSEC + (size_t)bx * 256 * ZLD, ZLD, ka->in[3], (unsigned char*)ka->out + ((size_t)bx << 20), (size_t)DM * 2, ka->in[19], H + (size_t)bx * 256 * DM, wave, lane); }
    SEAM(6);
    if (IN(7)) { PH pg8::Gemm g{H, (const bf16_t*)(ws + WS_WGU), M, NGU, DM, DM}; SO S; S.init(M, NGU, G, bx); EpiSwiglu E{(bf16_t*)(ws + WS_ACT)};
        pg8::gemm_phase<EpiSwiglu, SO, true, true>(lds, g, S, E); }
    SEAM(7);
    if (IN(8)) { PH pg8::Gemm g{(const bf16_t*)(ws + WS_ACT), (const bf16_t*)(ws + WS_WDN), M, DM, DFF, DFF}; SO S; S.init(M, DM, G, bx); EpiPlain E{(bf16_t*)(ws + WS_F), DM};
        pg8::gemm_phase<EpiPlain, SO, true, true>(lds, g, S, E); }
    SEAM(8);
    if (IN(9)) { PH WV bf16_t* F = (bf16_t*)(ws + WS_F) + (size_t)bx * 256 * DM; norm_pass<true, true>((const unsigned char*)ka->out + ((size_t)bx << 20), (size_t)DM * 2, F, DM, ka->in[20], (unsigned char*)F, (size_t)DM * 2, ka->in[24], H + (size_t)bx * 256 * DM, wave, lane); __syncthreads(); }
    if (IN(10)) { PH
        { PO S; S.init(DM, bx); pg8::Gemm g{(const bf16_t*)(ws + WS_PB), (const bf16_t*)(ws + WS_WPIN), M, DM, PLE, PLE}; EpiPlain E{(bf16_t*)(ws + WS_GE), DM}; pg8::gemm_phase<EpiPlain, PO, true, true>(lds, g, S, E); }
        __syncthreads();
        { PO S; S.init(DM, bx); pg8::Gemm g{H, (const bf16_t*)(ws + WS_WPG), M, DM, DM, DM}; EpiSigMul E{(bf16_t*)(ws + WS_GE)}; pg8::gemm_phase<EpiSigMul, PO, true, true>(lds, g, S, E); }
        __syncthreads();
    }
    if (IN(11)) { PH WV norm_pass<true, false>((const unsigned char*)(ws + WS_F) + (size_t)bx * 256 * DM * 2, (size_t)DM * 2, (const bf16_t*)(ws + WS_GE) + (size_t)bx * 256 * DM, DM, ka->in[25], (unsigned char*)(ka->out + (size_t)bx * 256 * DM), (size_t)DM * 4, nullptr, nullptr, wave, lane); }
#undef PH
#undef WV
#undef IN
#undef SEAM
}

extern "C" void kernel_launch(void* const* d_in, const int* in_sizes, int n_in, void* d_out, int out_size, void* d_ws, size_t ws_size, hipStream_t stream) {
    static int grid = 0;
    if (grid == 0) {
        if (n_in != 28 || in_sizes[0] != M * DM || out_size != M * DM || ws_size < WS_END) { fprintf(stderr, "kernel_launch: unexpected shapes (n_in %d, in0 %d, out %d, ws %zu)\n", n_in, n_in > 0 ? in_sizes[0] : -1, out_size, ws_size); grid = -1; return; }
        int dev = 0, cus = 0, per_cu = 0;
        if (hipGetDevice(&dev) != hipSuccess || hipDeviceGetAttribute(&cus, hipDeviceAttributeMultiprocessorCount, dev) != hipSuccess) { grid = -1; return; }
        if (hipFuncSetAttribute((const void*)fwd_kernel, hipFuncAttributeMaxDynamicSharedMemorySize, LDS_BYTES) != hipSuccess) { fprintf(stderr, "kernel_launch: hipFuncSetAttribute failed\n"); grid = -1; return; }
        if (hipOccupancyMaxActiveBlocksPerMultiprocessor(&per_cu, (const void*)fwd_kernel, NTHR, LDS_BYTES) != hipSuccess || per_cu < 1) { fprintf(stderr, "kernel_launch: occupancy query says %d\n", per_cu); per_cu = 1; }
        (void)hipGetLastError();
        grid = cus * 1;
        if (grid != M / 256) { fprintf(stderr, "kernel_launch: built for a 256-CU device (one workgroup per 256-row panel); got %d CUs\n", cus); grid = -1; return; }
    }
    if (grid < 0) return;
    if (hipMemsetAsync(d_ws, 0, 256, stream) != hipSuccess) { fprintf(stderr, "kernel_launch: memset failed\n"); return; }
    Args a{};
    for (int i = 0; i < 28; ++i) a.in[i] = (const float*)d_in[i];
    a.out = (float*)d_out; a.ws = (unsigned char*)d_ws;
#if MK_ONE
    a.ph_lo = 0; a.ph_hi = NPHASE;
    void* kargs[] = {&a};
    hipError_t e = hipLaunchCooperativeKernel((const void*)fwd_kernel, dim3(grid), dim3(NTHR), kargs, LDS_BYTES, stream);
    if (e != hipSuccess) fprintf(stderr, "kernel_launch: cooperative launch failed: %s (grid %d)\n", hipGetErrorString(e), grid);
#else
    for (int k = 0; k < NPHASE; ++k) for (int rep = 0; rep < 1 + ((REP_MASK >> k) & 1); ++rep) { a.ph_lo = k; a.ph_hi = k + 1; hipLaunchKernelGGL(fwd_kernel, dim3(grid), dim3(NTHR), LDS_BYTES, stream, a); }
#endif
}
```

```cpp
#include <hip/hip_runtime.h>
#include <hip/hip_cooperative_groups.h>
#include <cstdio>
#include <cstdint>
namespace cg = cooperative_groups;
#ifndef REP_MASK
#define REP_MASK 0
#endif
#ifndef MK_ONE
#define MK_ONE 1
#endif
namespace pg8 {
#define PG8_LAS __attribute__((address_space(3)))
typedef unsigned short bf16_t;
typedef short bf16x8 __attribute__((ext_vector_type(8)));
typedef float f32x4 __attribute__((ext_vector_type(4)));
typedef unsigned u32x4 __attribute__((ext_vector_type(4)));
constexpr int BM = 256, BK = 64, HALF = 128, HTB = HALF * BK * 2  , STAGE_BYTES = 8 * HTB, NXCD = 8, WGM = 8;

__host__ __device__ __forceinline__ int lds_byte(int r, int c) { const int st = (r >> 4) * 2 + (c >> 5), rr = r & 15, cc = c & 31, ob = rr * 64 + cc * 2; return st * 1024 + (ob ^ (((ob >> 9) & 1) << 5)); }
__host__ __device__ __forceinline__ void stage_rc(int b, int& R, int& C) { const int st = b / 1024, sb = b % 1024, swz = sb ^ (((sb >> 9) & 1) << 5); R = (st >> 1) * 16 + swz / 64; C = (st & 1) * 32 + (swz % 64) / 2; }
__host__ __device__ __forceinline__ int perm32(int rho) { const int n = rho >> 4, i = rho & 15; return 8 * (i >> 2) + 4 * n + (i & 3); }

struct Unit { int pm, pn; };
struct Gemm { const bf16_t* A; const bf16_t* Bt; int M, N, K, lda; };

struct StaticOrder {
    int nM, nN, nwg, G, c;
    __host__ __device__ void init(int M, int N, int G_, int c_) { nM = M / BM; nN = N / BM; nwg = nM * nN; G = G_; c = c_; }
    __host__ __device__ bool next(int i, Unit& u) const {
        const long L = (long)i * G + c; if (L >= nwg) return false;
        int wgid = (int)L; { const int q = nwg / NXCD, r = nwg % NXCD, xcd = wgid % NXCD, off = wgid / NXCD; wgid = (xcd < r ? xcd * (q + 1) : r * (q + 1) + (xcd - r) * q) + off; }
        const int nig = WGM * nN, gid = wgid / nig, fm = gid * WGM, gsz = (nM - fm) < WGM ? (nM - fm) : WGM;
        u.pm = fm + ((wgid % nig) % gsz); u.pn = (wgid % nig) / gsz; return true;
    }
    __device__ __forceinline__ void a_ready(const Unit&) const {}
    __device__ __forceinline__ void done(const Unit&) const {}
};

__device__ __forceinline__ unsigned cvt_pk_bf16(float lo, float hi) { unsigned r; asm volatile("v_cvt_pk_bf16_f32 %0, %1, %2" : "=v"(r) : "v"(lo), "v"(hi)); return r; }
typedef float f32x2 __attribute__((ext_vector_type(2)));
template <class Epi, class Sched, bool ALIGN_EPI = false, bool SP2 = false>
__device__ __forceinline__ void gemm_phase(PG8_LAS unsigned char* lds, const Gemm g, const Sched& S, const Epi& E) {
    const int tid = threadIdx.x, wid = __builtin_amdgcn_readfirstlane(tid >> 6), lane = tid & 63, wr = wid >> 2, wc = wid & 3, fr = lane & 15, fq = lane >> 4;
    const int K = g.K, nt = K / BK;
    unsigned voffA[2], voffB[2];
#pragma unroll
    for (int i = 0; i < 2; ++i) { int R, C; stage_rc(tid * 16 + i * 8192, R, C); const int Rb = Epi::PERM ? ((R & ~31) + perm32(R & 31)) : R;
        voffA[i] = (unsigned)(R * g.lda + C) * 2u; voffB[i] = (unsigned)(Rb * K + C) * 2u; }
    const size_t kstep = (size_t)(BK * 2);
    const size_t hstepA = (size_t)HALF * g.lda * 2, hstepB = (size_t)HALF * K * 2;
    const size_t tstepA = 2 * hstepA, tstepB = 2 * hstepB;
    const unsigned ldsw = (unsigned)wid * 1024u;
    const int aoff = lds_byte(wr * 64 + fr, fq * 8), boff = lds_byte(wc * 32 + fr, fq * 8);
#define PG8_SA(b, h) (((b) * 2 + (h)) * HTB)
#define PG8_SB(b, h) ((4 + (b) * 2 + (h)) * HTB)
#define PG8_STAGE(bufoff, gbase, voff) do { _Pragma("unroll") for (int _i = 0; _i < 2; ++_i) \
        __builtin_amdgcn_global_load_lds((const unsigned*)((const char*)(gbase) + (voff)[_i]), (PG8_LAS unsigned*)(lds + (bufoff) + ldsw + _i * 8192), 16, 0, 0); } while (0)
#define PG8_LDA(dst, b, h) do { _Pragma("unroll") for (int m = 0; m < 4; ++m) _Pragma("unroll") for (int k = 0; k < 2; ++k) dst[m][k] = *(const PG8_LAS bf16x8*)(lds + PG8_SA(b, h) + aoff + m * 2048 + k * 1024); } while (0)
#define PG8_LDB(dst, b, h) do { _Pragma("unroll") for (int n = 0; n < 2; ++n) _Pragma("unroll") for (int k = 0; k < 2; ++k) dst[n][k] = *(const PG8_LAS bf16x8*)(lds + PG8_SB(b, h) + boff + n * 2048 + k * 1024); } while (0)
#define PG8_MMA(ai, bj, At, Bt) do { __builtin_amdgcn_s_setprio(1); _Pragma("unroll") for (int m = 0; m < 4; ++m) _Pragma("unroll") for (int n = 0; n < 2; ++n) _Pragma("unroll") for (int k = 0; k < 2; ++k) \
        acc[ai][bj][m][n] = __builtin_amdgcn_mfma_f32_16x16x32_bf16(Bt[n][k], At[m][k], acc[ai][bj][m][n], 0, 0, 0); __builtin_amdgcn_s_setprio(0); } while (0)
#define PG8_WAIT_V(n) asm volatile("s_waitcnt vmcnt(" #n ")" ::: "memory")
#define PG8_WAIT_L(n) asm volatile("s_waitcnt lgkmcnt(" #n ")" ::: "memory")
#define PG8_BAR __builtin_amdgcn_s_barrier()
#define PG8_SCHED __builtin_amdgcn_sched_barrier(0)
    Unit cur, nxt; int ui = 0;
    if (!S.next(0, cur)) return;
    f32x4 acc[2][2][4][2];
#pragma unroll
    for (int a = 0; a < 2; ++a)
#pragma unroll
        for (int b = 0; b < 2; ++b)
#pragma unroll
            for (int m = 0; m < 4; ++m)
#pragma unroll
                for (int n = 0; n < 2; ++n) acc[a][b][m][n] = (f32x4){0.f, 0.f, 0.f, 0.f};
    bf16x8 At[4][2], B0[2][2], B1[2][2];
    const char* cA = (const char*)g.A + (size_t)cur.pm * tstepA; const char* cB = (const char*)g.Bt + (size_t)cur.pn * tstepB;
    S.a_ready(cur);
    if constexpr (SP2) {
        PG8_STAGE(PG8_SB(0, 0), cB, voffB); PG8_STAGE(PG8_SB(0, 1), cB + hstepB, voffB); PG8_STAGE(PG8_SA(0, 0), cA, voffA); PG8_STAGE(PG8_SA(0, 1), cA + hstepA, voffA);
        if (wr == 1) PG8_BAR;
        PG8_WAIT_V(2); PG8_BAR;
        PG8_STAGE(PG8_SB(1, 0), cB + kstep, voffB); PG8_STAGE(PG8_SA(1, 0), cA + kstep, voffA); PG8_STAGE(PG8_SB(1, 1), cB + hstepB + kstep, voffB);
        PG8_WAIT_V(6); PG8_BAR;
    } else {
        PG8_STAGE(PG8_SB(0, 0), cB, voffB); PG8_STAGE(PG8_SA(0, 0), cA, voffA); PG8_STAGE(PG8_SB(0, 1), cB + hstepB, voffB); PG8_STAGE(PG8_SA(0, 1), cA + hstepA, voffA);
        if (wr == 1) PG8_BAR;
        PG8_WAIT_V(4); PG8_BAR;
        PG8_STAGE(PG8_SB(1, 0), cB + kstep, voffB); PG8_STAGE(PG8_SA(1, 0), cA + kstep, voffA); PG8_STAGE(PG8_SB(1, 1), cB + hstepB + kstep, voffB);
        PG8_WAIT_V(6); PG8_BAR;
    }
    for (;;) {
        const bool has_next = S.next(ui + 1, nxt);
        const char* nA = has_next ? (const char*)g.A + (size_t)nxt.pm * tstepA : cA; const char* nB = has_next ? (const char*)g.Bt + (size_t)nxt.pn * tstepB : cB;
        for (int t = 0; t < nt; t += 2) {
            const bool last = (t == nt - 2);
            const char* a1 = cA + (size_t)(t + 1) * kstep;
            const char* a2 = last ? nA : cA + (size_t)(t + 2) * kstep; const char* b2 = last ? nB : cB + (size_t)(t + 2) * kstep;
            const char* a3 = a2 + kstep; const char* b3 = b2 + kstep;
            if (last && has_next) S.a_ready(nxt);
            if constexpr (SP2) {
            PG8_LDB(B0, 0, 0); PG8_LDB(B1, 0, 1); PG8_SCHED; PG8_LDA(At, 0, 0); PG8_STAGE(PG8_SA(1, 1), a1 + hstepA, voffA);
            PG8_WAIT_V(8); PG8_WAIT_L(0); PG8_BAR; PG8_MMA(0, 0, At, B0); PG8_MMA(0, 1, At, B1); PG8_BAR; PG8_SCHED;
            PG8_LDA(At, 0, 1); PG8_STAGE(PG8_SB(0, 0), b2, voffB); PG8_STAGE(PG8_SB(0, 1), b2 + hstepB, voffB); PG8_STAGE(PG8_SA(0, 0), a2, voffA);
            PG8_WAIT_V(8); PG8_WAIT_L(0); PG8_BAR; PG8_MMA(1, 0, At, B0); PG8_MMA(1, 1, At, B1); PG8_BAR; PG8_SCHED;
            PG8_LDB(B0, 1, 0); PG8_LDB(B1, 1, 1); PG8_SCHED; PG8_LDA(At, 1, 0); PG8_STAGE(PG8_SA(0, 1), a2 + hstepA, voffA);
            PG8_WAIT_V(8); PG8_WAIT_L(0); PG8_BAR; PG8_MMA(0, 0, At, B0); PG8_MMA(0, 1, At, B1); PG8_BAR; PG8_SCHED;
            PG8_LDA(At, 1, 1); PG8_STAGE(PG8_SB(1, 0), b3, voffB); PG8_STAGE(PG8_SB(1, 1), b3 + hstepB, voffB); PG8_STAGE(PG8_SA(1, 0), a3, voffA);
            PG8_WAIT_V(8); PG8_WAIT_L(0); PG8_BAR; PG8_MMA(1, 0, At, B0); PG8_MMA(1, 1, At, B1); PG8_BAR; PG8_SCHED;
            } else {
            PG8_LDB(B0, 0, 0); PG8_SCHED; PG8_LDA(At, 0, 0); PG8_STAGE(PG8_SA(1, 1), a1 + hstepA, voffA);
            PG8_WAIT_L(8); PG8_BAR; PG8_WAIT_L(0); PG8_MMA(0, 0, At, B0); PG8_BAR; PG8_SCHED;
            PG8_LDB(B1, 0, 1); PG8_STAGE(PG8_SB(0, 0), b2, voffB);
            PG8_BAR; PG8_WAIT_L(0); PG8_MMA(0, 1, At, B1); PG8_BAR;
            PG8_LDA(At, 0, 1); PG8_STAGE(PG8_SA(0, 0), a2, voffA);
            PG8_BAR; PG8_WAIT_L(0); PG8_MMA(1, 0, At, B0); PG8_BAR; PG8_SCHED;
            PG8_STAGE(PG8_SB(0, 1), b2 + hstepB, voffB);
            PG8_WAIT_V(6); PG8_BAR; PG8_MMA(1, 1, At, B1); PG8_BAR;
            PG8_LDB(B0, 1, 0); PG8_SCHED; PG8_LDA(At, 1, 0); PG8_STAGE(PG8_SA(0, 1), a2 + hstepA, voffA);
            PG8_WAIT_L(8); PG8_BAR; PG8_WAIT_L(0); PG8_MMA(0, 0, At, B0); PG8_BAR; PG8_SCHED;
            PG8_LDB(B1, 1, 1); PG8_STAGE(PG8_SB(1, 0), b3, voffB);
            PG8_BAR; PG8_WAIT_L(0); PG8_MMA(0, 1, At, B1); PG8_BAR;
            PG8_LDA(At, 1, 1); PG8_STAGE(PG8_SA(1, 0), a3, voffA);
            PG8_BAR; PG8_WAIT_L(0); PG8_MMA(1, 0, At, B0); PG8_BAR; PG8_SCHED;
            PG8_STAGE(PG8_SB(1, 1), b3 + hstepB, voffB);
            PG8_WAIT_V(6); PG8_BAR; PG8_MMA(1, 1, At, B1); PG8_BAR;
            }
        }
        if constexpr (ALIGN_EPI) { if (wr == 0) PG8_BAR; }
        if constexpr (!Epi::AFTER_DRAIN) { E(acc, cur, wr, wc, fr, fq); S.done(cur); }
        if (!has_next) break;
#pragma unroll
        for (int a = 0; a < 2; ++a)
#pragma unroll
            for (int b = 0; b < 2; ++b)
#pragma unroll
                for (int m = 0; m < 4; ++m)
#pragma unroll
                    for (int n = 0; n < 2; ++n) acc[a][b][m][n] = (f32x4){0.f, 0.f, 0.f, 0.f};
        cur = nxt; cA = nA; cB = nB; ++ui;
        if constexpr (ALIGN_EPI) { if (wr == 1) PG8_BAR; }
    }
    PG8_WAIT_V(0);
    if constexpr (!ALIGN_EPI) { if (wr == 0) PG8_BAR; }
    PG8_BAR;
    if constexpr (Epi::AFTER_DRAIN) { E.fused(acc, cur, wr, wc, fr, fq, lds, wid, lane); S.done(cur); }
#undef PG8_SA
#undef PG8_SB
#undef PG8_STAGE
#undef PG8_LDA
#undef PG8_LDB
#undef PG8_MMA
#undef PG8_WAIT_V
#undef PG8_WAIT_L
#undef PG8_BAR
#undef PG8_SCHED
}
}
using pg8::bf16_t; using pg8::bf16x8; using pg8::f32x4; using pg8::u32x4; using pg8::Unit; using pg8::cvt_pk_bf16;
#define LAS __attribute__((address_space(3)))
typedef unsigned u32x2 __attribute__((ext_vector_type(2)));

constexpr int DM = 1024, BATCH = 8, SEQ = 8192, M = BATCH * SEQ, NIN = 6144, DFF = 2816, NGU = 2 * DFF, PLE = 256, ZLD = 1024;
constexpr size_t ZSEC = (size_t)M * 1024;
constexpr float EPS = 1e-6f;
constexpr size_t MiB = 1u << 20;
constexpr size_t WS_WIN = 1 * MiB, WS_WA = 13 * MiB, WS_WB = 15 * MiB, WS_WO = 17 * MiB, WS_WPG = 19 * MiB, WS_WGU = 21 * MiB, WS_WDN = 32 * MiB, WS_WPIN = 38 * MiB;
constexpr size_t WS_WSB = 38 * MiB + 512 * 1024, WS_BIASP = 38 * MiB + 768 * 1024, WS_LRT = 39 * MiB;
constexpr size_t WS_PB = 40 * MiB, WS_H = 72 * MiB, WS_Z = 200 * MiB, WS_ACT = 200 * MiB, WS_F = 552 * MiB, WS_GE = 680 * MiB, WS_END = 968 * MiB;
constexpr int NWAVES = 8, NTHR = 512, LDS_BYTES = 147456;

__device__ __forceinline__ float bf_lo(unsigned w) { return __builtin_bit_cast(float, w << 16); }
__device__ __forceinline__ float bf_hi(unsigned w) { return __builtin_bit_cast(float, w & 0xffff0000u); }
__device__ __forceinline__ float bf1(unsigned short h) { return __builtin_bit_cast(float, ((unsigned)h) << 16); }
__device__ __forceinline__ unsigned short f2bf(float f) { unsigned u = __builtin_bit_cast(unsigned, f); return (unsigned short)((u + 0x7fffu + ((u >> 16) & 1u)) >> 16); }
__device__ __forceinline__ float fsigmoid(float x) { return __builtin_amdgcn_rcpf(1.0f + __builtin_amdgcn_exp2f(-1.4426950408889634f * x)); }
__device__ __forceinline__ float fgelu(float x) { const float u = x * (0.7978845608028654f + 0.035677408136300125f * x * x); return x * __builtin_amdgcn_rcpf(1.0f + __builtin_amdgcn_exp2f(-2.8853900817779268f * u)); }
__device__ __forceinline__ f32x4 fgelu4(f32x4 x) { const f32x4 t = x * (x * x * 0.035677408136300125f + 0.7978845608028654f) * (-2.8853900817779268f);
    f32x4 e; e[0] = __builtin_amdgcn_exp2f(t[0]); e[1] = __builtin_amdgcn_exp2f(t[1]); e[2] = __builtin_amdgcn_exp2f(t[2]); e[3] = __builtin_amdgcn_exp2f(t[3]);
    const f32x4 d = e + 1.0f; f32x4 r; r[0] = __builtin_amdgcn_rcpf(d[0]); r[1] = __builtin_amdgcn_rcpf(d[1]); r[2] = __builtin_amdgcn_rcpf(d[2]); r[3] = __builtin_amdgcn_rcpf(d[3]); return x * r; }
__device__ __forceinline__ f32x4 fsigmoid4(f32x4 x) { const f32x4 t = x * (-1.4426950408889634f);
    f32x4 e; e[0] = __builtin_amdgcn_exp2f(t[0]); e[1] = __builtin_amdgcn_exp2f(t[1]); e[2] = __builtin_amdgcn_exp2f(t[2]); e[3] = __builtin_amdgcn_exp2f(t[3]);
    const f32x4 d = e + 1.0f; f32x4 r; r[0] = __builtin_amdgcn_rcpf(d[0]); r[1] = __builtin_amdgcn_rcpf(d[1]); r[2] = __builtin_amdgcn_rcpf(d[2]); r[3] = __builtin_amdgcn_rcpf(d[3]); return r; }
__device__ __forceinline__ float wave_sum(float v) {
#pragma unroll
    for (int o = 1; o < 64; o <<= 1) v += __shfl_xor(v, o);
    return v;
}

#define EPI_LOOP_BEGIN \
    const int row0 = u.pm * 256 + wr * 64 + fr, col0 = u.pn * 256 + wc * 32 + 8 * fq; \
    _Pragma("unroll") for (int ai = 0; ai < 2; ++ai) _Pragma("unroll") for (int m = 0; m < 4; ++m) { const size_t row = (size_t)(row0 + ai * 128 + m * 16); \
    _Pragma("unroll") for (int bj = 0; bj < 2; ++bj) { const int col = col0 + bj * 128; f32x4 v0 = acc[ai][bj][m][0], v1 = acc[ai][bj][m][1];
#define EPI_LOOP_END } }
__device__ __forceinline__ u32x4 pack8(f32x4 v0, f32x4 v1) { u32x4 w; w.x = cvt_pk_bf16(v0[0], v0[1]); w.y = cvt_pk_bf16(v0[2], v0[3]); w.z = cvt_pk_bf16(v1[0], v1[1]); w.w = cvt_pk_bf16(v1[2], v1[3]); return w; }

struct EpiZ {
    static constexpr bool PERM = true, AFTER_DRAIN = false; bf16_t* Z;
    __device__ __forceinline__ void operator()(const f32x4 (&acc)[2][2][4][2], const Unit& u, int wr, int wc, int fr, int fq) const {
        const int sec = u.pn >> 2; const int mode = (sec == 2) ? 0 : (sec >= 4 ? 2 : 1); bf16_t* Zs = Z + (size_t)sec * ZSEC;
        EPI_LOOP_BEGIN
            if (mode == 1) { v0 = fgelu4(v0); v1 = fgelu4(v1); }
            else if (mode == 2) { v0 = fsigmoid4(v0); v1 = fsigmoid4(v1); }
            *(u32x4*)(Zs + row * ZLD + (col & 1023)) = pack8(v0, v1);
        EPI_LOOP_END
    }
};
struct EpiPlain {
    static constexpr bool PERM = true, AFTER_DRAIN = false; bf16_t* O; int ldc;
    __device__ __forceinline__ void operator()(const f32x4 (&acc)[2][2][4][2], const Unit& u, int wr, int wc, int fr, int fq) const {
        EPI_LOOP_BEGIN
            *(u32x4*)(O + row * ldc + col) = pack8(v0, v1);
        EPI_LOOP_END
    }
};
__device__ __forceinline__ void mul8(f32x4& v0, f32x4& v1, const u32x4 w) { v0[0] *= bf_lo(w.x); v0[1] *= bf_hi(w.x); v0[2] *= bf_lo(w.y); v0[3] *= bf_hi(w.y); v1[0] *= bf_lo(w.z); v1[1] *= bf_hi(w.z); v1[2] *= bf_lo(w.w); v1[3] *= bf_hi(w.w); }
__device__ __forceinline__ void add8(f32x4& v0, f32x4& v1, const u32x4 w) { v0[0] += bf_lo(w.x); v0[1] += bf_hi(w.x); v0[2] += bf_lo(w.y); v0[3] += bf_hi(w.y); v1[0] += bf_lo(w.z); v1[1] += bf_hi(w.z); v1[2] += bf_lo(w.w); v1[3] += bf_hi(w.w); }
template <bool ADD> struct EpiGate {
    static constexpr bool PERM = true, AFTER_DRAIN = false; bf16_t* O; const bf16_t* G; int ld;
    __device__ __forceinline__ void operator()(const f32x4 (&acc)[2][2][4][2], const Unit& u, int wr, int wc, int fr, int fq) const {
        const int row0 = u.pm * 256 + wr * 64 + fr, col0 = u.pn * 256 + wc * 32 + 8 * fq;
#pragma unroll
        for (int ai = 0; ai < 2; ++ai) {
            u32x4 gw[4][2], ow[4][2];
#pragma unroll
            for (int m = 0; m < 4; ++m)
#pragma unroll
                for (int bj = 0; bj < 2; ++bj) { const size_t off = (size_t)(row0 + ai * 128 + m * 16) * ld + col0 + bj * 128; gw[m][bj] = *(const u32x4*)(G + off); if (ADD) ow[m][bj] = *(const u32x4*)(O + off); }
#pragma unroll
            for (int m = 0; m < 4; ++m)
#pragma unroll
                for (int bj = 0; bj < 2; ++bj) { const size_t off = (size_t)(row0 + ai * 128 + m * 16) * ld + col0 + bj * 128; f32x4 v0 = acc[ai][bj][m][0], v1 = acc[ai][bj][m][1];
                    mul8(v0, v1, gw[m][bj]); if (ADD) add8(v0, v1, ow[m][bj]);
                    *(u32x4*)(O + off) = pack8(v0, v1); }
        }
    }
};
struct EpiSwiglu {
    static constexpr bool PERM = true, AFTER_DRAIN = false; bf16_t* O;
    __device__ __forceinline__ void operator()(const f32x4 (&acc)[2][2][4][2], const Unit& u, int wr, int wc, int fr, int fq) const {
        EPI_LOOP_BEGIN
            const int hid = u.pn * 128 + bj * 64 + wc * 16 + 4 * fq; (void)col;
            f32x4 o;
#pragma unroll
            for (int e = 0; e < 4; ++e) o[e] = v0[e] * fsigmoid(v0[e]) * v1[e];
            u32x2 w; w.x = cvt_pk_bf16(o[0], o[1]); w.y = cvt_pk_bf16(o[2], o[3]);
            *(u32x2*)(O + row * DFF + hid) = w;
        EPI_LOOP_END
    }
};
struct EpiSigMul {
    static constexpr bool PERM = true, AFTER_DRAIN = false; bf16_t* O;
    __device__ __forceinline__ void operator()(const f32x4 (&acc)[2][2][4][2], const Unit& u, int wr, int wc, int fr, int fq) const {
        const int row0 = u.pm * 256 + wr * 64 + fr, col0 = u.pn * 256 + wc * 32 + 8 * fq;
#pragma unroll
        for (int ai = 0; ai < 2; ++ai) {
            u32x4 ow[4][2];
#pragma unroll
            for (int m = 0; m < 4; ++m)
#pragma unroll
                for (int bj = 0; bj < 2; ++bj) ow[m][bj] = *(const u32x4*)(O + (size_t)(row0 + ai * 128 + m * 16) * DM + col0 + bj * 128);
#pragma unroll
            for (int m = 0; m < 4; ++m)
#pragma unroll
                for (int bj = 0; bj < 2; ++bj) { f32x4 v0 = acc[ai][bj][m][0], v1 = acc[ai][bj][m][1];
#pragma unroll
                    for (int e = 0; e < 4; ++e) { v0[e] = fsigmoid(v0[e]); v1[e] = fsigmoid(v1[e]); }
                    mul8(v0, v1, ow[m][bj]);
                    *(u32x4*)(O + (size_t)(row0 + ai * 128 + m * 16) * DM + col0 + bj * 128) = pack8(v0, v1); }
        }
    }
};

struct PanelOrder {
    int nN, pm;
    __device__ void init(int N, int pm_) { nN = N / 256; pm = pm_; }
    __device__ bool next(int i, Unit& u) const { if (i >= nN) return false; u.pm = pm; u.pn = i; return true; }
    __device__ __forceinline__ void a_ready(const Unit&) const {}
    __device__ __forceinline__ void done(const Unit&) const {}
};
template <int MODE> __device__ __forceinline__ void transpose_item(const float* W, int K, int N, bf16_t* WT, LAS float* scr, int item, int lane) {
    const int nblk = N / 32, kb = item / nblk, nb = item % nblk, k0 = 64 * kb, n0 = 32 * nb;
    float tv[32];
#pragma unroll
    for (int i = 0; i < 32; ++i) tv[i] = W[(size_t)(k0 + 2 * i + (lane >> 5)) * N + n0 + (lane & 31)];
#pragma unroll
    for (int i = 0; i < 32; ++i) scr[(2 * i + (lane >> 5)) * 33 + (lane & 31)] = tv[i];
    asm volatile("s_waitcnt lgkmcnt(0)" ::: "memory");
    const int c = lane & 7;
#pragma unroll
    for (int j = 0; j < 4; ++j) { const int n = (lane >> 3) + 8 * j; const LAS float* s = scr + (8 * c) * 33 + n;
        u32x4 o; o.x = cvt_pk_bf16(s[0 * 33], s[1 * 33]); o.y = cvt_pk_bf16(s[2 * 33], s[3 * 33]); o.z = cvt_pk_bf16(s[4 * 33], s[5 * 33]); o.w = cvt_pk_bf16(s[6 * 33], s[7 * 33]);
        const int ng = n0 + n; const int drow = (MODE == 0) ? ng : (256 * (ng >> 7) + 8 * ((ng & 127) >> 2) + (ng & 3) + 4 * (MODE - 1));
        *(u32x4*)(WT + (size_t)drow * K + k0 + 8 * c) = o; }
    asm volatile("s_waitcnt lgkmcnt(0)" ::: "memory");
}

struct Args { const float* in[28]; float* out; unsigned char* ws; int ph_lo, ph_hi; };

__device__ __forceinline__ void prologue(const __attribute__((address_space(4))) Args* ap, LAS unsigned char* lds, int gw, int NGW, int wave, int lane) {
    Args a;
    for (int i = 0; i < 28; ++i) a.in[i] = ap->in[i];
    a.out = ap->out; a.ws = ap->ws;
    unsigned char* ws = a.ws;
    LAS float* scr = (LAS float*)(lds + wave * 16384);
    constexpr int I_IN = 16 * (NIN / 32), I_SQ = 16 * 32, I_GU = 16 * (DFF / 32), I_DN = (DFF / 64) * 32, I_PI = 4 * 32;
    constexpr int NITEMS = I_IN + 4 * I_SQ + 2 * I_GU + I_DN + I_PI;
    for (int it = gw; it < NITEMS; it += NGW) {
        int r = it;
        if (r < I_IN) { transpose_item<0>(a.in[4], DM, NIN, (bf16_t*)(ws + WS_WIN), scr, r, lane); continue; } r -= I_IN;
        if (r < I_SQ) { transpose_item<0>(a.in[16], DM, DM, (bf16_t*)(ws + WS_WA), scr, r, lane); continue; } r -= I_SQ;
        if (r < I_SQ) { transpose_item<0>(a.in[17], DM, DM, (bf16_t*)(ws + WS_WB), scr, r, lane); continue; } r -= I_SQ;
        if (r < I_SQ) { transpose_item<0>(a.in[18], DM, DM, (bf16_t*)(ws + WS_WO), scr, r, lane); continue; } r -= I_SQ;
        if (r < I_SQ) { transpose_item<0>(a.in[27], DM, DM, (bf16_t*)(ws + WS_WPG), scr, r, lane); continue; } r -= I_SQ;
        if (r < I_GU) { transpose_item<1>(a.in[21], DM, DFF, (bf16_t*)(ws + WS_WGU), scr, r, lane); continue; } r -= I_GU;
        if (r < I_GU) { transpose_item<2>(a.in[22], DM, DFF, (bf16_t*)(ws + WS_WGU), scr, r, lane); continue; } r -= I_GU;
        if (r < I_DN) { transpose_item<0>(a.in[23], DFF, DM, (bf16_t*)(ws + WS_WDN), scr, r, lane); continue; } r -= I_DN;
        transpose_item<0>(a.in[26], PLE, DM, (bf16_t*)(ws + WS_WPIN), scr, r, lane);
    }
    const int gt = gw * 64 + lane, NGT = NGW * 64;
    { const float* wsrc = a.in[7]; bf16_t* d = (bf16_t*)(ws + WS_WSB);
      for (int e = gt; e < 8 * 128 * 128; e += NGT) { const int i = (e >> 7) & 127, j = e & 127; d[e] = ((j >> 6) <= (i >> 6)) ? f2bf(wsrc[e]) : (bf16_t)0; } }
    { bf16_t* d = (bf16_t*)(ws + WS_LRT); const float* cw = a.in[9];
      for (int e = gt; e < 2 * 16 * 4 * 64 * 64; e += NGT) { const int c = e & 63, j = (e >> 6) & 63, k = (e >> 12) & 3, hd = (e >> 14) & 15, which = e >> 18;
          const float* src = which ? a.in[13] : a.in[11]; d[e] = f2bf(cw[k * DM + hd * 64 + c] * src[hd * 4096 + c * 64 + j]); } }
    { float* d = (float*)(ws + WS_BIASP); const float* cb = a.in[10];
      for (int e = gw; e < 2 * DM; e += NGW) { const int which = e >> 10, ch = e & 1023, hd = ch >> 6, j = ch & 63; const float* w = (which ? a.in[13] : a.in[11]) + hd * 4096 + j;
          const float part = wave_sum(cb[hd * 64 + lane] * w[lane * 64]);
          if (lane == 0) d[e] = (which ? a.in[14] : a.in[12])[ch] + part; }
      for (int e = gt; e < DM; e += NGT) d[2 * DM + e] = 8.0f * 1.4426950408889634f * log1pf(expf(-a.in[15][e])); }
    { const f32x4* src = (const f32x4*)a.in[1]; u32x2* d = (u32x2*)(ws + WS_PB);
      for (int e = gt; e < M * PLE / 4; e += 4 * NGT) { f32x4 v[4];
#pragma unroll
          for (int i = 0; i < 4; ++i) v[i] = src[e + i * NGT < M * PLE / 4 ? e + i * NGT : e];
#pragma unroll
          for (int i = 0; i < 4; ++i) if (e + i * NGT < M * PLE / 4) { u32x2 w; w.x = cvt_pk_bf16(v[i][0], v[i][1]); w.y = cvt_pk_bf16(v[i][2], v[i][3]); d[e + i * NGT] = w; } } }
    { const float* x = a.in[0]; const float* g = a.in[2]; bf16_t* H = (bf16_t*)(ws + WS_H);
      f32x4 nx[4], gq[4];
#pragma unroll
      for (int j = 0; j < 4; ++j) { gq[j] = *(const f32x4*)(g + 256 * j + 4 * lane); nx[j] = *(const f32x4*)(x + (size_t)gw * DM + 256 * j + 4 * lane); }
      for (int m = gw; m < M; m += NGW) {
          f32x4 v[4]; float ss = 0.f;
#pragma unroll
          for (int j = 0; j < 4; ++j) { v[j] = nx[j]; ss += (v[j][0] * v[j][0] + v[j][1] * v[j][1]) + (v[j][2] * v[j][2] + v[j][3] * v[j][3]); }
          { const int mn = m + NGW < M ? m + NGW : m;
#pragma unroll
              for (int j = 0; j < 4; ++j) nx[j] = *(const f32x4*)(x + (size_t)mn * DM + 256 * j + 4 * lane); }
          const float rs = rsqrtf(wave_sum(ss) * (1.f / DM) + EPS);
#pragma unroll
          for (int j = 0; j < 4; ++j) { const f32x4 gg = gq[j]; u32x2 w; w.x = cvt_pk_bf16(v[j][0] * rs * gg[0], v[j][1] * rs * gg[1]); w.y = cvt_pk_bf16(v[j][2] * rs * gg[2], v[j][3] * rs * gg[3]);
              *(u32x2*)(H + (size_t)m * DM + 256 * j + 4 * lane) = w; }
      } }
}

template <bool XIN_BF16, bool XOUT_BF16>
__device__ __forceinline__ void norm_pass(const unsigned char* xin, size_t xin_pitch, const bf16_t* y, int ldy, const float* g1, unsigned char* xo, size_t xo_pitch, const float* g2, bf16_t* hn, int wave, int lane) {
    u32x4 yq[2], xb[2]; f32x4 xf[2][2];
    f32x4 G1[2][2], G2[2][2];
#pragma unroll
    for (int j = 0; j < 2; ++j) { const int c0 = 512 * j + 8 * lane; G1[j][0] = *(const f32x4*)(g1 + c0); G1[j][1] = *(const f32x4*)(g1 + c0 + 4);
        if (g2) { G2[j][0] = *(const f32x4*)(g2 + c0); G2[j][1] = *(const f32x4*)(g2 + c0 + 4); } else { G2[j][0] = G1[j][0]; G2[j][1] = G1[j][1]; } }
#define NP_LOAD(r_) do { _Pragma("unroll") for (int j = 0; j < 2; ++j) { const int c0 = 512 * j + 8 * lane; yq[j] = *(const u32x4*)(y + (size_t)(r_) * ldy + c0); \
        if (XIN_BF16) xb[j] = *(const u32x4*)(xin + (size_t)(r_) * xin_pitch + 2 * c0); \
        else { xf[j][0] = *(const f32x4*)(xin + (size_t)(r_) * xin_pitch + 4 * c0); xf[j][1] = *(const f32x4*)(xin + (size_t)(r_) * xin_pitch + 4 * c0 + 16); } } } while (0)
    NP_LOAD(wave);
    for (int r = wave; r < 256; r += NWAVES) {
        float yv[16], xv[16]; float ss = 0.f;
#pragma unroll
        for (int j = 0; j < 2; ++j) { const u32x4 w = yq[j];
            yv[8 * j + 0] = bf_lo(w.x); yv[8 * j + 1] = bf_hi(w.x); yv[8 * j + 2] = bf_lo(w.y); yv[8 * j + 3] = bf_hi(w.y); yv[8 * j + 4] = bf_lo(w.z); yv[8 * j + 5] = bf_hi(w.z); yv[8 * j + 6] = bf_lo(w.w); yv[8 * j + 7] = bf_hi(w.w);
            if (XIN_BF16) { const u32x4 a = xb[j];
                xv[8 * j + 0] = bf_lo(a.x); xv[8 * j + 1] = bf_hi(a.x); xv[8 * j + 2] = bf_lo(a.y); xv[8 * j + 3] = bf_hi(a.y); xv[8 * j + 4] = bf_lo(a.z); xv[8 * j + 5] = bf_hi(a.z); xv[8 * j + 6] = bf_lo(a.w); xv[8 * j + 7] = bf_hi(a.w);
            } else {
#pragma unroll
                for (int e = 0; e < 4; ++e) { xv[8 * j + e] = xf[j][0][e]; xv[8 * j + 4 + e] = xf[j][1][e]; } } }
        NP_LOAD(r + NWAVES < 256 ? r + NWAVES : r);
#pragma unroll
        for (int e = 0; e < 16; ++e) ss += yv[e] * yv[e];
        const float rs = rsqrtf(wave_sum(ss) * (1.f / DM) + EPS);
        float s2 = 0.f;
#pragma unroll
        for (int j = 0; j < 2; ++j) { const int c0 = 512 * j + 8 * lane; const f32x4 ga = G1[j][0], gb = G1[j][1];
#pragma unroll
            for (int e = 0; e < 4; ++e) { xv[8 * j + e] += yv[8 * j + e] * rs * ga[e]; xv[8 * j + 4 + e] += yv[8 * j + 4 + e] * rs * gb[e]; }
            if (XOUT_BF16) { *(u32x4*)(xo + (size_t)r * xo_pitch + 2 * c0) = pack8((f32x4){xv[8 * j], xv[8 * j + 1], xv[8 * j + 2], xv[8 * j + 3]}, (f32x4){xv[8 * j + 4], xv[8 * j + 5], xv[8 * j + 6], xv[8 * j + 7]});
#pragma unroll
                for (int e = 0; e < 8; ++e) xv[8 * j + e] = bf1(f2bf(xv[8 * j + e]));
            } else { *(f32x4*)(xo + (size_t)r * xo_pitch + 4 * c0) = (f32x4){xv[8 * j], xv[8 * j + 1], xv[8 * j + 2], xv[8 * j + 3]};
                *(f32x4*)(xo + (size_t)r * xo_pitch + 4 * c0 + 16) = (f32x4){xv[8 * j + 4], xv[8 * j + 5], xv[8 * j + 6], xv[8 * j + 7]}; } }
        if (hn) {
#pragma unroll
            for (int e = 0; e < 16; ++e) s2 += xv[e] * xv[e];
            const float r2 = rsqrtf(wave_sum(s2) * (1.f / DM) + EPS);
#pragma unroll
            for (int j = 0; j < 2; ++j) { const int c0 = 512 * j + 8 * lane; const f32x4 ga = G2[j][0], gb = G2[j][1];
                f32x4 o0, o1;
#pragma unroll
                for (int e = 0; e < 4; ++e) { o0[e] = xv[8 * j + e] * r2 * ga[e]; o1[e] = xv[8 * j + 4 + e] * r2 * gb[e]; }
                *(u32x4*)(hn + (size_t)r * DM + c0) = pack8(o0, o1); }
        }
    }
#undef NP_LOAD
}
#define LDS_BARRIER() do { asm volatile("s_waitcnt lgkmcnt(0)" ::: "memory"); __builtin_amdgcn_s_barrier(); asm volatile("" ::: "memory"); } while (0)
typedef short s16x4 __attribute__((ext_vector_type(4)));
__device__ __forceinline__ void mixerA_unit(LAS unsigned char* lds, int blk, const bf16_t* Z, bf16_t* AO, const bf16_t* WSB, const float* ln_g, const float* ln_b, const float* b_s) {
    const int tid = threadIdx.x, wave = __builtin_amdgcn_readfirstlane(tid >> 6), lane = tid & 63, fr = lane & 15, fq = lane >> 4;
    LAS float* st = (LAS float*)lds;
    LAS bf16_t* Wl = (LAS bf16_t*)(lds + 1024);
    LAS bf16_t* Vn = Wl + 128 * 136;
    LAS float* bsl = (LAS float*)(Vn + 128 * 136);
    const size_t row0 = (size_t)blk * 128;
    const int cc = tid & 15;
    u32x4 wq[4], vq[4]; f32x4 lg0, lg1, lb0, lb1;
#define MA_PREFETCH(g) do { _Pragma("unroll") for (int it = 0; it < 4; ++it) { const int q = tid + 512 * it; wq[it] = *(const u32x4*)(WSB + (g) * 16384 + (q >> 4) * 128 + (q & 15) * 8); \
        vq[it] = *(const u32x4*)(Z + (row0 + (tid >> 4) + 32 * it) * ZLD + ZSEC + (g) * 128 + cc * 8); } \
        lg0 = *(const f32x4*)(ln_g + (g) * 128 + cc * 8); lg1 = *(const f32x4*)(ln_g + (g) * 128 + cc * 8 + 4); lb0 = *(const f32x4*)(ln_b + (g) * 128 + cc * 8); lb1 = *(const f32x4*)(ln_b + (g) * 128 + cc * 8 + 4); } while (0)
    MA_PREFETCH(0);
    u32x2 un[8];
#define MA_LOAD_U(g) do { _Pragma("unroll") for (int it = 0; it < 8; ++it) un[it] = *(const u32x2*)(Z + (row0 + 16 * it + fr) * ZLD + (g) * 128 + 16 * wave + 4 * fq); } while (0)
    MA_LOAD_U(0);
    bsl[tid] = b_s[tid]; bsl[512 + tid] = b_s[512 + tid];
#pragma unroll 8
    for (int rr = 0; rr < 16; ++rr) {
        const int r = 16 * wave + rr; const bf16_t* vp = Z + (row0 + r) * ZLD + ZSEC + lane * 16;
        const u32x4 w0 = *(const u32x4*)vp, w1 = *(const u32x4*)(vp + 8);
        float f[16] = {bf_lo(w0.x), bf_hi(w0.x), bf_lo(w0.y), bf_hi(w0.y), bf_lo(w0.z), bf_hi(w0.z), bf_lo(w0.w), bf_hi(w0.w), bf_lo(w1.x), bf_hi(w1.x), bf_lo(w1.y), bf_hi(w1.y), bf_lo(w1.z), bf_hi(w1.z), bf_lo(w1.w), bf_hi(w1.w)};
        float s = 0.f, q = 0.f;
#pragma unroll
        for (int e = 0; e < 16; ++e) { s += f[e]; q += f[e] * f[e]; }
#pragma unroll
        for (int o = 1; o < 64; o <<= 1) { s += __shfl_xor(s, o); q += __shfl_xor(q, o); }
        const float mean = s * (1.f / 1024.f); const float var = fmaxf(q * (1.f / 1024.f) - mean * mean, 0.f);
        if (lane == 0) { st[2 * r] = mean; st[2 * r + 1] = rsqrtf(var + EPS); }
    }
    LDS_BARRIER();
    const unsigned vaddr = (unsigned)(uintptr_t)(Vn + (8 * fq + (fr >> 2)) * 136 + 16 * wave + 4 * (fr & 3));
    for (int g = 0; g < 8; ++g) {
#pragma unroll
        for (int it = 0; it < 4; ++it) { const int q = tid + 512 * it; *(LAS u32x4*)(Wl + (q >> 4) * 136 + (q & 15) * 8) = wq[it]; }
#pragma unroll
        for (int it = 0; it < 4; ++it) { const int j = (tid >> 4) + 32 * it; const u32x4 w = vq[it]; const float mu = st[2 * j], rs = st[2 * j + 1];
            const f32x4 o0 = (f32x4){(bf_lo(w.x) - mu) * rs * lg0[0] + lb0[0], (bf_hi(w.x) - mu) * rs * lg0[1] + lb0[1], (bf_lo(w.y) - mu) * rs * lg0[2] + lb0[2], (bf_hi(w.y) - mu) * rs * lg0[3] + lb0[3]};
            const f32x4 o1 = (f32x4){(bf_lo(w.z) - mu) * rs * lg1[0] + lb1[0], (bf_hi(w.z) - mu) * rs * lg1[1] + lb1[1], (bf_lo(w.w) - mu) * rs * lg1[2] + lb1[2], (bf_hi(w.w) - mu) * rs * lg1[3] + lb1[3]};
            *(LAS u32x4*)(Vn + j * 136 + cc * 8) = pack8(o0, o1); }
        LDS_BARRIER();
        u32x2 uq[8]; float bsv[8];
#pragma unroll
        for (int it = 0; it < 8; ++it) { uq[it] = un[it]; bsv[it] = bsl[g * 128 + 16 * it + fr]; }
        MA_LOAD_U(g < 7 ? g + 1 : 7);
        MA_PREFETCH(g < 7 ? g + 1 : 7);
        s16x4 t00, t01, t10, t11, t20, t21, t30, t31;
        asm volatile("ds_read_b64_tr_b16 %0, %8\n\tds_read_b64_tr_b16 %1, %8 offset:1088\n\tds_read_b64_tr_b16 %2, %8 offset:8704\n\tds_read_b64_tr_b16 %3, %8 offset:9792\n\t"
                     "ds_read_b64_tr_b16 %4, %8 offset:17408\n\tds_read_b64_tr_b16 %5, %8 offset:18496\n\tds_read_b64_tr_b16 %6, %8 offset:26112\n\tds_read_b64_tr_b16 %7, %8 offset:27200\n\ts_waitcnt lgkmcnt(0)"
                     : "=&v"(t00), "=&v"(t01), "=&v"(t10), "=&v"(t11), "=&v"(t20), "=&v"(t21), "=&v"(t30), "=&v"(t31) : "v"(vaddr) : "memory");
        bf16x8 avk[4];
        avk[0] = __builtin_shufflevector(t00, t01, 0, 1, 2, 3, 4, 5, 6, 7); avk[1] = __builtin_shufflevector(t10, t11, 0, 1, 2, 3, 4, 5, 6, 7);
        avk[2] = __builtin_shufflevector(t20, t21, 0, 1, 2, 3, 4, 5, 6, 7); avk[3] = __builtin_shufflevector(t30, t31, 0, 1, 2, 3, 4, 5, 6, 7);
        f32x4 acc[8];
#pragma unroll
        for (int it = 0; it < 8; ++it) acc[it] = (f32x4){0.f, 0.f, 0.f, 0.f};
#pragma unroll
        for (int k = 0; k < 4; ++k) {
#pragma unroll
            for (int it = 0; it < 8; ++it) { if (it < 4 && k >= 2) continue;
                const bf16x8 bv = *(const LAS bf16x8*)(Wl + (16 * it + fr) * 136 + 32 * k + 8 * fq);
                acc[it] = __builtin_amdgcn_mfma_f32_16x16x32_bf16(avk[k], bv, acc[it], 0, 0, 0); } }
#pragma unroll
        for (int it = 0; it < 8; ++it) { const float bs = bsv[it]; const u32x2 uw = uq[it];
            u32x2 o; o.x = cvt_pk_bf16(bf_lo(uw.x) * (acc[it][0] + bs), bf_hi(uw.x) * (acc[it][1] + bs)); o.y = cvt_pk_bf16(bf_lo(uw.y) * (acc[it][2] + bs), bf_hi(uw.y) * (acc[it][3] + bs));
            *(u32x2*)(AO + (row0 + 16 * it + fr) * DM + g * 128 + 16 * wave + 4 * fq) = o; }
        LDS_BARRIER();
    }
#undef MA_PREFETCH
#undef MA_LOAD_U
}

typedef float f32x16 __attribute__((ext_vector_type(16)));
__device__ __forceinline__ void mixerB_unit(LAS unsigned char* lds, int unit, const bf16_t* Z, bf16_t* BO, const bf16_t* LRT, const float* BIASP, const float* conv_w, const float* conv_b) {
    const int tid = threadIdx.x, wave = __builtin_amdgcn_readfirstlane(tid >> 6), lane = tid & 63, l31 = lane & 31, hh = lane >> 5;
    const int b = unit >> 5, hd = (unit >> 1) & 15, half = unit & 1, ch0 = hd * 64, jo = half * 32;
    const bool is_c = wave < 4;
    constexpr int NT = SEQ / 128;
    LAS bf16_t* wl = (LAS bf16_t*)lds;
    LAS bf16_t* xrl = (LAS bf16_t*)(lds + 36864);
    LAS float* cwl = (LAS float*)(lds + 74592);
    LAS float* alb = (LAS float*)(lds + 75616);
    LAS float* gil = (LAS float*)(lds + 112480);
    LAS float* sA = (LAS float*)(lds + 130912);
    LAS float* sH = sA + 256;
    LAS float* cry = sH + 256;
#pragma unroll
    for (int it = 0; it < 4; ++it) { const int q = tid + 512 * it, row = q >> 3, c8 = q & 7, gate = row >> 7, k = (row >> 5) & 3, j = row & 31;
        *(LAS u32x4*)(wl + row * 72 + c8 * 8) = *(const u32x4*)(LRT + ((size_t)((gate * 16 + hd) * 4 + k) * 64 + jo + j) * 64 + c8 * 8); }
    if (tid < 128) cwl[tid] = conv_w[(tid >> 5) * DM + ch0 + jo + (tid & 31)];
    else if (tid < 192) { const int wq = (tid - 128) >> 5, ch = ch0 + jo + (tid & 31); cwl[128 + (tid - 128)] = BIASP[wq * DM + ch]; cwl[192 + (tid - 128)] = wq ? conv_b[ch] : BIASP[2 * DM + ch]; }
    if (tid < 64) cry[tid] = 0.f;
    const int sid = tid & 255, sc = sid & 31, seg = sid >> 5;
    const bf16_t* xbase = Z + ((size_t)b * SEQ + (sid >> 3)) * ZLD + 2 * ZSEC + ch0 + (sid & 7) * 8;
    const bf16_t* xhalo = Z + ((size_t)b * SEQ + (sid < 24 ? (sid >> 3) : 0)) * ZLD + 2 * ZSEC + ch0 + (sid & 7) * 8 - (ptrdiff_t)3 * ZLD;
    const bf16_t* gbase = Z + ((size_t)b * SEQ + 16 * seg) * ZLD + 3 * ZSEC + ch0 + jo + sc;
    bf16_t* obase = BO + ((size_t)b * SEQ + 16 * seg) * DM + ch0 + jo + sc;
    u32x4 rq[4], hq; unsigned gy[16];
#define MB_LOAD_RAW(tile) do { const bf16_t* xp_ = xbase + (size_t)(tile) * 128 * ZLD; _Pragma("unroll") for (int it = 0; it < 4; ++it) rq[it] = *(const u32x4*)(xp_ + (size_t)(32 * it) * ZLD); \
        hq = *(const u32x4*)(xhalo + (size_t)((tile) > 0 ? (tile) : 1) * 128 * ZLD); } while (0)
#define MB_STORE_RAW(buf) do { LAS bf16_t* xd_ = xrl + (buf) * 9432; _Pragma("unroll") for (int it = 0; it < 4; ++it) *(LAS u32x4*)(xd_ + (3 + (sid >> 3) + 32 * it) * 72 + (sid & 7) * 8) = rq[it]; \
        if (sid < 24) *(LAS u32x4*)(xd_ + (sid >> 3) * 72 + (sid & 7) * 8) = hq; } while (0)
#define MB_LOAD_GY(tile) do { _Pragma("unroll") for (int s_ = 0; s_ < 16; ++s_) gy[s_] = (unsigned)gbase[((size_t)(tile) * 128 + s_) * ZLD]; } while (0)
    const int t_ = 32 * wave + l31;
#define MB_MFMA(GATE, buf, a0_, a1_) do { const LAS bf16_t* xs_ = xrl + (buf) * 9432; _Pragma("unroll") for (int e_ = 0; e_ < 16; ++e_) { a0_[e_] = 0.f; a1_[e_] = 0.f; } \
        _Pragma("unroll") for (int ks = 0; ks < 16; ks += 2) { \
            const bf16x8 w0_ = *(const LAS bf16x8*)(wl + (((GATE) * 4 + (ks >> 2)) * 32 + l31) * 72 + 16 * (ks & 3) + 8 * hh), x0_ = *(const LAS bf16x8*)(xs_ + (t_ + (ks >> 2)) * 72 + 16 * (ks & 3) + 8 * hh); \
            const bf16x8 w1_ = *(const LAS bf16x8*)(wl + (((GATE) * 4 + ((ks + 1) >> 2)) * 32 + l31) * 72 + 16 * ((ks + 1) & 3) + 8 * hh), x1_ = *(const LAS bf16x8*)(xs_ + (t_ + ((ks + 1) >> 2)) * 72 + 16 * ((ks + 1) & 3) + 8 * hh); \
            a0_ = __builtin_amdgcn_mfma_f32_32x32x16_bf16(w0_, x0_, a0_, 0, 0, 0); a1_ = __builtin_amdgcn_mfma_f32_32x32x16_bf16(w1_, x1_, a1_, 0, 0, 0); \
            if ((ks & 2) != 0) __builtin_amdgcn_sched_barrier(0); } \
        } while (0)
#define MB_EW_R(accA, accB, dst) do { const LAS float* bsl_ = cwl + 128; const LAS float* c2l_ = cwl + 192; \
        _Pragma("unroll") for (int i = 0; i < 4; ++i) { f32x4 o_; const f32x4 bs_ = *(const LAS f32x4*)(bsl_ + 8 * i + 4 * hh), c2_ = *(const LAS f32x4*)(c2l_ + 8 * i + 4 * hh); \
            _Pragma("unroll") for (int j = 0; j < 4; ++j) o_[j] = __builtin_amdgcn_exp2f(-c2_[j] * fsigmoid(((accA)[4 * i + j] + (accB)[4 * i + j]) + bs_[j])); \
            *(LAS f32x4*)((dst) + t_ * 36 + 8 * i + 4 * hh) = o_; } } while (0)
#define MB_EW_I(accA, accB, buf, dst) do { const LAS bf16_t* xs_ = xrl + (buf) * 9432; const LAS float* bsl_ = cwl + 160; const LAS float* c2l_ = cwl + 224; \
        _Pragma("unroll") for (int i = 0; i < 4; ++i) { f32x4 xc_ = *(const LAS f32x4*)(c2l_ + 8 * i + 4 * hh); const f32x4 bs_ = *(const LAS f32x4*)(bsl_ + 8 * i + 4 * hh); \
            _Pragma("unroll") for (int k = 0; k < 4; ++k) { const u32x2 w_ = *(const LAS u32x2*)(xs_ + (t_ + k) * 72 + jo + 8 * i + 4 * hh); const f32x4 cw_ = *(const LAS f32x4*)(cwl + k * 32 + 8 * i + 4 * hh); \
                xc_[0] += cw_[0] * bf_lo(w_.x); xc_[1] += cw_[1] * bf_hi(w_.x); xc_[2] += cw_[2] * bf_lo(w_.y); xc_[3] += cw_[3] * bf_hi(w_.y); } \
            f32x4 o_; \
            _Pragma("unroll") for (int j = 0; j < 4; ++j) o_[j] = fsigmoid(((accA)[4 * i + j] + (accB)[4 * i + j]) + bs_[j]) * xc_[j]; \
            *(LAS f32x4*)((dst) + t_ * 36 + 8 * i + 4 * hh) = o_; } } while (0)
    if (!is_c) { MB_LOAD_RAW(0); hq = (u32x4){0u, 0u, 0u, 0u}; MB_STORE_RAW(0); MB_LOAD_RAW(1); MB_STORE_RAW(1); MB_LOAD_RAW(2); MB_LOAD_GY(0); }
    LDS_BARRIER();
    f32x16 accR0, accR1, accI0, accI1;
    if (is_c) { MB_MFMA(0, 0, accR0, accR1); MB_MFMA(1, 0, accI0, accI1); MB_EW_R(accR0, accR1, alb); MB_EW_I(accI0, accI1, 0, gil); MB_MFMA(0, 1, accR0, accR1); }
    LDS_BARRIER();
    float a16[16], g16[16];
    for (int tile = 0; tile < NT; ++tile) {
        if (is_c) { MB_MFMA(1, (tile + 1) & 1, accI0, accI1); MB_EW_R(accR0, accR1, alb + ((tile + 1) & 1) * 4608); }
        else {
            const LAS float* al = alb + (tile & 1) * 4608; float A = 1.f, Hh = 0.f;
#pragma unroll
            for (int s = 0; s < 16; ++s) { const float av = al[(16 * seg + s) * 36 + sc]; a16[s] = av; g16[s] = __builtin_amdgcn_sqrtf(fmaxf(1.0f - av * av, 0.f)) * gil[(16 * seg + s) * 36 + sc]; A *= av; Hh = av * Hh + g16[s]; }
            sA[seg * 32 + sc] = A; sH[seg * 32 + sc] = Hh;
            MB_STORE_RAW(tile & 1);
            MB_LOAD_RAW(tile + 3 < NT ? tile + 3 : NT - 1);
        }
        LDS_BARRIER();
        if (is_c) { MB_MFMA(0, tile & 1, accR0, accR1); MB_EW_I(accI0, accI1, (tile + 1) & 1, gil); }
        else {
            float h = cry[(tile & 1) * 32 + sc];
#pragma unroll
            for (int s = 0; s < 7; ++s) { const float As = sA[s * 32 + sc], Hs = sH[s * 32 + sc]; h = (s < seg) ? As * h + Hs : h; }
            bf16_t* op = obase + (size_t)tile * 128 * DM;
#pragma unroll
            for (int s = 0; s < 16; ++s) { h = a16[s] * h + g16[s]; op[(size_t)s * DM] = f2bf(h * __builtin_bit_cast(float, gy[s] << 16)); }
            if (seg == 7) cry[((tile + 1) & 1) * 32 + sc] = h;
            MB_LOAD_GY(tile + 1 < NT ? tile + 1 : NT - 1);
        }
        LDS_BARRIER();
    }
#undef MB_LOAD_RAW
#undef MB_STORE_RAW
#undef MB_LOAD_GY
#undef MB_MFMA
#undef MB_EW_R
#undef MB_EW_I
}

typedef __attribute__((address_space(1))) unsigned gu32;
#define XB_TMO      128
#define XB_XCNT(j)  (256  + 64 * (j))
#define XB_XSUB(j)  (1280 + 64 * (j))
#define XB_XGEN(j)  (2304 + 64 * (j))
#define XB_TOP      3328
#define XB_TOPGEN   3392
#define XCD_BAR_WORDS 3456
#define XB_SPIN_CAP (1u << 18)

__device__ __forceinline__ unsigned xb_ld(unsigned* p)              { return __hip_atomic_load(p, __ATOMIC_RELAXED, __HIP_MEMORY_SCOPE_AGENT); }
__device__ __forceinline__ unsigned xb_add(unsigned* p, unsigned v) { return __hip_atomic_fetch_add(p, v, __ATOMIC_RELAXED, __HIP_MEMORY_SCOPE_AGENT); }
__device__ __forceinline__ unsigned xb_xcc_id() { return (unsigned)__builtin_amdgcn_s_getreg((3 << 11) | 20) & 0xFu; }
#define XB_SPIN(cond, bar) do { unsigned _sp = 0; while (cond) { __builtin_amdgcn_s_sleep(1); \
    if ((++_sp & 255u) == 0u) { if (xb_ld(&(bar)[XB_TMO])) break; if (_sp > XB_SPIN_CAP) { atomicAdd(&(bar)[XB_TMO], 1u); break; } } } } while (0)

struct XcdBarrier {
    unsigned* bar; unsigned x;
    volatile LAS unsigned* st;
};

__device__ __forceinline__ XcdBarrier xcd_barrier_post(unsigned* bar, volatile LAS unsigned* st) {
    XcdBarrier b; b.bar = bar; b.x = xb_xcc_id(); b.st = st;
    if (threadIdx.x == 0) (void)xb_add(&bar[XB_XCNT(b.x)], 1u);
    return b;
}
__device__ __forceinline__ void xcd_barrier_complete(unsigned* bar, unsigned x, unsigned& nloc, unsigned& nx) {
    const unsigned G = gridDim.x * gridDim.y * gridDim.z;
    unsigned sum, cnt, mine, sp = 0u;
    for (;;) {
        sum = 0u; cnt = 0u; mine = 0u;
#pragma unroll
        for (unsigned j = 0; j < 16; ++j) { const unsigned c = xb_ld(&bar[XB_XCNT(j)]); sum += c; cnt += (c > 0u) ? 1u : 0u; mine = (j == x) ? c : mine; }
        if (sum == G) break;
        __builtin_amdgcn_s_sleep(1);
        if ((++sp & 255u) == 0u) { if (xb_ld(&bar[XB_TMO])) break; if (sp > XB_SPIN_CAP) { atomicAdd(&bar[XB_TMO], 1u); break; } }
    }
    nloc = mine > 0u ? mine : 1u; nx = cnt > 0u ? cnt : 1u;
}

__device__ __forceinline__ void xcd_barrier(const XcdBarrier& b) {
    asm volatile("s_waitcnt vmcnt(0)" ::: "memory");
    __syncthreads();
    if (threadIdx.x == 0) {
        unsigned* bar = b.bar;
        __builtin_amdgcn_s_waitcnt(0);
        unsigned nloc = b.st[0], nx = b.st[1];
        if (nloc == 0u) { xcd_barrier_complete(bar, b.x, nloc, nx); b.st[0] = nloc; b.st[1] = nx; }
        const unsigned old = xb_add(&bar[XB_XSUB(b.x)], 1u);
        const unsigned gen = old / nloc;
        if (old + 1u == (gen + 1u) * nloc) {
            __builtin_amdgcn_fence(__ATOMIC_RELEASE, "agent");
            asm volatile("s_waitcnt vmcnt(0)" ::: "memory");
            const unsigned og = xb_add(&bar[XB_TOP], 1u);
            const unsigned tg = og / nx;
            if (og + 1u == (tg + 1u) * nx) xb_add(&bar[XB_TOPGEN], 1u);
            else XB_SPIN(xb_ld(&bar[XB_TOPGEN]) == tg, bar);
            __builtin_amdgcn_fence(__ATOMIC_ACQUIRE, "agent");
            xb_add(&bar[XB_XGEN(b.x)], 1u);
            asm volatile("s_waitcnt vmcnt(0)" ::: "memory");
        } else {
            XB_SPIN(xb_ld(&bar[XB_XGEN(b.x)]) == gen, bar);
            __builtin_amdgcn_fence(__ATOMIC_ACQUIRE, "agent");
            asm volatile("s_waitcnt vmcnt(0)" ::: "memory");
        }
    }
    __syncthreads();
}
typedef const __attribute__((address_space(4))) Args* KArgs;
__device__ __forceinline__ KArgs kargs() {
#if defined(__HIP_DEVICE_COMPILE__)
    auto p0 = __builtin_amdgcn_kernarg_segment_ptr(); KArgs p = (KArgs)p0; asm volatile("" : "+s"(p)); return p;
#else
    return nullptr;
#endif
}
constexpr int NPHASE = 12;
__global__ void __launch_bounds__(NTHR, 2) fwd_kernel(Args args) {
    extern __shared__ __attribute__((aligned(16))) unsigned char lds_raw[];
    LAS unsigned char* lds = (LAS unsigned char*)lds_raw;
    const int lo = args.ph_lo, hi = args.ph_hi;
    volatile LAS unsigned* bst = (volatile LAS unsigned*)(lds + LDS_BYTES - 64);
    if (threadIdx.x == 0) { bst[0] = 0u; bst[1] = 0u; }
    __syncthreads();
    XcdBarrier xbar; xbar.bar = (unsigned*)args.ws; xbar.x = 0; xbar.st = bst;
    if (hi - lo > 1) xbar = xcd_barrier_post((unsigned*)args.ws, bst);
#define IN(k) (lo <= (k) && (k) < hi)
#define SEAM(k) do { if (IN(k) && IN((k) + 1)) { if ((k) == 0) cg::this_grid().sync(); else xcd_barrier(xbar); } } while (0)
#define PH KArgs ka = kargs(); unsigned char* ws = ka->ws; bf16_t* Z = (bf16_t*)(ws + WS_Z); bf16_t* H = (bf16_t*)(ws + WS_H); const int G = gridDim.x, bx = blockIdx.x; (void)Z; (void)H; (void)G; (void)bx;
#define WV const int lane = threadIdx.x & 63, wave = __builtin_amdgcn_readfirstlane(threadIdx.x >> 6);
    typedef pg8::StaticOrder SO;
    typedef PanelOrder PO;
    if (IN(0)) { PH WV prologue(ka, lds, bx * NWAVES + wave, G * NWAVES, wave, lane); __syncthreads(); }
    SEAM(0);
    if (IN(1)) { PH pg8::Gemm g{H, (const bf16_t*)(ws + WS_WIN), M, NIN, DM, DM}; SO S; S.init(M, NIN, G, bx); EpiZ E{Z};
        pg8::gemm_phase<EpiZ, SO, true, true>(lds, g, S, E); }
    SEAM(1);
    if (IN(2)) { PH mixerB_unit(lds, ((((bx >> 4) << 3) | (bx & 7)) << 1) | ((bx >> 3) & 1), Z, (bf16_t*)ka->out + (size_t)M * DM, (const bf16_t*)(ws + WS_LRT), (const float*)(ws + WS_BIASP), ka->in[9], ka->in[10]); }
    if (IN(3)) { PH for (int u = bx; u < M / 128; u += G) mixerA_unit(lds, u, Z, (bf16_t*)ka->out, (const bf16_t*)(ws + WS_WSB), ka->in[5], ka->in[6], ka->in[8]); }
    SEAM(3);
    if (IN(4)) { PH
        { SO S; S.init(M, DM, G, bx); pg8::Gemm g{(const bf16_t*)ka->out, (const bf16_t*)(ws + WS_WA), M, DM, DM, DM}; EpiGate<false> E{Z + ZSEC, Z + 4 * ZSEC, ZLD}; pg8::gemm_phase<EpiGate<false>, SO, true, true>(lds, g, S, E); }
        __syncthreads();
        { SO S; S.init(M, DM, G, bx); pg8::Gemm g{(const bf16_t*)ka->out + (size_t)M * DM, (const bf16_t*)(ws + WS_WB), M, DM, DM, DM}; EpiGate<true> E{Z + ZSEC, Z + 5 * ZSEC, ZLD}; pg8::gemm_phase<EpiGate<true>, SO, true, true>(lds, g, S, E); }
        __syncthreads();
    }
    SEAM(4);
    if (IN(5)) { PH PO S; S.init(DM, bx); pg8::Gemm g{Z + ZSEC, (const bf16_t*)(ws + WS_WO), M, DM, DM, ZLD}; EpiPlain E{Z + 2 * ZSEC, ZLD}; pg8::gemm_phase<EpiPlain, PO, true, true>(lds, g, S, E); __syncthreads(); }
    if (IN(6)) { PH WV norm_pass<false, true>((const unsigned char*)(ka->in[0] + (size_t)bx * 256 * DM), (size_t)DM * 4, Z + 2 * ZSEC + (size_t)bx * 256 * ZLD, ZLD, ka->in[3], (unsigned char*)ka->out + ((size_t)bx << 20), (size_t)DM * 2, ka->in[19], H + (size_t)bx * 256 * DM, wave, lane); }
    SEAM(6);
    if (IN(7)) { PH pg8::Gemm g{H, (const bf16_t*)(ws + WS_WGU), M, NGU, DM, DM}; SO S; S.init(M, NGU, G, bx); EpiSwiglu E{(bf16_t*)(ws + WS_ACT)};
        pg8::gemm_phase<EpiSwiglu, SO, true, true>(lds, g, S, E); }
    SEAM(7);
    if (IN(8)) { PH pg8::Gemm g{(const bf16_t*)(ws + WS_ACT), (const bf16_t*)(ws + WS_WDN), M, DM, DFF, DFF}; SO S; S.init(M, DM, G, bx); EpiPlain E{(bf16_t*)(ws + WS_F), DM};
        pg8::gemm_phase<EpiPlain, SO, true, true>(lds, g, S, E); }
    SEAM(8);
    if (IN(9)) { PH WV bf16_t* F = (bf16_t*)(ws + WS_F) + (size_t)bx * 256 * DM; norm_pass<true, true>((const unsigned char*)ka->out + ((size_t)bx << 20), (size_t)DM * 2, F, DM, ka->in[20], (unsigned char*)F, (size_t)DM * 2, ka->in[24], H + (size_t)bx * 256 * DM, wave, lane); __syncthreads(); }
    if (IN(10)) { PH
        { PO S; S.init(DM, bx); pg8::Gemm g{(const bf16_t*)(ws + WS_PB), (const bf16_t*)(ws + WS_WPIN), M, DM, PLE, PLE}; EpiPlain E{(bf16_t*)(ws + WS_GE), DM}; pg8::gemm_phase<EpiPlain, PO, true, true>(lds, g, S, E); }
        __syncthreads();
        { PO S; S.init(DM, bx); pg8::Gemm g{H, (const bf16_t*)(ws + WS_WPG), M, DM, DM, DM}; EpiSigMul E{(bf16_t*)(ws + WS_GE)}; pg8::gemm_phase<EpiSigMul, PO, true, true>(lds, g, S, E); }
        __syncthreads();
    }
    if (IN(11)) { PH WV norm_pass<true, false>((const unsigned char*)(ws + WS_F) + (size_t)bx * 256 * DM * 2, (size_t)DM * 2, (const bf16_t*)(ws + WS_GE) + (size_t)bx * 256 * DM, DM, ka->in[25], (unsigned char*)(ka->out + (size_t)bx * 256 * DM), (size_t)DM * 4, nullptr, nullptr, wave, lane); }
#undef PH
#undef WV
#undef IN
#undef SEAM
}

extern "C" void kernel_launch(void* const* d_in, const int* in_sizes, int n_in, void* d_out, int out_size, void* d_ws, size_t ws_size, hipStream_t stream) {
    static int grid = 0;
    if (grid == 0) {
        if (n_in != 28 || in_sizes[0] != M * DM || out_size != M * DM || ws_size < WS_END) { fprintf(stderr, "kernel_launch: unexpected shapes (n_in %d, in0 %d, out %d, ws %zu)\n", n_in, n_in > 0 ? in_sizes[0] : -1, out_size, ws_size); grid = -1; return; }
        int dev = 0, cus = 0, per_cu = 0;
        if (hipGetDevice(&dev) != hipSuccess || hipDeviceGetAttribute(&cus, hipDeviceAttributeMultiprocessorCount, dev) != hipSuccess) { grid = -1; return; }
        if (hipFuncSetAttribute((const void*)fwd_kernel, hipFuncAttributeMaxDynamicSharedMemorySize, LDS_BYTES) != hipSuccess) { fprintf(stderr, "kernel_launch: hipFuncSetAttribute failed\n"); grid = -1; return; }
        if (hipOccupancyMaxActiveBlocksPerMultiprocessor(&per_cu, (const void*)fwd_kernel, NTHR, LDS_BYTES) != hipSuccess || per_cu < 1) { fprintf(stderr, "kernel_launch: occupancy query says %d\n", per_cu); per_cu = 1; }
        (void)hipGetLastError();
        grid = cus * 1;
        if (grid != M / 256) { fprintf(stderr, "kernel_launch: built for a 256-CU device (one workgroup per 256-row panel); got %d CUs\n", cus); grid = -1; return; }
    }
    if (grid < 0) return;
    if (hipMemsetAsync(d_ws, 0, 16384, stream) != hipSuccess) { fprintf(stderr, "kernel_launch: memset failed\n"); return; }
    Args a{};
    for (int i = 0; i < 28; ++i) a.in[i] = (const float*)d_in[i];
    a.out = (float*)d_out; a.ws = (unsigned char*)d_ws;
#if MK_ONE
    a.ph_lo = 0; a.ph_hi = NPHASE;
    void* kargs[] = {&a};
    hipError_t e = hipLaunchCooperativeKernel((const void*)fwd_kernel, dim3(grid), dim3(NTHR), kargs, LDS_BYTES, stream);
    if (e != hipSuccess) fprintf(stderr, "kernel_launch: cooperative launch failed: %s (grid %d)\n", hipGetErrorString(e), grid);
#else
    for (int k = 0; k < NPHASE; ++k) for (int rep = 0; rep < 1 + ((REP_MASK >> k) & 1); ++rep) { a.ph_lo = k; a.ph_hi = k + 1; hipLaunchKernelGGL(fwd_kernel, dim3(grid), dim3(NTHR), LDS_BYTES, stream, a); }
#endif
}
```

```cpp
#include <hip/hip_runtime.h>
#include <hip/hip_cooperative_groups.h>
#include <cstdio>
#include <cstdint>
namespace cg = cooperative_groups;
#ifndef REP_MASK
#define REP_MASK 0
#endif
#ifndef MK_ONE
#define MK_ONE 1
#endif
namespace pg8 {
#define PG8_LAS __attribute__((address_space(3)))
typedef unsigned short bf16_t;
typedef short bf16x8 __attribute__((ext_vector_type(8)));
typedef float f32x4 __attribute__((ext_vector_type(4)));
typedef unsigned u32x4 __attribute__((ext_vector_type(4)));
constexpr int BM = 256, BK = 64, HALF = 128, HTB = HALF * BK * 2  , STAGE_BYTES = 8 * HTB, NXCD = 8, WGM = 8;

__host__ __device__ __forceinline__ int lds_byte(int r, int c) { const int st = (r >> 4) * 2 + (c >> 5), rr = r & 15, cc = c & 31, ob = rr * 64 + cc * 2; return st * 1024 + (ob ^ (((ob >> 9) & 1) << 5)); }
__host__ __device__ __forceinline__ void stage_rc(int b, int& R, int& C) { const int st = b / 1024, sb = b % 1024, swz = sb ^ (((sb >> 9) & 1) << 5); R = (st >> 1) * 16 + swz / 64; C = (st & 1) * 32 + (swz % 64) / 2; }
__host__ __device__ __forceinline__ int perm32(int rho) { const int n = rho >> 4, i = rho & 15; return 8 * (i >> 2) + 4 * n + (i & 3); }

struct Unit { int pm, pn; };
struct Gemm { const bf16_t* A; const bf16_t* Bt; int M, N, K, lda; };

struct StaticOrder {
    int nM, nN, nwg, G, c;
    __host__ __device__ void init(int M, int N, int G_, int c_) { nM = M / BM; nN = N / BM; nwg = nM * nN; G = G_; c = c_; }
    __host__ __device__ bool next(int i, Unit& u) const {
        const long L = (long)i * G + c; if (L >= nwg) return false;
        int wgid = (int)L; { const int q = nwg / NXCD, r = nwg % NXCD, xcd = wgid % NXCD, off = wgid / NXCD; wgid = (xcd < r ? xcd * (q + 1) : r * (q + 1) + (xcd - r) * q) + off; }
        const int nig = WGM * nN, gid = wgid / nig, fm = gid * WGM, gsz = (nM - fm) < WGM ? (nM - fm) : WGM;
        u.pm = fm + ((wgid % nig) % gsz); u.pn = (wgid % nig) / gsz; return true;
    }
    __device__ __forceinline__ void a_ready(const Unit&) const {}
    __device__ __forceinline__ void done(const Unit&) const {}
};

__device__ __forceinline__ unsigned cvt_pk_bf16(float lo, float hi) { unsigned r; asm volatile("v_cvt_pk_bf16_f32 %0, %1, %2" : "=v"(r) : "v"(lo), "v"(hi)); return r; }
typedef float f32x2 __attribute__((ext_vector_type(2)));
template <class Epi, class Sched, bool ALIGN_EPI = false, bool SP2 = false>
__device__ __forceinline__ void gemm_phase(PG8_LAS unsigned char* lds, const Gemm g, const Sched& S, const Epi& E) {
    const int tid = threadIdx.x, wid = __builtin_amdgcn_readfirstlane(tid >> 6), lane = tid & 63, wr = wid >> 2, wc = wid & 3, fr = lane & 15, fq = lane >> 4;
    const int K = g.K, nt = K / BK;
    unsigned voffA[2], voffB[2];
#pragma unroll
    for (int i = 0; i < 2; ++i) { int R, C; stage_rc(tid * 16 + i * 8192, R, C); const int Rb = Epi::PERM ? ((R & ~31) + perm32(R & 31)) : R;
        voffA[i] = (unsigned)(R * g.lda + C) * 2u; voffB[i] = (unsigned)(Rb * K + C) * 2u; }
    const size_t kstep = (size_t)(BK * 2);
    const size_t hstepA = (size_t)HALF * g.lda * 2, hstepB = (size_t)HALF * K * 2;
    const size_t tstepA = 2 * hstepA, tstepB = 2 * hstepB;
    const unsigned ldsw = (unsigned)wid * 1024u;
    const int aoff = lds_byte(wr * 64 + fr, fq * 8), boff = lds_byte(wc * 32 + fr, fq * 8);
#define PG8_SA(b, h) (((b) * 2 + (h)) * HTB)
#define PG8_SB(b, h) ((4 + (b) * 2 + (h)) * HTB)
#define PG8_STAGE(bufoff, gbase, voff) do { _Pragma("unroll") for (int _i = 0; _i < 2; ++_i) \
        __builtin_amdgcn_global_load_lds((const unsigned*)((const char*)(gbase) + (voff)[_i]), (PG8_LAS unsigned*)(lds + (bufoff) + ldsw + _i * 8192), 16, 0, 0); } while (0)
#define PG8_LDA(dst, b, h) do { _Pragma("unroll") for (int m = 0; m < 4; ++m) _Pragma("unroll") for (int k = 0; k < 2; ++k) dst[m][k] = *(const PG8_LAS bf16x8*)(lds + PG8_SA(b, h) + aoff + m * 2048 + k * 1024); } while (0)
#define PG8_LDB(dst, b, h) do { _Pragma("unroll") for (int n = 0; n < 2; ++n) _Pragma("unroll") for (int k = 0; k < 2; ++k) dst[n][k] = *(const PG8_LAS bf16x8*)(lds + PG8_SB(b, h) + boff + n * 2048 + k * 1024); } while (0)
#define PG8_MMA(ai, bj, At, Bt) do { __builtin_amdgcn_s_setprio(1); _Pragma("unroll") for (int m = 0; m < 4; ++m) _Pragma("unroll") for (int n = 0; n < 2; ++n) _Pragma("unroll") for (int k = 0; k < 2; ++k) \
        acc[ai][bj][m][n] = __builtin_amdgcn_mfma_f32_16x16x32_bf16(Bt[n][k], At[m][k], acc[ai][bj][m][n], 0, 0, 0); __builtin_amdgcn_s_setprio(0); } while (0)
#define PG8_WAIT_V(n) asm volatile("s_waitcnt vmcnt(" #n ")" ::: "memory")
#define PG8_WAIT_L(n) asm volatile("s_waitcnt lgkmcnt(" #n ")" ::: "memory")
#define PG8_BAR __builtin_amdgcn_s_barrier()
#define PG8_SCHED __builtin_amdgcn_sched_barrier(0)
    Unit cur, nxt; int ui = 0;
    if (!S.next(0, cur)) return;
    f32x4 acc[2][2][4][2];
#pragma unroll
    for (int a = 0; a < 2; ++a)
#pragma unroll
        for (int b = 0; b < 2; ++b)
#pragma unroll
            for (int m = 0; m < 4; ++m)
#pragma unroll
                for (int n = 0; n < 2; ++n) acc[a][b][m][n] = (f32x4){0.f, 0.f, 0.f, 0.f};
    bf16x8 At[4][2], B0[2][2], B1[2][2];
    const char* cA = (const char*)g.A + (size_t)cur.pm * tstepA; const char* cB = (const char*)g.Bt + (size_t)cur.pn * tstepB;
    S.a_ready(cur);
    if constexpr (SP2) {
        PG8_STAGE(PG8_SB(0, 0), cB, voffB); PG8_STAGE(PG8_SB(0, 1), cB + hstepB, voffB); PG8_STAGE(PG8_SA(0, 0), cA, voffA); PG8_STAGE(PG8_SA(0, 1), cA + hstepA, voffA);
        if (wr == 1) PG8_BAR;
        PG8_WAIT_V(2); PG8_BAR;
        PG8_STAGE(PG8_SB(1, 0), cB + kstep, voffB); PG8_STAGE(PG8_SA(1, 0), cA + kstep, voffA); PG8_STAGE(PG8_SB(1, 1), cB + hstepB + kstep, voffB);
        PG8_WAIT_V(6); PG8_BAR;
    } else {
        PG8_STAGE(PG8_SB(0, 0), cB, voffB); PG8_STAGE(PG8_SA(0, 0), cA, voffA); PG8_STAGE(PG8_SB(0, 1), cB + hstepB, voffB); PG8_STAGE(PG8_SA(0, 1), cA + hstepA, voffA);
        if (wr == 1) PG8_BAR;
        PG8_WAIT_V(4); PG8_BAR;
        PG8_STAGE(PG8_SB(1, 0), cB + kstep, voffB); PG8_STAGE(PG8_SA(1, 0), cA + kstep, voffA); PG8_STAGE(PG8_SB(1, 1), cB + hstepB + kstep, voffB);
        PG8_WAIT_V(6); PG8_BAR;
    }
    for (;;) {
        const bool has_next = S.next(ui + 1, nxt);
        const char* nA = has_next ? (const char*)g.A + (size_t)nxt.pm * tstepA : cA; const char* nB = has_next ? (const char*)g.Bt + (size_t)nxt.pn * tstepB : cB;
        for (int t = 0; t < nt; t += 2) {
            const bool last = (t == nt - 2);
            const char* a1 = cA + (size_t)(t + 1) * kstep;
            const char* a2 = last ? nA : cA + (size_t)(t + 2) * kstep; const char* b2 = last ? nB : cB + (size_t)(t + 2) * kstep;
            const char* a3 = a2 + kstep; const char* b3 = b2 + kstep;
            if (last && has_next) S.a_ready(nxt);
            if constexpr (SP2) {
            PG8_LDB(B0, 0, 0); PG8_LDB(B1, 0, 1); PG8_SCHED; PG8_LDA(At, 0, 0); PG8_STAGE(PG8_SA(1, 1), a1 + hstepA, voffA);
            PG8_WAIT_V(8); PG8_WAIT_L(0); PG8_BAR; PG8_MMA(0, 0, At, B0); PG8_MMA(0, 1, At, B1); PG8_BAR; PG8_SCHED;
            PG8_LDA(At, 0, 1); PG8_STAGE(PG8_SB(0, 0), b2, voffB); PG8_STAGE(PG8_SB(0, 1), b2 + hstepB, voffB); PG8_STAGE(PG8_SA(0, 0), a2, voffA);
            PG8_WAIT_V(8); PG8_WAIT_L(0); PG8_BAR; PG8_MMA(1, 0, At, B0); PG8_MMA(1, 1, At, B1); PG8_BAR; PG8_SCHED;
            PG8_LDB(B0, 1, 0); PG8_LDB(B1, 1, 1); PG8_SCHED; PG8_LDA(At, 1, 0); PG8_STAGE(PG8_SA(0, 1), a2 + hstepA, voffA);
            PG8_WAIT_V(8); PG8_WAIT_L(0); PG8_BAR; PG8_MMA(0, 0, At, B0); PG8_MMA(0, 1, At, B1); PG8_BAR; PG8_SCHED;
            PG8_LDA(At, 1, 1); PG8_STAGE(PG8_SB(1, 0), b3, voffB); PG8_STAGE(PG8_SB(1, 1), b3 + hstepB, voffB); PG8_STAGE(PG8_SA(1, 0), a3, voffA);
            PG8_WAIT_V(8); PG8_WAIT_L(0); PG8_BAR; PG8_MMA(1, 0, At, B0); PG8_MMA(1, 1, At, B1); PG8_BAR; PG8_SCHED;
            } else {
            PG8_LDB(B0, 0, 0); PG8_SCHED; PG8_LDA(At, 0, 0); PG8_STAGE(PG8_SA(1, 1), a1 + hstepA, voffA);
            PG8_WAIT_L(8); PG8_BAR; PG8_WAIT_L(0); PG8_MMA(0, 0, At, B0); PG8_BAR; PG8_SCHED;
            PG8_LDB(B1, 0, 1); PG8_STAGE(PG8_SB(0, 0), b2, voffB);
            PG8_BAR; PG8_WAIT_L(0); PG8_MMA(0, 1, At, B1); PG8_BAR;
            PG8_LDA(At, 0, 1); PG8_STAGE(PG8_SA(0, 0), a2, voffA);
            PG8_BAR; PG8_WAIT_L(0); PG8_MMA(1, 0, At, B0); PG8_BAR; PG8_SCHED;
            PG8_STAGE(PG8_SB(0, 1), b2 + hstepB, voffB);
            PG8_WAIT_V(6); PG8_BAR; PG8_MMA(1, 1, At, B1); PG8_BAR;
            PG8_LDB(B0, 1, 0); PG8_SCHED; PG8_LDA(At, 1, 0); PG8_STAGE(PG8_SA(0, 1), a2 + hstepA, voffA);
            PG8_WAIT_L(8); PG8_BAR; PG8_WAIT_L(0); PG8_MMA(0, 0, At, B0); PG8_BAR; PG8_SCHED;
            PG8_LDB(B1, 1, 1); PG8_STAGE(PG8_SB(1, 0), b3, voffB);
            PG8_BAR; PG8_WAIT_L(0); PG8_MMA(0, 1, At, B1); PG8_BAR;
            PG8_LDA(At, 1, 1); PG8_STAGE(PG8_SA(1, 0), a3, voffA);
            PG8_BAR; PG8_WAIT_L(0); PG8_MMA(1, 0, At, B0); PG8_BAR; PG8_SCHED;
            PG8_STAGE(PG8_SB(1, 1), b3 + hstepB, voffB);
            PG8_WAIT_V(6); PG8_BAR; PG8_MMA(1, 1, At, B1); PG8_BAR;
            }
        }
        if constexpr (ALIGN_EPI) { if (wr == 0) PG8_BAR; }
        if constexpr (!Epi::AFTER_DRAIN) { E(acc, cur, wr, wc, fr, fq); S.done(cur); }
        if (!has_next) break;
#pragma unroll
        for (int a = 0; a < 2; ++a)
#pragma unroll
            for (int b = 0; b < 2; ++b)
#pragma unroll
                for (int m = 0; m < 4; ++m)
#pragma unroll
                    for (int n = 0; n < 2; ++n) acc[a][b][m][n] = (f32x4){0.f, 0.f, 0.f, 0.f};
        cur = nxt; cA = nA; cB = nB; ++ui;
        if constexpr (ALIGN_EPI) { if (wr == 1) PG8_BAR; }
    }
    PG8_WAIT_V(0);
    if constexpr (!ALIGN_EPI) { if (wr == 0) PG8_BAR; }
    PG8_BAR;
    if constexpr (Epi::AFTER_DRAIN) { E.fused(acc, cur, wr, wc, fr, fq, lds, wid, lane); S.done(cur); }
#undef PG8_SA
#undef PG8_SB
#undef PG8_STAGE
#undef PG8_LDA
#undef PG8_LDB
#undef PG8_MMA
#undef PG8_WAIT_V
#undef PG8_WAIT_L
#undef PG8_BAR
#undef PG8_SCHED
}
}
using pg8::bf16_t; using pg8::bf16x8; using pg8::f32x4; using pg8::u32x4; using pg8::Unit; using pg8::cvt_pk_bf16;
#define LAS __attribute__((address_space(3)))
typedef unsigned u32x2 __attribute__((ext_vector_type(2)));

constexpr int DM = 1024, BATCH = 8, SEQ = 8192, M = BATCH * SEQ, NIN = 6144, DFF = 2816, NGU = 2 * DFF, PLE = 256, ZLD = 1024;
constexpr size_t ZSEC = (size_t)M * 1024;
constexpr float EPS = 1e-6f;
constexpr size_t MiB = 1u << 20;
constexpr size_t WS_WIN = 1 * MiB, WS_WA = 13 * MiB, WS_WB = 15 * MiB, WS_WO = 17 * MiB, WS_WPG = 19 * MiB, WS_WGU = 21 * MiB, WS_WDN = 32 * MiB, WS_WPIN = 38 * MiB;
constexpr size_t WS_WSB = 38 * MiB + 512 * 1024, WS_BIASP = 38 * MiB + 768 * 1024, WS_LRT = 39 * MiB;
constexpr size_t WS_PB = 40 * MiB, WS_H = 72 * MiB, WS_Z = 200 * MiB, WS_ACT = 200 * MiB, WS_F = 552 * MiB, WS_GE = 680 * MiB, WS_END = 968 * MiB;
constexpr int NWAVES = 8, NTHR = 512, LDS_BYTES = 147456;

__device__ __forceinline__ float bf_lo(unsigned w) { return __builtin_bit_cast(float, w << 16); }
__device__ __forceinline__ float bf_hi(unsigned w) { return __builtin_bit_cast(float, w & 0xffff0000u); }
__device__ __forceinline__ float bf1(unsigned short h) { return __builtin_bit_cast(float, ((unsigned)h) << 16); }
__device__ __forceinline__ unsigned short f2bf(float f) { unsigned u = __builtin_bit_cast(unsigned, f); return (unsigned short)((u + 0x7fffu + ((u >> 16) & 1u)) >> 16); }
__device__ __forceinline__ float fsigmoid(float x) { return __builtin_amdgcn_rcpf(1.0f + __builtin_amdgcn_exp2f(-1.4426950408889634f * x)); }
__device__ __forceinline__ float fgelu(float x) { const float u = x * (0.7978845608028654f + 0.035677408136300125f * x * x); return x * __builtin_amdgcn_rcpf(1.0f + __builtin_amdgcn_exp2f(-2.8853900817779268f * u)); }
__device__ __forceinline__ f32x4 fgelu4(f32x4 x) { const f32x4 t = x * (x * x * 0.035677408136300125f + 0.7978845608028654f) * (-2.8853900817779268f);
    f32x4 e; e[0] = __builtin_amdgcn_exp2f(t[0]); e[1] = __builtin_amdgcn_exp2f(t[1]); e[2] = __builtin_amdgcn_exp2f(t[2]); e[3] = __builtin_amdgcn_exp2f(t[3]);
    const f32x4 d = e + 1.0f; f32x4 r; r[0] = __builtin_amdgcn_rcpf(d[0]); r[1] = __builtin_amdgcn_rcpf(d[1]); r[2] = __builtin_amdgcn_rcpf(d[2]); r[3] = __builtin_amdgcn_rcpf(d[3]); return x * r; }
__device__ __forceinline__ f32x4 fsigmoid4(f32x4 x) { const f32x4 t = x * (-1.4426950408889634f);
    f32x4 e; e[0] = __builtin_amdgcn_exp2f(t[0]); e[1] = __builtin_amdgcn_exp2f(t[1]); e[2] = __builtin_amdgcn_exp2f(t[2]); e[3] = __builtin_amdgcn_exp2f(t[3]);
    const f32x4 d = e + 1.0f; f32x4 r; r[0] = __builtin_amdgcn_rcpf(d[0]); r[1] = __builtin_amdgcn_rcpf(d[1]); r[2] = __builtin_amdgcn_rcpf(d[2]); r[3] = __builtin_amdgcn_rcpf(d[3]); return r; }
__device__ __forceinline__ float wave_sum(float v) {
#pragma unroll
    for (int o = 1; o < 64; o <<= 1) v += __shfl_xor(v, o);
    return v;
}

#define EPI_LOOP_BEGIN \
    const int row0 = u.pm * 256 + wr * 64 + fr, col0 = u.pn * 256 + wc * 32 + 8 * fq; \
    _Pragma("unroll") for (int ai = 0; ai < 2; ++ai) _Pragma("unroll") for (int m = 0; m < 4; ++m) { const size_t row = (size_t)(row0 + ai * 128 + m * 16); \
    _Pragma("unroll") for (int bj = 0; bj < 2; ++bj) { const int col = col0 + bj * 128; f32x4 v0 = acc[ai][bj][m][0], v1 = acc[ai][bj][m][1];
#define EPI_LOOP_END } }
__device__ __forceinline__ u32x4 pack8(f32x4 v0, f32x4 v1) { u32x4 w; w.x = cvt_pk_bf16(v0[0], v0[1]); w.y = cvt_pk_bf16(v0[2], v0[3]); w.z = cvt_pk_bf16(v1[0], v1[1]); w.w = cvt_pk_bf16(v1[2], v1[3]); return w; }

struct EpiZ {
    static constexpr bool PERM = true, AFTER_DRAIN = false; bf16_t* Z;
    __device__ __forceinline__ void operator()(const f32x4 (&acc)[2][2][4][2], const Unit& u, int wr, int wc, int fr, int fq) const {
        const int sec = u.pn >> 2; const int mode = (sec == 2) ? 0 : (sec >= 4 ? 2 : 1); bf16_t* Zs = Z + (size_t)sec * ZSEC;
        EPI_LOOP_BEGIN
            if (mode == 1) { v0 = fgelu4(v0); v1 = fgelu4(v1); }
            else if (mode == 2) { v0 = fsigmoid4(v0); v1 = fsigmoid4(v1); }
            *(u32x4*)(Zs + row * ZLD + (col & 1023)) = pack8(v0, v1);
        EPI_LOOP_END
    }
};
struct EpiPlain {
    static constexpr bool PERM = true, AFTER_DRAIN = false; bf16_t* O; int ldc;
    __device__ __forceinline__ void operator()(const f32x4 (&acc)[2][2][4][2], const Unit& u, int wr, int wc, int fr, int fq) const {
        EPI_LOOP_BEGIN
            *(u32x4*)(O + row * ldc + col) = pack8(v0, v1);
        EPI_LOOP_END
    }
};
__device__ __forceinline__ void mul8(f32x4& v0, f32x4& v1, const u32x4 w) { v0[0] *= bf_lo(w.x); v0[1] *= bf_hi(w.x); v0[2] *= bf_lo(w.y); v0[3] *= bf_hi(w.y); v1[0] *= bf_lo(w.z); v1[1] *= bf_hi(w.z); v1[2] *= bf_lo(w.w); v1[3] *= bf_hi(w.w); }
__device__ __forceinline__ void add8(f32x4& v0, f32x4& v1, const u32x4 w) { v0[0] += bf_lo(w.x); v0[1] += bf_hi(w.x); v0[2] += bf_lo(w.y); v0[3] += bf_hi(w.y); v1[0] += bf_lo(w.z); v1[1] += bf_hi(w.z); v1[2] += bf_lo(w.w); v1[3] += bf_hi(w.w); }
template <bool ADD> struct EpiGate {
    static constexpr bool PERM = true, AFTER_DRAIN = false; bf16_t* O; const bf16_t* G; int ld;
    __device__ __forceinline__ void operator()(const f32x4 (&acc)[2][2][4][2], const Unit& u, int wr, int wc, int fr, int fq) const {
        const int row0 = u.pm * 256 + wr * 64 + fr, col0 = u.pn * 256 + wc * 32 + 8 * fq;
        if constexpr (!ADD) {
            u32x4 gw[2][4][2];
#pragma unroll
            for (int ai = 0; ai < 2; ++ai)
#pragma unroll
                for (int m = 0; m < 4; ++m)
#pragma unroll
                    for (int bj = 0; bj < 2; ++bj) gw[ai][m][bj] = *(const u32x4*)(G + (size_t)(row0 + ai * 128 + m * 16) * ld + col0 + bj * 128);
#pragma unroll
            for (int ai = 0; ai < 2; ++ai)
#pragma unroll
                for (int m = 0; m < 4; ++m)
#pragma unroll
                    for (int bj = 0; bj < 2; ++bj) { f32x4 v0 = acc[ai][bj][m][0], v1 = acc[ai][bj][m][1]; mul8(v0, v1, gw[ai][m][bj]);
                        *(u32x4*)(O + (size_t)(row0 + ai * 128 + m * 16) * ld + col0 + bj * 128) = pack8(v0, v1); }
        } else {
#pragma unroll
            for (int ai = 0; ai < 2; ++ai) {
                u32x4 gw[4][2], ow[4][2];
#pragma unroll
                for (int m = 0; m < 4; ++m)
#pragma unroll
                    for (int bj = 0; bj < 2; ++bj) { const size_t off = (size_t)(row0 + ai * 128 + m * 16) * ld + col0 + bj * 128; gw[m][bj] = *(const u32x4*)(G + off); ow[m][bj] = *(const u32x4*)(O + off); }
#pragma unroll
                for (int m = 0; m < 4; ++m)
#pragma unroll
                    for (int bj = 0; bj < 2; ++bj) { const size_t off = (size_t)(row0 + ai * 128 + m * 16) * ld + col0 + bj * 128; f32x4 v0 = acc[ai][bj][m][0], v1 = acc[ai][bj][m][1];
                        mul8(v0, v1, gw[m][bj]); add8(v0, v1, ow[m][bj]);
                        *(u32x4*)(O + off) = pack8(v0, v1); }
            }
        }
    }
};
struct EpiSwiglu {
    static constexpr bool PERM = true, AFTER_DRAIN = false; bf16_t* O;
    __device__ __forceinline__ void operator()(const f32x4 (&acc)[2][2][4][2], const Unit& u, int wr, int wc, int fr, int fq) const {
        EPI_LOOP_BEGIN
            const int hid = u.pn * 128 + bj * 64 + wc * 16 + 4 * fq; (void)col;
            f32x4 o;
#pragma unroll
            for (int e = 0; e < 4; ++e) o[e] = v0[e] * fsigmoid(v0[e]) * v1[e];
            u32x2 w; w.x = cvt_pk_bf16(o[0], o[1]); w.y = cvt_pk_bf16(o[2], o[3]);
            *(u32x2*)(O + row * DFF + hid) = w;
        EPI_LOOP_END
    }
};
struct EpiSigMul {
    static constexpr bool PERM = true, AFTER_DRAIN = false; bf16_t* O;
    __device__ __forceinline__ void operator()(const f32x4 (&acc)[2][2][4][2], const Unit& u, int wr, int wc, int fr, int fq) const {
        const int row0 = u.pm * 256 + wr * 64 + fr, col0 = u.pn * 256 + wc * 32 + 8 * fq;
#pragma unroll
        for (int ai = 0; ai < 2; ++ai) {
            u32x4 ow[4][2];
#pragma unroll
            for (int m = 0; m < 4; ++m)
#pragma unroll
                for (int bj = 0; bj < 2; ++bj) ow[m][bj] = *(const u32x4*)(O + (size_t)(row0 + ai * 128 + m * 16) * DM + col0 + bj * 128);
#pragma unroll
            for (int m = 0; m < 4; ++m)
#pragma unroll
                for (int bj = 0; bj < 2; ++bj) { f32x4 v0 = acc[ai][bj][m][0], v1 = acc[ai][bj][m][1];
#pragma unroll
                    for (int e = 0; e < 4; ++e) { v0[e] = fsigmoid(v0[e]); v1[e] = fsigmoid(v1[e]); }
                    mul8(v0, v1, ow[m][bj]);
                    *(u32x4*)(O + (size_t)(row0 + ai * 128 + m * 16) * DM + col0 + bj * 128) = pack8(v0, v1); }
        }
    }
};

struct PanelOrder {
    int nN, pm;
    __device__ void init(int N, int pm_) { nN = N / 256; pm = pm_; }
    __device__ bool next(int i, Unit& u) const { if (i >= nN) return false; u.pm = pm; u.pn = i; return true; }
    __device__ __forceinline__ void a_ready(const Unit&) const {}
    __device__ __forceinline__ void done(const Unit&) const {}
};
template <int MODE> __device__ __forceinline__ void transpose_item(const float* W, int K, int N, bf16_t* WT, LAS float* scr, int item, int lane) {
    const int nblk = N / 32, kb = item / nblk, nb = item % nblk, k0 = 64 * kb, n0 = 32 * nb;
    float tv[32];
#pragma unroll
    for (int i = 0; i < 32; ++i) tv[i] = W[(size_t)(k0 + 2 * i + (lane >> 5)) * N + n0 + (lane & 31)];
#pragma unroll
    for (int i = 0; i < 32; ++i) scr[(2 * i + (lane >> 5)) * 33 + (lane & 31)] = tv[i];
    asm volatile("s_waitcnt lgkmcnt(0)" ::: "memory");
    const int c = lane & 7;
#pragma unroll
    for (int j = 0; j < 4; ++j) { const int n = (lane >> 3) + 8 * j; const LAS float* s = scr + (8 * c) * 33 + n;
        u32x4 o; o.x = cvt_pk_bf16(s[0 * 33], s[1 * 33]); o.y = cvt_pk_bf16(s[2 * 33], s[3 * 33]); o.z = cvt_pk_bf16(s[4 * 33], s[5 * 33]); o.w = cvt_pk_bf16(s[6 * 33], s[7 * 33]);
        const int ng = n0 + n; const int drow = (MODE == 0) ? ng : (256 * (ng >> 7) + 8 * ((ng & 127) >> 2) + (ng & 3) + 4 * (MODE - 1));
        *(u32x4*)(WT + (size_t)drow * K + k0 + 8 * c) = o; }
    asm volatile("s_waitcnt lgkmcnt(0)" ::: "memory");
}

struct Args { const float* in[28]; float* out; unsigned char* ws; int ph_lo, ph_hi; };

__device__ __forceinline__ void prologue(const __attribute__((address_space(4))) Args* ap, LAS unsigned char* lds, int gw, int NGW, int wave, int lane) {
    Args a;
    for (int i = 0; i < 28; ++i) a.in[i] = ap->in[i];
    a.out = ap->out; a.ws = ap->ws;
    unsigned char* ws = a.ws;
    LAS float* scr = (LAS float*)(lds + wave * 16384);
    constexpr int I_IN = 16 * (NIN / 32), I_SQ = 16 * 32, I_GU = 16 * (DFF / 32), I_DN = (DFF / 64) * 32, I_PI = 4 * 32;
    constexpr int NITEMS = I_IN + 4 * I_SQ + 2 * I_GU + I_DN + I_PI;
    for (int it = gw; it < NITEMS; it += NGW) {
        int r = it;
        if (r < I_IN) { transpose_item<0>(a.in[4], DM, NIN, (bf16_t*)(ws + WS_WIN), scr, r, lane); continue; } r -= I_IN;
        if (r < I_SQ) { transpose_item<0>(a.in[16], DM, DM, (bf16_t*)(ws + WS_WA), scr, r, lane); continue; } r -= I_SQ;
        if (r < I_SQ) { transpose_item<0>(a.in[17], DM, DM, (bf16_t*)(ws + WS_WB), scr, r, lane); continue; } r -= I_SQ;
        if (r < I_SQ) { transpose_item<0>(a.in[18], DM, DM, (bf16_t*)(ws + WS_WO), scr, r, lane); continue; } r -= I_SQ;
        if (r < I_SQ) { transpose_item<0>(a.in[27], DM, DM, (bf16_t*)(ws + WS_WPG), scr, r, lane); continue; } r -= I_SQ;
        if (r < I_GU) { transpose_item<1>(a.in[21], DM, DFF, (bf16_t*)(ws + WS_WGU), scr, r, lane); continue; } r -= I_GU;
        if (r < I_GU) { transpose_item<2>(a.in[22], DM, DFF, (bf16_t*)(ws + WS_WGU), scr, r, lane); continue; } r -= I_GU;
        if (r < I_DN) { transpose_item<0>(a.in[23], DFF, DM, (bf16_t*)(ws + WS_WDN), scr, r, lane); continue; } r -= I_DN;
        transpose_item<0>(a.in[26], PLE, DM, (bf16_t*)(ws + WS_WPIN), scr, r, lane);
    }
    const int gt = gw * 64 + lane, NGT = NGW * 64;
    { const float* wsrc = a.in[7]; bf16_t* d = (bf16_t*)(ws + WS_WSB);
      for (int e = gt; e < 8 * 128 * 128; e += NGT) { const int i = (e >> 7) & 127, j = e & 127; d[e] = ((j >> 6) <= (i >> 6)) ? f2bf(wsrc[e]) : (bf16_t)0; } }
    { bf16_t* d = (bf16_t*)(ws + WS_LRT); const float* cw = a.in[9];
      for (int e = gt; e < 2 * 16 * 4 * 64 * 64; e += NGT) { const int c = e & 63, j = (e >> 6) & 63, k = (e >> 12) & 3, hd = (e >> 14) & 15, which = e >> 18;
          const float* src = which ? a.in[13] : a.in[11]; d[e] = f2bf(cw[k * DM + hd * 64 + c] * src[hd * 4096 + c * 64 + j]); } }
    { float* d = (float*)(ws + WS_BIASP); const float* cb = a.in[10];
      for (int e = gw; e < 2 * DM; e += NGW) { const int which = e >> 10, ch = e & 1023, hd = ch >> 6, j = ch & 63; const float* w = (which ? a.in[13] : a.in[11]) + hd * 4096 + j;
          const float part = wave_sum(cb[hd * 64 + lane] * w[lane * 64]);
          if (lane == 0) d[e] = (which ? a.in[14] : a.in[12])[ch] + part; }
      for (int e = gt; e < DM; e += NGT) d[2 * DM + e] = 8.0f * 1.4426950408889634f * log1pf(expf(-a.in[15][e])); }
    { const f32x4* src = (const f32x4*)a.in[1]; u32x2* d = (u32x2*)(ws + WS_PB);
      for (int e = gt; e < M * PLE / 4; e += 4 * NGT) { f32x4 v[4];
#pragma unroll
          for (int i = 0; i < 4; ++i) v[i] = src[e + i * NGT < M * PLE / 4 ? e + i * NGT : e];
#pragma unroll
          for (int i = 0; i < 4; ++i) if (e + i * NGT < M * PLE / 4) { u32x2 w; w.x = cvt_pk_bf16(v[i][0], v[i][1]); w.y = cvt_pk_bf16(v[i][2], v[i][3]); d[e + i * NGT] = w; } } }
    { const float* x = a.in[0]; const float* g = a.in[2]; bf16_t* H = (bf16_t*)(ws + WS_H);
      f32x4 nx[4], gq[4];
#pragma unroll
      for (int j = 0; j < 4; ++j) { gq[j] = *(const f32x4*)(g + 256 * j + 4 * lane); nx[j] = *(const f32x4*)(x + (size_t)gw * DM + 256 * j + 4 * lane); }
      for (int m = gw; m < M; m += NGW) {
          f32x4 v[4]; float ss = 0.f;
#pragma unroll
          for (int j = 0; j < 4; ++j) { v[j] = nx[j]; ss += (v[j][0] * v[j][0] + v[j][1] * v[j][1]) + (v[j][2] * v[j][2] + v[j][3] * v[j][3]); }
          { const int mn = m + NGW < M ? m + NGW : m;
#pragma unroll
              for (int j = 0; j < 4; ++j) nx[j] = *(const f32x4*)(x + (size_t)mn * DM + 256 * j + 4 * lane); }
          const float rs = rsqrtf(wave_sum(ss) * (1.f / DM) + EPS);
#pragma unroll
          for (int j = 0; j < 4; ++j) { const f32x4 gg = gq[j]; u32x2 w; w.x = cvt_pk_bf16(v[j][0] * rs * gg[0], v[j][1] * rs * gg[1]); w.y = cvt_pk_bf16(v[j][2] * rs * gg[2], v[j][3] * rs * gg[3]);
              *(u32x2*)(H + (size_t)m * DM + 256 * j + 4 * lane) = w; }
      } }
}

template <bool XIN_BF16, bool XOUT_BF16>
__device__ __forceinline__ void norm_pass(const unsigned char* xin, size_t xin_pitch, const bf16_t* y, int ldy, const float* g1, unsigned char* xo, size_t xo_pitch, const float* g2, bf16_t* hn, int wave, int lane) {
    u32x4 yq[2], xb[2]; f32x4 xf[2][2];
    f32x4 G1[2][2], G2[2][2];
#pragma unroll
    for (int j = 0; j < 2; ++j) { const int c0 = 512 * j + 8 * lane; G1[j][0] = *(const f32x4*)(g1 + c0); G1[j][1] = *(const f32x4*)(g1 + c0 + 4);
        if (g2) { G2[j][0] = *(const f32x4*)(g2 + c0); G2[j][1] = *(const f32x4*)(g2 + c0 + 4); } else { G2[j][0] = G1[j][0]; G2[j][1] = G1[j][1]; } }
#define NP_LOAD(r_) do { _Pragma("unroll") for (int j = 0; j < 2; ++j) { const int c0 = 512 * j + 8 * lane; yq[j] = *(const u32x4*)(y + (size_t)(r_) * ldy + c0); \
        if (XIN_BF16) xb[j] = *(const u32x4*)(xin + (size_t)(r_) * xin_pitch + 2 * c0); \
        else { xf[j][0] = *(const f32x4*)(xin + (size_t)(r_) * xin_pitch + 4 * c0); xf[j][1] = *(const f32x4*)(xin + (size_t)(r_) * xin_pitch + 4 * c0 + 16); } } } while (0)
    NP_LOAD(wave);
    for (int r = wave; r < 256; r += NWAVES) {
        float yv[16], xv[16]; float ss = 0.f;
#pragma unroll
        for (int j = 0; j < 2; ++j) { const u32x4 w = yq[j];
            yv[8 * j + 0] = bf_lo(w.x); yv[8 * j + 1] = bf_hi(w.x); yv[8 * j + 2] = bf_lo(w.y); yv[8 * j + 3] = bf_hi(w.y); yv[8 * j + 4] = bf_lo(w.z); yv[8 * j + 5] = bf_hi(w.z); yv[8 * j + 6] = bf_lo(w.w); yv[8 * j + 7] = bf_hi(w.w);
            if (XIN_BF16) { const u32x4 a = xb[j];
                xv[8 * j + 0] = bf_lo(a.x); xv[8 * j + 1] = bf_hi(a.x); xv[8 * j + 2] = bf_lo(a.y); xv[8 * j + 3] = bf_hi(a.y); xv[8 * j + 4] = bf_lo(a.z); xv[8 * j + 5] = bf_hi(a.z); xv[8 * j + 6] = bf_lo(a.w); xv[8 * j + 7] = bf_hi(a.w);
            } else {
#pragma unroll
                for (int e = 0; e < 4; ++e) { xv[8 * j + e] = xf[j][0][e]; xv[8 * j + 4 + e] = xf[j][1][e]; } } }
        NP_LOAD(r + NWAVES < 256 ? r + NWAVES : r);
#pragma unroll
        for (int e = 0; e < 16; ++e) ss += yv[e] * yv[e];
        const float rs = rsqrtf(wave_sum(ss) * (1.f / DM) + EPS);
        float s2 = 0.f;
#pragma unroll
        for (int j = 0; j < 2; ++j) { const int c0 = 512 * j + 8 * lane; const f32x4 ga = G1[j][0], gb = G1[j][1];
#pragma unroll
            for (int e = 0; e < 4; ++e) { xv[8 * j + e] += yv[8 * j + e] * rs * ga[e]; xv[8 * j + 4 + e] += yv[8 * j + 4 + e] * rs * gb[e]; }
            if (XOUT_BF16) { *(u32x4*)(xo + (size_t)r * xo_pitch + 2 * c0) = pack8((f32x4){xv[8 * j], xv[8 * j + 1], xv[8 * j + 2], xv[8 * j + 3]}, (f32x4){xv[8 * j + 4], xv[8 * j + 5], xv[8 * j + 6], xv[8 * j + 7]});
#pragma unroll
                for (int e = 0; e < 8; ++e) xv[8 * j + e] = bf1(f2bf(xv[8 * j + e]));
            } else { *(f32x4*)(xo + (size_t)r * xo_pitch + 4 * c0) = (f32x4){xv[8 * j], xv[8 * j + 1], xv[8 * j + 2], xv[8 * j + 3]};
                *(f32x4*)(xo + (size_t)r * xo_pitch + 4 * c0 + 16) = (f32x4){xv[8 * j + 4], xv[8 * j + 5], xv[8 * j + 6], xv[8 * j + 7]}; } }
        if (hn) {
#pragma unroll
            for (int e = 0; e < 16; ++e) s2 += xv[e] * xv[e];
            const float r2 = rsqrtf(wave_sum(s2) * (1.f / DM) + EPS);
#pragma unroll
            for (int j = 0; j < 2; ++j) { const int c0 = 512 * j + 8 * lane; const f32x4 ga = G2[j][0], gb = G2[j][1];
                f32x4 o0, o1;
#pragma unroll
                for (int e = 0; e < 4; ++e) { o0[e] = xv[8 * j + e] * r2 * ga[e]; o1[e] = xv[8 * j + 4 + e] * r2 * gb[e]; }
                *(u32x4*)(hn + (size_t)r * DM + c0) = pack8(o0, o1); }
        }
    }
#undef NP_LOAD
}
#define LDS_BARRIER() do { asm volatile("s_waitcnt lgkmcnt(0)" ::: "memory"); __builtin_amdgcn_s_barrier(); asm volatile("" ::: "memory"); } while (0)
typedef short s16x4 __attribute__((ext_vector_type(4)));
__device__ __forceinline__ void mixerA_unit(LAS unsigned char* lds, int blk, const bf16_t* Z, bf16_t* AO, const bf16_t* WSB, const float* ln_g, const float* ln_b, const float* b_s) {
    const int tid = threadIdx.x, wave = __builtin_amdgcn_readfirstlane(tid >> 6), lane = tid & 63, fr = lane & 15, fq = lane >> 4;
    LAS float* st = (LAS float*)lds;
    LAS bf16_t* Wl = (LAS bf16_t*)(lds + 1024);
    LAS bf16_t* Vn = Wl + 128 * 136;
    LAS float* bsl = (LAS float*)(Vn + 128 * 136);
    const size_t row0 = (size_t)blk * 128;
    const int cc = tid & 15;
    u32x4 wq[4], vq[4]; f32x4 lg0, lg1, lb0, lb1;
#define MA_PREFETCH(g) do { _Pragma("unroll") for (int it = 0; it < 4; ++it) { const int q = tid + 512 * it; wq[it] = *(const u32x4*)(WSB + (g) * 16384 + (q >> 4) * 128 + (q & 15) * 8); \
        vq[it] = *(const u32x4*)(Z + (row0 + (tid >> 4) + 32 * it) * ZLD + ZSEC + (g) * 128 + cc * 8); } \
        lg0 = *(const f32x4*)(ln_g + (g) * 128 + cc * 8); lg1 = *(const f32x4*)(ln_g + (g) * 128 + cc * 8 + 4); lb0 = *(const f32x4*)(ln_b + (g) * 128 + cc * 8); lb1 = *(const f32x4*)(ln_b + (g) * 128 + cc * 8 + 4); } while (0)
    MA_PREFETCH(0);
    u32x2 un[8];
#define MA_LOAD_U(g) do { _Pragma("unroll") for (int it = 0; it < 8; ++it) un[it] = *(const u32x2*)(Z + (row0 + 16 * it + fr) * ZLD + (g) * 128 + 16 * wave + 4 * fq); } while (0)
    MA_LOAD_U(0);
    bsl[tid] = b_s[tid]; bsl[512 + tid] = b_s[512 + tid];
#pragma unroll 8
    for (int rr = 0; rr < 16; ++rr) {
        const int r = 16 * wave + rr; const bf16_t* vp = Z + (row0 + r) * ZLD + ZSEC + lane * 16;
        const u32x4 w0 = *(const u32x4*)vp, w1 = *(const u32x4*)(vp + 8);
        float f[16] = {bf_lo(w0.x), bf_hi(w0.x), bf_lo(w0.y), bf_hi(w0.y), bf_lo(w0.z), bf_hi(w0.z), bf_lo(w0.w), bf_hi(w0.w), bf_lo(w1.x), bf_hi(w1.x), bf_lo(w1.y), bf_hi(w1.y), bf_lo(w1.z), bf_hi(w1.z), bf_lo(w1.w), bf_hi(w1.w)};
        float s = 0.f, q = 0.f;
#pragma unroll
        for (int e = 0; e < 16; ++e) { s += f[e]; q += f[e] * f[e]; }
#pragma unroll
        for (int o = 1; o < 64; o <<= 1) { s += __shfl_xor(s, o); q += __shfl_xor(q, o); }
        const float mean = s * (1.f / 1024.f); const float var = fmaxf(q * (1.f / 1024.f) - mean * mean, 0.f);
        if (lane == 0) { st[2 * r] = mean; st[2 * r + 1] = rsqrtf(var + EPS); }
    }
    LDS_BARRIER();
    const unsigned vaddr = (unsigned)(uintptr_t)(Vn + (8 * fq + (fr >> 2)) * 136 + 16 * wave + 4 * (fr & 3));
    for (int g = 0; g < 8; ++g) {
#pragma unroll
        for (int it = 0; it < 4; ++it) { const int q = tid + 512 * it; *(LAS u32x4*)(Wl + (q >> 4) * 136 + (q & 15) * 8) = wq[it]; }
#pragma unroll
        for (int it = 0; it < 4; ++it) { const int j = (tid >> 4) + 32 * it; const u32x4 w = vq[it]; const float mu = st[2 * j], rs = st[2 * j + 1];
            const f32x4 o0 = (f32x4){(bf_lo(w.x) - mu) * rs * lg0[0] + lb0[0], (bf_hi(w.x) - mu) * rs * lg0[1] + lb0[1], (bf_lo(w.y) - mu) * rs * lg0[2] + lb0[2], (bf_hi(w.y) - mu) * rs * lg0[3] + lb0[3]};
            const f32x4 o1 = (f32x4){(bf_lo(w.z) - mu) * rs * lg1[0] + lb1[0], (bf_hi(w.z) - mu) * rs * lg1[1] + lb1[1], (bf_lo(w.w) - mu) * rs * lg1[2] + lb1[2], (bf_hi(w.w) - mu) * rs * lg1[3] + lb1[3]};
            *(LAS u32x4*)(Vn + j * 136 + cc * 8) = pack8(o0, o1); }
        LDS_BARRIER();
        u32x2 uq[8]; float bsv[8];
#pragma unroll
        for (int it = 0; it < 8; ++it) { uq[it] = un[it]; bsv[it] = bsl[g * 128 + 16 * it + fr]; }
        MA_LOAD_U(g < 7 ? g + 1 : 7);
        MA_PREFETCH(g < 7 ? g + 1 : 7);
        s16x4 t00, t01, t10, t11, t20, t21, t30, t31;
        asm volatile("ds_read_b64_tr_b16 %0, %8\n\tds_read_b64_tr_b16 %1, %8 offset:1088\n\tds_read_b64_tr_b16 %2, %8 offset:8704\n\tds_read_b64_tr_b16 %3, %8 offset:9792\n\t"
                     "ds_read_b64_tr_b16 %4, %8 offset:17408\n\tds_read_b64_tr_b16 %5, %8 offset:18496\n\tds_read_b64_tr_b16 %6, %8 offset:26112\n\tds_read_b64_tr_b16 %7, %8 offset:27200\n\ts_waitcnt lgkmcnt(0)"
                     : "=&v"(t00), "=&v"(t01), "=&v"(t10), "=&v"(t11), "=&v"(t20), "=&v"(t21), "=&v"(t30), "=&v"(t31) : "v"(vaddr) : "memory");
        bf16x8 avk[4];
        avk[0] = __builtin_shufflevector(t00, t01, 0, 1, 2, 3, 4, 5, 6, 7); avk[1] = __builtin_shufflevector(t10, t11, 0, 1, 2, 3, 4, 5, 6, 7);
        avk[2] = __builtin_shufflevector(t20, t21, 0, 1, 2, 3, 4, 5, 6, 7); avk[3] = __builtin_shufflevector(t30, t31, 0, 1, 2, 3, 4, 5, 6, 7);
        f32x4 acc[8];
#pragma unroll
        for (int it = 0; it < 8; ++it) acc[it] = (f32x4){0.f, 0.f, 0.f, 0.f};
#pragma unroll
        for (int k = 0; k < 4; ++k) {
#pragma unroll
            for (int it = 0; it < 8; ++it) { if (it < 4 && k >= 2) continue;
                const bf16x8 bv = *(const LAS bf16x8*)(Wl + (16 * it + fr) * 136 + 32 * k + 8 * fq);
                acc[it] = __builtin_amdgcn_mfma_f32_16x16x32_bf16(avk[k], bv, acc[it], 0, 0, 0); } }
#pragma unroll
        for (int it = 0; it < 8; ++it) { const float bs = bsv[it]; const u32x2 uw = uq[it];
            u32x2 o; o.x = cvt_pk_bf16(bf_lo(uw.x) * (acc[it][0] + bs), bf_hi(uw.x) * (acc[it][1] + bs)); o.y = cvt_pk_bf16(bf_lo(uw.y) * (acc[it][2] + bs), bf_hi(uw.y) * (acc[it][3] + bs));
            *(u32x2*)(AO + (row0 + 16 * it + fr) * DM + g * 128 + 16 * wave + 4 * fq) = o; }
        LDS_BARRIER();
    }
#undef MA_PREFETCH
#undef MA_LOAD_U
}

typedef float f32x16 __attribute__((ext_vector_type(16)));
__device__ __forceinline__ void mixerB_unit(LAS unsigned char* lds, int unit, const bf16_t* Z, bf16_t* BO, const bf16_t* LRT, const float* BIASP, const float* conv_w, const float* conv_b) {
    const int tid = threadIdx.x, wave = __builtin_amdgcn_readfirstlane(tid >> 6), lane = tid & 63, l31 = lane & 31, hh = lane >> 5;
    const int b = unit >> 5, hd = (unit >> 1) & 15, half = unit & 1, ch0 = hd * 64, jo = half * 32;
    const bool is_c = wave < 4;
    constexpr int NT = SEQ / 128;
    LAS bf16_t* wl = (LAS bf16_t*)lds;
    LAS bf16_t* xrl = (LAS bf16_t*)(lds + 36864);
    LAS float* cwl = (LAS float*)(lds + 74592);
    LAS float* alb = (LAS float*)(lds + 75616);
    LAS float* gil = (LAS float*)(lds + 112480);
    LAS float* sA = (LAS float*)(lds + 130912);
    LAS float* sH = sA + 256;
    LAS float* cry = sH + 256;
#pragma unroll
    for (int it = 0; it < 4; ++it) { const int q = tid + 512 * it, row = q >> 3, c8 = q & 7, gate = row >> 7, k = (row >> 5) & 3, j = row & 31;
        *(LAS u32x4*)(wl + row * 72 + c8 * 8) = *(const u32x4*)(LRT + ((size_t)((gate * 16 + hd) * 4 + k) * 64 + jo + j) * 64 + c8 * 8); }
    if (tid < 128) cwl[tid] = conv_w[(tid >> 5) * DM + ch0 + jo + (tid & 31)];
    else if (tid < 192) { const int wq = (tid - 128) >> 5, ch = ch0 + jo + (tid & 31); cwl[128 + (tid - 128)] = BIASP[wq * DM + ch]; cwl[192 + (tid - 128)] = wq ? conv_b[ch] : BIASP[2 * DM + ch]; }
    if (tid < 64) cry[tid] = 0.f;
    const int sid = tid & 255, sc = sid & 31, seg = sid >> 5;
    const bf16_t* xbase = Z + ((size_t)b * SEQ + (sid >> 3)) * ZLD + 2 * ZSEC + ch0 + (sid & 7) * 8;
    const bf16_t* xhalo = Z + ((size_t)b * SEQ + (sid < 24 ? (sid >> 3) : 0)) * ZLD + 2 * ZSEC + ch0 + (sid & 7) * 8 - (ptrdiff_t)3 * ZLD;
    const bf16_t* gbase = Z + ((size_t)b * SEQ + 16 * seg) * ZLD + 3 * ZSEC + ch0 + jo + sc;
    bf16_t* obase = BO + ((size_t)b * SEQ + 16 * seg) * DM + ch0 + jo + sc;
    u32x4 rq[4], hq; unsigned gy[16];
#define MB_LOAD_RAW(tile) do { const bf16_t* xp_ = xbase + (size_t)(tile) * 128 * ZLD; _Pragma("unroll") for (int it = 0; it < 4; ++it) rq[it] = *(const u32x4*)(xp_ + (size_t)(32 * it) * ZLD); \
        hq = *(const u32x4*)(xhalo + (size_t)((tile) > 0 ? (tile) : 1) * 128 * ZLD); } while (0)
#define MB_STORE_RAW(buf) do { LAS bf16_t* xd_ = xrl + (buf) * 9432; _Pragma("unroll") for (int it = 0; it < 4; ++it) *(LAS u32x4*)(xd_ + (3 + (sid >> 3) + 32 * it) * 72 + (sid & 7) * 8) = rq[it]; \
        if (sid < 24) *(LAS u32x4*)(xd_ + (sid >> 3) * 72 + (sid & 7) * 8) = hq; } while (0)
#define MB_LOAD_GY(tile) do { _Pragma("unroll") for (int s_ = 0; s_ < 16; ++s_) gy[s_] = (unsigned)gbase[((size_t)(tile) * 128 + s_) * ZLD]; } while (0)
    const int t_ = 32 * wave + l31;
#define MB_MFMA(GATE, buf, a0_, a1_) do { const LAS bf16_t* xs_ = xrl + (buf) * 9432; _Pragma("unroll") for (int e_ = 0; e_ < 16; ++e_) { a0_[e_] = 0.f; a1_[e_] = 0.f; } \
        _Pragma("unroll") for (int ks = 0; ks < 16; ks += 2) { \
            const bf16x8 w0_ = *(const LAS bf16x8*)(wl + (((GATE) * 4 + (ks >> 2)) * 32 + l31) * 72 + 16 * (ks & 3) + 8 * hh), x0_ = *(const LAS bf16x8*)(xs_ + (t_ + (ks >> 2)) * 72 + 16 * (ks & 3) + 8 * hh); \
            const bf16x8 w1_ = *(const LAS bf16x8*)(wl + (((GATE) * 4 + ((ks + 1) >> 2)) * 32 + l31) * 72 + 16 * ((ks + 1) & 3) + 8 * hh), x1_ = *(const LAS bf16x8*)(xs_ + (t_ + ((ks + 1) >> 2)) * 72 + 16 * ((ks + 1) & 3) + 8 * hh); \
            a0_ = __builtin_amdgcn_mfma_f32_32x32x16_bf16(w0_, x0_, a0_, 0, 0, 0); a1_ = __builtin_amdgcn_mfma_f32_32x32x16_bf16(w1_, x1_, a1_, 0, 0, 0); \
            if ((ks & 2) != 0) __builtin_amdgcn_sched_barrier(0); } \
        } while (0)
#define MB_EW_R(accA, accB, dst) do { const LAS float* bsl_ = cwl + 128; const LAS float* c2l_ = cwl + 192; \
        _Pragma("unroll") for (int i = 0; i < 4; ++i) { f32x4 o_; const f32x4 bs_ = *(const LAS f32x4*)(bsl_ + 8 * i + 4 * hh), c2_ = *(const LAS f32x4*)(c2l_ + 8 * i + 4 * hh); \
            _Pragma("unroll") for (int j = 0; j < 4; ++j) o_[j] = __builtin_amdgcn_exp2f(-c2_[j] * fsigmoid(((accA)[4 * i + j] + (accB)[4 * i + j]) + bs_[j])); \
            *(LAS f32x4*)((dst) + t_ * 36 + 8 * i + 4 * hh) = o_; } } while (0)
#define MB_EW_I(accA, accB, buf, dst) do { const LAS bf16_t* xs_ = xrl + (buf) * 9432; const LAS float* bsl_ = cwl + 160; const LAS float* c2l_ = cwl + 224; \
        _Pragma("unroll") for (int i = 0; i < 4; ++i) { f32x4 xc_ = *(const LAS f32x4*)(c2l_ + 8 * i + 4 * hh); const f32x4 bs_ = *(const LAS f32x4*)(bsl_ + 8 * i + 4 * hh); \
            _Pragma("unroll") for (int k = 0; k < 4; ++k) { const u32x2 w_ = *(const LAS u32x2*)(xs_ + (t_ + k) * 72 + jo + 8 * i + 4 * hh); const f32x4 cw_ = *(const LAS f32x4*)(cwl + k * 32 + 8 * i + 4 * hh); \
                xc_[0] += cw_[0] * bf_lo(w_.x); xc_[1] += cw_[1] * bf_hi(w_.x); xc_[2] += cw_[2] * bf_lo(w_.y); xc_[3] += cw_[3] * bf_hi(w_.y); } \
            f32x4 o_; \
            _Pragma("unroll") for (int j = 0; j < 4; ++j) o_[j] = fsigmoid(((accA)[4 * i + j] + (accB)[4 * i + j]) + bs_[j]) * xc_[j]; \
            *(LAS f32x4*)((dst) + t_ * 36 + 8 * i + 4 * hh) = o_; } } while (0)
    if (!is_c) { MB_LOAD_RAW(0); hq = (u32x4){0u, 0u, 0u, 0u}; MB_STORE_RAW(0); MB_LOAD_RAW(1); MB_STORE_RAW(1); MB_LOAD_RAW(2); MB_LOAD_GY(0); }
    LDS_BARRIER();
    f32x16 accR0, accR1, accI0, accI1;
    if (is_c) { MB_MFMA(0, 0, accR0, accR1); MB_MFMA(1, 0, accI0, accI1); MB_EW_R(accR0, accR1, alb); MB_EW_I(accI0, accI1, 0, gil); MB_MFMA(0, 1, accR0, accR1); }
    LDS_BARRIER();
    float a16[16], g16[16];
    for (int tile = 0; tile < NT; ++tile) {
        if (is_c) { MB_MFMA(1, (tile + 1) & 1, accI0, accI1); MB_EW_R(accR0, accR1, alb + ((tile + 1) & 1) * 4608); }
        else {
            const LAS float* al = alb + (tile & 1) * 4608; float A = 1.f, Hh = 0.f;
#pragma unroll
            for (int s = 0; s < 16; ++s) { const float av = al[(16 * seg + s) * 36 + sc]; a16[s] = av; g16[s] = __builtin_amdgcn_sqrtf(fmaxf(1.0f - av * av, 0.f)) * gil[(16 * seg + s) * 36 + sc]; A *= av; Hh = av * Hh + g16[s]; }
            sA[seg * 32 + sc] = A; sH[seg * 32 + sc] = Hh;
            MB_STORE_RAW(tile & 1);
            MB_LOAD_RAW(tile + 3 < NT ? tile + 3 : NT - 1);
        }
        LDS_BARRIER();
        if (is_c) { MB_MFMA(0, tile & 1, accR0, accR1); MB_EW_I(accI0, accI1, (tile + 1) & 1, gil); }
        else {
            float h = cry[(tile & 1) * 32 + sc];
#pragma unroll
            for (int s = 0; s < 7; ++s) { const float As = sA[s * 32 + sc], Hs = sH[s * 32 + sc]; h = (s < seg) ? As * h + Hs : h; }
            bf16_t* op = obase + (size_t)tile * 128 * DM;
#pragma unroll
            for (int s = 0; s < 16; ++s) { h = a16[s] * h + g16[s]; op[(size_t)s * DM] = f2bf(h * __builtin_bit_cast(float, gy[s] << 16)); }
            if (seg == 7) cry[((tile + 1) & 1) * 32 + sc] = h;
            MB_LOAD_GY(tile + 1 < NT ? tile + 1 : NT - 1);
        }
        LDS_BARRIER();
    }
#undef MB_LOAD_RAW
#undef MB_STORE_RAW
#undef MB_LOAD_GY
#undef MB_MFMA
#undef MB_EW_R
#undef MB_EW_I
}

typedef __attribute__((address_space(1))) unsigned gu32;
#define XB_TMO      128
#define XB_XCNT(j)  (256  + 64 * (j))
#define XB_XSUB(j)  (1280 + 64 * (j))
#define XB_XGEN(j)  (2304 + 64 * (j))
#define XB_TOP      3328
#define XB_TOPGEN   3392
#define XCD_BAR_WORDS 3456
#define XB_SPIN_CAP (1u << 18)

__device__ __forceinline__ unsigned xb_ld(unsigned* p)              { return __hip_atomic_load(p, __ATOMIC_RELAXED, __HIP_MEMORY_SCOPE_AGENT); }
__device__ __forceinline__ unsigned xb_add(unsigned* p, unsigned v) { return __hip_atomic_fetch_add(p, v, __ATOMIC_RELAXED, __HIP_MEMORY_SCOPE_AGENT); }
__device__ __forceinline__ unsigned xb_xcc_id() { return (unsigned)__builtin_amdgcn_s_getreg((3 << 11) | 20) & 0xFu; }
#define XB_SPIN(cond, bar) do { unsigned _sp = 0; while (cond) { __builtin_amdgcn_s_sleep(1); \
    if ((++_sp & 255u) == 0u) { if (xb_ld(&(bar)[XB_TMO])) break; if (_sp > XB_SPIN_CAP) { atomicAdd(&(bar)[XB_TMO], 1u); break; } } } } while (0)

struct XcdBarrier {
    unsigned* bar; unsigned x;
    volatile LAS unsigned* st;
};

__device__ __forceinline__ XcdBarrier xcd_barrier_post(unsigned* bar, volatile LAS unsigned* st) {
    XcdBarrier b; b.bar = bar; b.x = xb_xcc_id(); b.st = st;
    if (threadIdx.x == 0) (void)xb_add(&bar[XB_XCNT(b.x)], 1u);
    return b;
}
__device__ __forceinline__ void xcd_barrier_complete(unsigned* bar, unsigned x, unsigned& nloc, unsigned& nx) {
    const unsigned G = gridDim.x * gridDim.y * gridDim.z;
    unsigned sum, cnt, mine, sp = 0u;
    for (;;) {
        sum = 0u; cnt = 0u; mine = 0u;
#pragma unroll
        for (unsigned j = 0; j < 16; ++j) { const unsigned c = xb_ld(&bar[XB_XCNT(j)]); sum += c; cnt += (c > 0u) ? 1u : 0u; mine = (j == x) ? c : mine; }
        if (sum == G) break;
        __builtin_amdgcn_s_sleep(1);
        if ((++sp & 255u) == 0u) { if (xb_ld(&bar[XB_TMO])) break; if (sp > XB_SPIN_CAP) { atomicAdd(&bar[XB_TMO], 1u); break; } }
    }
    nloc = mine > 0u ? mine : 1u; nx = cnt > 0u ? cnt : 1u;
}

__device__ __forceinline__ void xcd_barrier(const XcdBarrier& b) {
    asm volatile("s_waitcnt vmcnt(0)" ::: "memory");
    __syncthreads();
    if (threadIdx.x == 0) {
        unsigned* bar = b.bar;
        __builtin_amdgcn_s_waitcnt(0);
        unsigned nloc = b.st[0], nx = b.st[1];
        if (nloc == 0u) { xcd_barrier_complete(bar, b.x, nloc, nx); b.st[0] = nloc; b.st[1] = nx; }
        const unsigned old = xb_add(&bar[XB_XSUB(b.x)], 1u);
        const unsigned gen = old / nloc;
        if (old + 1u == (gen + 1u) * nloc) {
            __builtin_amdgcn_fence(__ATOMIC_RELEASE, "agent");
            asm volatile("s_waitcnt vmcnt(0)" ::: "memory");
            const unsigned og = xb_add(&bar[XB_TOP], 1u);
            const unsigned tg = og / nx;
            if (og + 1u == (tg + 1u) * nx) xb_add(&bar[XB_TOPGEN], 1u);
            else XB_SPIN(xb_ld(&bar[XB_TOPGEN]) == tg, bar);
            __builtin_amdgcn_fence(__ATOMIC_ACQUIRE, "agent");
            xb_add(&bar[XB_XGEN(b.x)], 1u);
            asm volatile("s_waitcnt vmcnt(0)" ::: "memory");
        } else {
            XB_SPIN(xb_ld(&bar[XB_XGEN(b.x)]) == gen, bar);
            __builtin_amdgcn_fence(__ATOMIC_ACQUIRE, "agent");
            asm volatile("s_waitcnt vmcnt(0)" ::: "memory");
        }
    }
    __syncthreads();
}
typedef const __attribute__((address_space(4))) Args* KArgs;
__device__ __forceinline__ KArgs kargs() {
#if defined(__HIP_DEVICE_COMPILE__)
    auto p0 = __builtin_amdgcn_kernarg_segment_ptr(); KArgs p = (KArgs)p0; asm volatile("" : "+s"(p)); return p;
#else
    return nullptr;
#endif
}
constexpr int NPHASE = 12;
__global__ void __launch_bounds__(NTHR, 2) fwd_kernel(Args args) {
    extern __shared__ __attribute__((aligned(16))) unsigned char lds_raw[];
    LAS unsigned char* lds = (LAS unsigned char*)lds_raw;
    const int lo = args.ph_lo, hi = args.ph_hi;
    volatile LAS unsigned* bst = (volatile LAS unsigned*)(lds + LDS_BYTES - 64);
    if (threadIdx.x == 0) { bst[0] = 0u; bst[1] = 0u; }
    __syncthreads();
    XcdBarrier xbar; xbar.bar = (unsigned*)args.ws; xbar.x = 0; xbar.st = bst;
    if (hi - lo > 1) xbar = xcd_barrier_post((unsigned*)args.ws, bst);
#define IN(k) (lo <= (k) && (k) < hi)
#define SEAM(k) do { if (IN(k) && IN((k) + 1)) { if ((k) == 0) cg::this_grid().sync(); else xcd_barrier(xbar); } } while (0)
#define PH KArgs ka = kargs(); unsigned char* ws = ka->ws; bf16_t* Z = (bf16_t*)(ws + WS_Z); bf16_t* H = (bf16_t*)(ws + WS_H); const int G = gridDim.x, bx = blockIdx.x; (void)Z; (void)H; (void)G; (void)bx;
#define WV const int lane = threadIdx.x & 63, wave = __builtin_amdgcn_readfirstlane(threadIdx.x >> 6);
    typedef pg8::StaticOrder SO;
    typedef PanelOrder PO;
    if (IN(0)) { PH WV prologue(ka, lds, bx * NWAVES + wave, G * NWAVES, wave, lane); __syncthreads(); }
    SEAM(0);
    if (IN(1)) { PH pg8::Gemm g{H, (const bf16_t*)(ws + WS_WIN), M, NIN, DM, DM}; SO S; S.init(M, NIN, G, bx); EpiZ E{Z};
        pg8::gemm_phase<EpiZ, SO, true, true>(lds, g, S, E); }
    SEAM(1);
    if (IN(2)) { PH mixerB_unit(lds, ((((bx >> 4) << 3) | (bx & 7)) << 1) | ((bx >> 3) & 1), Z, (bf16_t*)ka->out + (size_t)M * DM, (const bf16_t*)(ws + WS_LRT), (const float*)(ws + WS_BIASP), ka->in[9], ka->in[10]); }
    if (IN(3)) { PH for (int u = bx; u < M / 128; u += G) mixerA_unit(lds, u, Z, (bf16_t*)ka->out, (const bf16_t*)(ws + WS_WSB), ka->in[5], ka->in[6], ka->in[8]); }
    SEAM(3);
    if (IN(4)) { PH
        { SO S; S.init(M, DM, G, bx); pg8::Gemm g{(const bf16_t*)ka->out, (const bf16_t*)(ws + WS_WA), M, DM, DM, DM}; EpiGate<false> E{Z + ZSEC, Z + 4 * ZSEC, ZLD}; pg8::gemm_phase<EpiGate<false>, SO, true, true>(lds, g, S, E); }
        __syncthreads();
        { SO S; S.init(M, DM, G, bx); pg8::Gemm g{(const bf16_t*)ka->out + (size_t)M * DM, (const bf16_t*)(ws + WS_WB), M, DM, DM, DM}; EpiGate<true> E{Z + ZSEC, Z + 5 * ZSEC, ZLD}; pg8::gemm_phase<EpiGate<true>, SO, true, true>(lds, g, S, E); }
        __syncthreads();
    }
    SEAM(4);
    if (IN(5)) { PH PO S; S.init(DM, bx); pg8::Gemm g{Z + ZSEC, (const bf16_t*)(ws + WS_WO), M, DM, DM, ZLD}; EpiPlain E{Z + 2 * ZSEC, ZLD}; pg8::gemm_phase<EpiPlain, PO, true, true>(lds, g, S, E); __syncthreads(); }
    if (IN(6)) { PH WV norm_pass<false, true>((const unsigned char*)(ka->in[0] + (size_t)bx * 256 * DM), (size_t)DM * 4, Z + 2 * ZSEC + (size_t)bx * 256 * ZLD, ZLD, ka->in[3], (unsigned char*)ka->out + ((size_t)bx << 20), (size_t)DM * 2, ka->in[19], H + (size_t)bx * 256 * DM, wave, lane); }
    SEAM(6);
    if (IN(7)) { PH pg8::Gemm g{H, (const bf16_t*)(ws + WS_WGU), M, NGU, DM, DM}; SO S; S.init(M, NGU, G, bx); EpiSwiglu E{(bf16_t*)(ws + WS_ACT)};
        pg8::gemm_phase<EpiSwiglu, SO, true, true>(lds, g, S, E); }
    SEAM(7);
    if (IN(8)) { PH pg8::Gemm g{(const bf16_t*)(ws + WS_ACT), (const bf16_t*)(ws + WS_WDN), M, DM, DFF, DFF}; SO S; S.init(M, DM, G, bx); EpiPlain E{(bf16_t*)(ws + WS_F), DM};
        pg8::gemm_phase<EpiPlain, SO, true, true>(lds, g, S, E); }
    SEAM(8);
    if (IN(9)) { PH WV bf16_t* F = (bf16_t*)(ws + WS_F) + (size_t)bx * 256 * DM; norm_pass<true, true>((const unsigned char*)ka->out + ((size_t)bx << 20), (size_t)DM * 2, F, DM, ka->in[20], (unsigned char*)F, (size_t)DM * 2, ka->in[24], H + (size_t)bx * 256 * DM, wave, lane); __syncthreads(); }
    if (IN(10)) { PH
        { PO S; S.init(DM, bx); pg8::Gemm g{(const bf16_t*)(ws + WS_PB), (const bf16_t*)(ws + WS_WPIN), M, DM, PLE, PLE}; EpiPlain E{(bf16_t*)(ws + WS_GE), DM}; pg8::gemm_phase<EpiPlain, PO, true, true>(lds, g, S, E); }
        __syncthreads();
        { PO S; S.init(DM, bx); pg8::Gemm g{H, (const bf16_t*)(ws + WS_WPG), M, DM, DM, DM}; EpiSigMul E{(bf16_t*)(ws + WS_GE)}; pg8::gemm_phase<EpiSigMul, PO, true, true>(lds, g, S, E); }
        __syncthreads();
    }
    if (IN(11)) { PH WV norm_pass<true, false>((const unsigned char*)(ws + WS_F) + (size_t)bx * 256 * DM * 2, (size_t)DM * 2, (const bf16_t*)(ws + WS_GE) + (size_t)bx * 256 * DM, DM, ka->in[25], (unsigned char*)(ka->out + (size_t)bx * 256 * DM), (size_t)DM * 4, nullptr, nullptr, wave, lane); }
#undef PH
#undef WV
#undef IN
#undef SEAM
}

extern "C" void kernel_launch(void* const* d_in, const int* in_sizes, int n_in, void* d_out, int out_size, void* d_ws, size_t ws_size, hipStream_t stream) {
    static int grid = 0;
    if (grid == 0) {
        if (n_in != 28 || in_sizes[0] != M * DM || out_size != M * DM || ws_size < WS_END) { fprintf(stderr, "kernel_launch: unexpected shapes (n_in %d, in0 %d, out %d, ws %zu)\n", n_in, n_in > 0 ? in_sizes[0] : -1, out_size, ws_size); grid = -1; return; }
        int dev = 0, cus = 0, per_cu = 0;
        if (hipGetDevice(&dev) != hipSuccess || hipDeviceGetAttribute(&cus, hipDeviceAttributeMultiprocessorCount, dev) != hipSuccess) { grid = -1; return; }
        if (hipFuncSetAttribute((const void*)fwd_kernel, hipFuncAttributeMaxDynamicSharedMemorySize, LDS_BYTES) != hipSuccess) { fprintf(stderr, "kernel_launch: hipFuncSetAttribute failed\n"); grid = -1; return; }
        if (hipOccupancyMaxActiveBlocksPerMultiprocessor(&per_cu, (const void*)fwd_kernel, NTHR, LDS_BYTES) != hipSuccess || per_cu < 1) { fprintf(stderr, "kernel_launch: occupancy query says %d\n", per_cu); per_cu = 1; }
        (void)hipGetLastError();
        grid = cus * 1;
        if (grid != M / 256) { fprintf(stderr, "kernel_launch: built for a 256-CU device (one workgroup per 256-row panel); got %d CUs\n", cus); grid = -1; return; }
    }
    if (grid < 0) return;
    if (hipMemsetAsync(d_ws, 0, 16384, stream) != hipSuccess) { fprintf(stderr, "kernel_launch: memset failed\n"); return; }
    Args a{};
    for (int i = 0; i < 28; ++i) a.in[i] = (const float*)d_in[i];
    a.out = (float*)d_out; a.ws = (unsigned char*)d_ws;
#if MK_ONE
    a.ph_lo = 0; a.ph_hi = NPHASE;
    void* kargs[] = {&a};
    hipError_t e = hipLaunchCooperativeKernel((const void*)fwd_kernel, dim3(grid), dim3(NTHR), kargs, LDS_BYTES, stream);
    if (e != hipSuccess) fprintf(stderr, "kernel_launch: cooperative launch failed: %s (grid %d)\n", hipGetErrorString(e), grid);
#else
    for (int k = 0; k < NPHASE; ++k) for (int rep = 0; rep < 1 + ((REP_MASK >> k) & 1); ++rep) { a.ph_lo = k; a.ph_hi = k + 1; hipLaunchKernelGGL(fwd_kernel, dim3(grid), dim3(NTHR), LDS_BYTES, stream, a); }
#endif
}
```

```cpp
#include <hip/hip_runtime.h>
#include <hip/hip_cooperative_groups.h>
#include <cstdio>
#include <cstdint>
namespace cg = cooperative_groups;
#ifndef REP_MASK
#define REP_MASK 0
#endif
#ifndef MK_ONE
#define MK_ONE 1
#endif
namespace pg8 {
#define PG8_LAS __attribute__((address_space(3)))
typedef unsigned short bf16_t;
typedef short bf16x8 __attribute__((ext_vector_type(8)));
typedef float f32x4 __attribute__((ext_vector_type(4)));
typedef unsigned u32x4 __attribute__((ext_vector_type(4)));
constexpr int BM = 256, BK = 64, HALF = 128, HTB = HALF * BK * 2  , STAGE_BYTES = 8 * HTB, NXCD = 8, WGM = 8;

__host__ __device__ __forceinline__ int lds_byte(int r, int c) { const int st = (r >> 4) * 2 + (c >> 5), rr = r & 15, cc = c & 31, ob = rr * 64 + cc * 2; return st * 1024 + (ob ^ (((ob >> 9) & 1) << 5)); }
__host__ __device__ __forceinline__ void stage_rc(int b, int& R, int& C) { const int st = b / 1024, sb = b % 1024, swz = sb ^ (((sb >> 9) & 1) << 5); R = (st >> 1) * 16 + swz / 64; C = (st & 1) * 32 + (swz % 64) / 2; }
__host__ __device__ __forceinline__ int perm32(int rho) { const int n = rho >> 4, i = rho & 15; return 8 * (i >> 2) + 4 * n + (i & 3); }

struct Unit { int pm, pn; };
struct Gemm { const bf16_t* A; const bf16_t* Bt; int M, N, K, lda; };

struct StaticOrder {
    int nM, nN, nwg, G, c;
    __host__ __device__ void init(int M, int N, int G_, int c_) { nM = M / BM; nN = N / BM; nwg = nM * nN; G = G_; c = c_; }
    __host__ __device__ bool next(int i, Unit& u) const {
        const long L = (long)i * G + c; if (L >= nwg) return false;
        int wgid = (int)L; { const int q = nwg / NXCD, r = nwg % NXCD, xcd = wgid % NXCD, off = wgid / NXCD; wgid = (xcd < r ? xcd * (q + 1) : r * (q + 1) + (xcd - r) * q) + off; }
        const int nig = WGM * nN, gid = wgid / nig, fm = gid * WGM, gsz = (nM - fm) < WGM ? (nM - fm) : WGM;
        u.pm = fm + ((wgid % nig) % gsz); u.pn = (wgid % nig) / gsz; return true;
    }
    __device__ __forceinline__ void a_ready(const Unit&) const {}
    __device__ __forceinline__ void done(const Unit&) const {}
};

__device__ __forceinline__ unsigned cvt_pk_bf16(float lo, float hi) { unsigned r; asm volatile("v_cvt_pk_bf16_f32 %0, %1, %2" : "=v"(r) : "v"(lo), "v"(hi)); return r; }
typedef float f32x2 __attribute__((ext_vector_type(2)));
template <class Epi, class Sched, bool ALIGN_EPI = false, bool SP2 = false>
__device__ __forceinline__ void gemm_phase(PG8_LAS unsigned char* lds, const Gemm g, const Sched& S, const Epi& E) {
    const int tid = threadIdx.x, wid = __builtin_amdgcn_readfirstlane(tid >> 6), lane = tid & 63, wr = wid >> 2, wc = wid & 3, fr = lane & 15, fq = lane >> 4;
    const int K = g.K, nt = K / BK;
    unsigned voffA[2], voffB[2];
#pragma unroll
    for (int i = 0; i < 2; ++i) { int R, C; stage_rc(tid * 16 + i * 8192, R, C); const int Rb = Epi::PERM ? ((R & ~31) + perm32(R & 31)) : R;
        voffA[i] = (unsigned)(R * g.lda + C) * 2u; voffB[i] = (unsigned)(Rb * K + C) * 2u; }
    const size_t kstep = (size_t)(BK * 2);
    const size_t hstepA = (size_t)HALF * g.lda * 2, hstepB = (size_t)HALF * K * 2;
    const size_t tstepA = 2 * hstepA, tstepB = 2 * hstepB;
    const unsigned ldsw = (unsigned)wid * 1024u;
    const int aoff = lds_byte(wr * 64 + fr, fq * 8), boff = lds_byte(wc * 32 + fr, fq * 8);
#define PG8_SA(b, h) (((b) * 2 + (h)) * HTB)
#define PG8_SB(b, h) ((4 + (b) * 2 + (h)) * HTB)
#define PG8_STAGE(bufoff, gbase, voff) do { _Pragma("unroll") for (int _i = 0; _i < 2; ++_i) \
        __builtin_amdgcn_global_load_lds((const unsigned*)((const char*)(gbase) + (voff)[_i]), (PG8_LAS unsigned*)(lds + (bufoff) + ldsw + _i * 8192), 16, 0, 0); } while (0)
#define PG8_LDA(dst, b, h) do { _Pragma("unroll") for (int m = 0; m < 4; ++m) _Pragma("unroll") for (int k = 0; k < 2; ++k) dst[m][k] = *(const PG8_LAS bf16x8*)(lds + PG8_SA(b, h) + aoff + m * 2048 + k * 1024); } while (0)
#define PG8_LDB(dst, b, h) do { _Pragma("unroll") for (int n = 0; n < 2; ++n) _Pragma("unroll") for (int k = 0; k < 2; ++k) dst[n][k] = *(const PG8_LAS bf16x8*)(lds + PG8_SB(b, h) + boff + n * 2048 + k * 1024); } while (0)
#define PG8_MMA(ai, bj, At, Bt) do { __builtin_amdgcn_s_setprio(1); _Pragma("unroll") for (int m = 0; m < 4; ++m) _Pragma("unroll") for (int n = 0; n < 2; ++n) _Pragma("unroll") for (int k = 0; k < 2; ++k) \
        acc[ai][bj][m][n] = __builtin_amdgcn_mfma_f32_16x16x32_bf16(Bt[n][k], At[m][k], acc[ai][bj][m][n], 0, 0, 0); __builtin_amdgcn_s_setprio(0); } while (0)
#define PG8_WAIT_V(n) asm volatile("s_waitcnt vmcnt(" #n ")" ::: "memory")
#define PG8_WAIT_L(n) asm volatile("s_waitcnt lgkmcnt(" #n ")" ::: "memory")
#define PG8_BAR __builtin_amdgcn_s_barrier()
#define PG8_SCHED __builtin_amdgcn_sched_barrier(0)
    Unit cur, nxt; int ui = 0;
    if (!S.next(0, cur)) return;
    f32x4 acc[2][2][4][2];
#pragma unroll
    for (int a = 0; a < 2; ++a)
#pragma unroll
        for (int b = 0; b < 2; ++b)
#pragma unroll
            for (int m = 0; m < 4; ++m)
#pragma unroll
                for (int n = 0; n < 2; ++n) acc[a][b][m][n] = (f32x4){0.f, 0.f, 0.f, 0.f};
    bf16x8 At[4][2], B0[2][2], B1[2][2];
    const char* cA = (const char*)g.A + (size_t)cur.pm * tstepA; const char* cB = (const char*)g.Bt + (size_t)cur.pn * tstepB;
    S.a_ready(cur);
    if constexpr (SP2) {
        PG8_STAGE(PG8_SB(0, 0), cB, voffB); PG8_STAGE(PG8_SB(0, 1), cB + hstepB, voffB); PG8_STAGE(PG8_SA(0, 0), cA, voffA); PG8_STAGE(PG8_SA(0, 1), cA + hstepA, voffA);
        if (wr == 1) PG8_BAR;
        PG8_WAIT_V(2); PG8_BAR;
        PG8_STAGE(PG8_SB(1, 0), cB + kstep, voffB); PG8_STAGE(PG8_SA(1, 0), cA + kstep, voffA); PG8_STAGE(PG8_SB(1, 1), cB + hstepB + kstep, voffB);
        PG8_WAIT_V(6); PG8_BAR;
    } else {
        PG8_STAGE(PG8_SB(0, 0), cB, voffB); PG8_STAGE(PG8_SA(0, 0), cA, voffA); PG8_STAGE(PG8_SB(0, 1), cB + hstepB, voffB); PG8_STAGE(PG8_SA(0, 1), cA + hstepA, voffA);
        if (wr == 1) PG8_BAR;
        PG8_WAIT_V(4); PG8_BAR;
        PG8_STAGE(PG8_SB(1, 0), cB + kstep, voffB); PG8_STAGE(PG8_SA(1, 0), cA + kstep, voffA); PG8_STAGE(PG8_SB(1, 1), cB + hstepB + kstep, voffB);
        PG8_WAIT_V(6); PG8_BAR;
    }
    for (;;) {
        const bool has_next = S.next(ui + 1, nxt);
        const char* nA = has_next ? (const char*)g.A + (size_t)nxt.pm * tstepA : cA; const char* nB = has_next ? (const char*)g.Bt + (size_t)nxt.pn * tstepB : cB;
        for (int t = 0; t < nt; t += 2) {
            const bool last = (t == nt - 2);
            const char* a1 = cA + (size_t)(t + 1) * kstep;
            const char* a2 = last ? nA : cA + (size_t)(t + 2) * kstep; const char* b2 = last ? nB : cB + (size_t)(t + 2) * kstep;
            const char* a3 = a2 + kstep; const char* b3 = b2 + kstep;
            if (last && has_next) S.a_ready(nxt);
            if constexpr (SP2) {
            PG8_LDB(B0, 0, 0); PG8_LDB(B1, 0, 1); PG8_SCHED; PG8_LDA(At, 0, 0); PG8_STAGE(PG8_SA(1, 1), a1 + hstepA, voffA);
            PG8_WAIT_V(8); PG8_WAIT_L(0); PG8_BAR; PG8_MMA(0, 0, At, B0); PG8_MMA(0, 1, At, B1); PG8_BAR; PG8_SCHED;
            PG8_LDA(At, 0, 1); PG8_STAGE(PG8_SB(0, 0), b2, voffB); PG8_STAGE(PG8_SB(0, 1), b2 + hstepB, voffB); PG8_STAGE(PG8_SA(0, 0), a2, voffA);
            PG8_WAIT_V(8); PG8_WAIT_L(0); PG8_BAR; PG8_MMA(1, 0, At, B0); PG8_MMA(1, 1, At, B1); PG8_BAR; PG8_SCHED;
            PG8_LDB(B0, 1, 0); PG8_LDB(B1, 1, 1); PG8_SCHED; PG8_LDA(At, 1, 0); PG8_STAGE(PG8_SA(0, 1), a2 + hstepA, voffA);
            PG8_WAIT_V(8); PG8_WAIT_L(0); PG8_BAR; PG8_MMA(0, 0, At, B0); PG8_MMA(0, 1, At, B1); PG8_BAR; PG8_SCHED;
            PG8_LDA(At, 1, 1); PG8_STAGE(PG8_SB(1, 0), b3, voffB); PG8_STAGE(PG8_SB(1, 1), b3 + hstepB, voffB); PG8_STAGE(PG8_SA(1, 0), a3, voffA);
            PG8_WAIT_V(8); PG8_WAIT_L(0); PG8_BAR; PG8_MMA(1, 0, At, B0); PG8_MMA(1, 1, At, B1); PG8_BAR; PG8_SCHED;
            } else {
            PG8_LDB(B0, 0, 0); PG8_SCHED; PG8_LDA(At, 0, 0); PG8_STAGE(PG8_SA(1, 1), a1 + hstepA, voffA);
            PG8_WAIT_L(8); PG8_BAR; PG8_WAIT_L(0); PG8_MMA(0, 0, At, B0); PG8_BAR; PG8_SCHED;
            PG8_LDB(B1, 0, 1); PG8_STAGE(PG8_SB(0, 0), b2, voffB);
            PG8_BAR; PG8_WAIT_L(0); PG8_MMA(0, 1, At, B1); PG8_BAR;
            PG8_LDA(At, 0, 1); PG8_STAGE(PG8_SA(0, 0), a2, voffA);
            PG8_BAR; PG8_WAIT_L(0); PG8_MMA(1, 0, At, B0); PG8_BAR; PG8_SCHED;
            PG8_STAGE(PG8_SB(0, 1), b2 + hstepB, voffB);
            PG8_WAIT_V(6); PG8_BAR; PG8_MMA(1, 1, At, B1); PG8_BAR;
            PG8_LDB(B0, 1, 0); PG8_SCHED; PG8_LDA(At, 1, 0); PG8_STAGE(PG8_SA(0, 1), a2 + hstepA, voffA);
            PG8_WAIT_L(8); PG8_BAR; PG8_WAIT_L(0); PG8_MMA(0, 0, At, B0); PG8_BAR; PG8_SCHED;
            PG8_LDB(B1, 1, 1); PG8_STAGE(PG8_SB(1, 0), b3, voffB);
            PG8_BAR; PG8_WAIT_L(0); PG8_MMA(0, 1, At, B1); PG8_BAR;
            PG8_LDA(At, 1, 1); PG8_STAGE(PG8_SA(1, 0), a3, voffA);
            PG8_BAR; PG8_WAIT_L(0); PG8_MMA(1, 0, At, B0); PG8_BAR; PG8_SCHED;
            PG8_STAGE(PG8_SB(1, 1), b3 + hstepB, voffB);
            PG8_WAIT_V(6); PG8_BAR; PG8_MMA(1, 1, At, B1); PG8_BAR;
            }
        }
        if constexpr (ALIGN_EPI) { if (wr == 0) PG8_BAR; }
        if constexpr (!Epi::AFTER_DRAIN) { E(acc, cur, wr, wc, fr, fq); S.done(cur); }
        if (!has_next) break;
#pragma unroll
        for (int a = 0; a < 2; ++a)
#pragma unroll
            for (int b = 0; b < 2; ++b)
#pragma unroll
                for (int m = 0; m < 4; ++m)
#pragma unroll
                    for (int n = 0; n < 2; ++n) acc[a][b][m][n] = (f32x4){0.f, 0.f, 0.f, 0.f};
        cur = nxt; cA = nA; cB = nB; ++ui;
        if constexpr (ALIGN_EPI) { if (wr == 1) PG8_BAR; }
    }
    PG8_WAIT_V(0);
    if constexpr (!ALIGN_EPI) { if (wr == 0) PG8_BAR; }
    PG8_BAR;
    if constexpr (Epi::AFTER_DRAIN) { E.fused(acc, cur, wr, wc, fr, fq, lds, wid, lane); S.done(cur); }
#undef PG8_SA
#undef PG8_SB
#undef PG8_STAGE
#undef PG8_LDA
#undef PG8_LDB
#undef PG8_MMA
#undef PG8_WAIT_V
#undef PG8_WAIT_L
#undef PG8_BAR
#undef PG8_SCHED
}
}
using pg8::bf16_t; using pg8::bf16x8; using pg8::f32x4; using pg8::u32x4; using pg8::Unit; using pg8::cvt_pk_bf16;
#define LAS __attribute__((address_space(3)))
typedef unsigned u32x2 __attribute__((ext_vector_type(2)));

constexpr int DM = 1024, BATCH = 8, SEQ = 8192, M = BATCH * SEQ, NIN = 6144, DFF = 2816, NGU = 2 * DFF, PLE = 256, ZLD = 1024;
constexpr size_t ZSEC = (size_t)M * 1024;
constexpr float EPS = 1e-6f;
constexpr size_t MiB = 1u << 20;
constexpr size_t WS_WIN = 1 * MiB, WS_WA = 13 * MiB, WS_WB = 15 * MiB, WS_WO = 17 * MiB, WS_WPG = 19 * MiB, WS_WGU = 21 * MiB, WS_WDN = 32 * MiB, WS_WPIN = 38 * MiB;
constexpr size_t WS_WSB = 38 * MiB + 512 * 1024, WS_BIASP = 38 * MiB + 768 * 1024, WS_LRT = 39 * MiB;
constexpr size_t WS_PB = 40 * MiB, WS_H = 72 * MiB, WS_Z = 200 * MiB, WS_ACT = 200 * MiB, WS_F = 552 * MiB, WS_GE = 680 * MiB, WS_END = 968 * MiB;
constexpr int NWAVES = 8, NTHR = 512, LDS_BYTES = 147456;

__device__ __forceinline__ float bf_lo(unsigned w) { return __builtin_bit_cast(float, w << 16); }
__device__ __forceinline__ float bf_hi(unsigned w) { return __builtin_bit_cast(float, w & 0xffff0000u); }
__device__ __forceinline__ float bf1(unsigned short h) { return __builtin_bit_cast(float, ((unsigned)h) << 16); }
__device__ __forceinline__ unsigned short f2bf(float f) { unsigned u = __builtin_bit_cast(unsigned, f); return (unsigned short)((u + 0x7fffu + ((u >> 16) & 1u)) >> 16); }
__device__ __forceinline__ float fsigmoid(float x) { return __builtin_amdgcn_rcpf(1.0f + __builtin_amdgcn_exp2f(-1.4426950408889634f * x)); }
__device__ __forceinline__ float fgelu(float x) { const float u = x * (0.7978845608028654f + 0.035677408136300125f * x * x); return x * __builtin_amdgcn_rcpf(1.0f + __builtin_amdgcn_exp2f(-2.8853900817779268f * u)); }
__device__ __forceinline__ f32x4 fgelu4(f32x4 x) { const f32x4 t = x * (x * x * 0.035677408136300125f + 0.7978845608028654f) * (-2.8853900817779268f);
    f32x4 e; e[0] = __builtin_amdgcn_exp2f(t[0]); e[1] = __builtin_amdgcn_exp2f(t[1]); e[2] = __builtin_amdgcn_exp2f(t[2]); e[3] = __builtin_amdgcn_exp2f(t[3]);
    const f32x4 d = e + 1.0f; f32x4 r; r[0] = __builtin_amdgcn_rcpf(d[0]); r[1] = __builtin_amdgcn_rcpf(d[1]); r[2] = __builtin_amdgcn_rcpf(d[2]); r[3] = __builtin_amdgcn_rcpf(d[3]); return x * r; }
__device__ __forceinline__ f32x4 fsigmoid4(f32x4 x) { const f32x4 t = x * (-1.4426950408889634f);
    f32x4 e; e[0] = __builtin_amdgcn_exp2f(t[0]); e[1] = __builtin_amdgcn_exp2f(t[1]); e[2] = __builtin_amdgcn_exp2f(t[2]); e[3] = __builtin_amdgcn_exp2f(t[3]);
    const f32x4 d = e + 1.0f; f32x4 r; r[0] = __builtin_amdgcn_rcpf(d[0]); r[1] = __builtin_amdgcn_rcpf(d[1]); r[2] = __builtin_amdgcn_rcpf(d[2]); r[3] = __builtin_amdgcn_rcpf(d[3]); return r; }
__device__ __forceinline__ float wave_sum(float v) {
#pragma unroll
    for (int o = 1; o < 64; o <<= 1) v += __shfl_xor(v, o);
    return v;
}

#define EPI_LOOP_BEGIN \
    const int row0 = u.pm * 256 + wr * 64 + fr, col0 = u.pn * 256 + wc * 32 + 8 * fq; \
    _Pragma("unroll") for (int ai = 0; ai < 2; ++ai) _Pragma("unroll") for (int m = 0; m < 4; ++m) { const size_t row = (size_t)(row0 + ai * 128 + m * 16); \
    _Pragma("unroll") for (int bj = 0; bj < 2; ++bj) { const int col = col0 + bj * 128; f32x4 v0 = acc[ai][bj][m][0], v1 = acc[ai][bj][m][1];
#define EPI_LOOP_END } }
__device__ __forceinline__ u32x4 pack8(f32x4 v0, f32x4 v1) { u32x4 w; w.x = cvt_pk_bf16(v0[0], v0[1]); w.y = cvt_pk_bf16(v0[2], v0[3]); w.z = cvt_pk_bf16(v1[0], v1[1]); w.w = cvt_pk_bf16(v1[2], v1[3]); return w; }

struct EpiZ {
    static constexpr bool PERM = true, AFTER_DRAIN = false; bf16_t* Z;
    __device__ __forceinline__ void operator()(const f32x4 (&acc)[2][2][4][2], const Unit& u, int wr, int wc, int fr, int fq) const {
        const int sec = u.pn >> 2; const int mode = (sec == 2) ? 0 : (sec >= 4 ? 2 : 1); bf16_t* Zs = Z + (size_t)sec * ZSEC;
        EPI_LOOP_BEGIN
            if (mode == 1) { v0 = fgelu4(v0); v1 = fgelu4(v1); }
            else if (mode == 2) { v0 = fsigmoid4(v0); v1 = fsigmoid4(v1); }
            *(u32x4*)(Zs + row * ZLD + (col & 1023)) = pack8(v0, v1);
        EPI_LOOP_END
    }
};
struct EpiPlain {
    static constexpr bool PERM = true, AFTER_DRAIN = false; bf16_t* O; int ldc;
    __device__ __forceinline__ void operator()(const f32x4 (&acc)[2][2][4][2], const Unit& u, int wr, int wc, int fr, int fq) const {
        EPI_LOOP_BEGIN
            *(u32x4*)(O + row * ldc + col) = pack8(v0, v1);
        EPI_LOOP_END
    }
};
__device__ __forceinline__ void mul8(f32x4& v0, f32x4& v1, const u32x4 w) { v0[0] *= bf_lo(w.x); v0[1] *= bf_hi(w.x); v0[2] *= bf_lo(w.y); v0[3] *= bf_hi(w.y); v1[0] *= bf_lo(w.z); v1[1] *= bf_hi(w.z); v1[2] *= bf_lo(w.w); v1[3] *= bf_hi(w.w); }
__device__ __forceinline__ void add8(f32x4& v0, f32x4& v1, const u32x4 w) { v0[0] += bf_lo(w.x); v0[1] += bf_hi(w.x); v0[2] += bf_lo(w.y); v0[3] += bf_hi(w.y); v1[0] += bf_lo(w.z); v1[1] += bf_hi(w.z); v1[2] += bf_lo(w.w); v1[3] += bf_hi(w.w); }
template <bool ADD> struct EpiGate {
    static constexpr bool PERM = true, AFTER_DRAIN = false; bf16_t* O; const bf16_t* G; int ld;
    __device__ __forceinline__ void operator()(const f32x4 (&acc)[2][2][4][2], const Unit& u, int wr, int wc, int fr, int fq) const {
        const int row0 = u.pm * 256 + wr * 64 + fr, col0 = u.pn * 256 + wc * 32 + 8 * fq;
        if constexpr (!ADD) {
            u32x4 gw[2][4][2];
#pragma unroll
            for (int ai = 0; ai < 2; ++ai)
#pragma unroll
                for (int m = 0; m < 4; ++m)
#pragma unroll
                    for (int bj = 0; bj < 2; ++bj) gw[ai][m][bj] = *(const u32x4*)(G + (size_t)(row0 + ai * 128 + m * 16) * ld + col0 + bj * 128);
#pragma unroll
            for (int ai = 0; ai < 2; ++ai)
#pragma unroll
                for (int m = 0; m < 4; ++m)
#pragma unroll
                    for (int bj = 0; bj < 2; ++bj) { f32x4 v0 = acc[ai][bj][m][0], v1 = acc[ai][bj][m][1]; mul8(v0, v1, gw[ai][m][bj]);
                        *(u32x4*)(O + (size_t)(row0 + ai * 128 + m * 16) * ld + col0 + bj * 128) = pack8(v0, v1); }
        } else {
#pragma unroll
            for (int ai = 0; ai < 2; ++ai) {
                u32x4 gw[4][2], ow[4][2];
#pragma unroll
                for (int m = 0; m < 4; ++m)
#pragma unroll
                    for (int bj = 0; bj < 2; ++bj) { const size_t off = (size_t)(row0 + ai * 128 + m * 16) * ld + col0 + bj * 128; gw[m][bj] = *(const u32x4*)(G + off); ow[m][bj] = *(const u32x4*)(O + off); }
#pragma unroll
                for (int m = 0; m < 4; ++m)
#pragma unroll
                    for (int bj = 0; bj < 2; ++bj) { const size_t off = (size_t)(row0 + ai * 128 + m * 16) * ld + col0 + bj * 128; f32x4 v0 = acc[ai][bj][m][0], v1 = acc[ai][bj][m][1];
                        mul8(v0, v1, gw[m][bj]); add8(v0, v1, ow[m][bj]);
                        *(u32x4*)(O + off) = pack8(v0, v1); }
            }
        }
    }
};
struct EpiSwiglu {
    static constexpr bool PERM = true, AFTER_DRAIN = false; bf16_t* O;
    __device__ __forceinline__ void operator()(const f32x4 (&acc)[2][2][4][2], const Unit& u, int wr, int wc, int fr, int fq) const {
        const int row0 = u.pm * 256 + wr * 64 + fr, hid = u.pn * 128 + wc * 32 + 8 * fq;
#pragma unroll
        for (int ai = 0; ai < 2; ++ai)
#pragma unroll
            for (int m = 0; m < 4; ++m) { const size_t row = (size_t)(row0 + ai * 128 + m * 16);
                const f32x4 o0 = acc[ai][0][m][0] * fsigmoid4(acc[ai][0][m][0]) * acc[ai][1][m][0], o1 = acc[ai][0][m][1] * fsigmoid4(acc[ai][0][m][1]) * acc[ai][1][m][1];
                *(u32x4*)(O + row * DFF + hid) = pack8(o0, o1); }
    }
};
struct EpiSigMul {
    static constexpr bool PERM = true, AFTER_DRAIN = false; bf16_t* O;
    __device__ __forceinline__ void operator()(const f32x4 (&acc)[2][2][4][2], const Unit& u, int wr, int wc, int fr, int fq) const {
        const int row0 = u.pm * 256 + wr * 64 + fr, col0 = u.pn * 256 + wc * 32 + 8 * fq;
#pragma unroll
        for (int ai = 0; ai < 2; ++ai) {
            u32x4 ow[4][2];
#pragma unroll
            for (int m = 0; m < 4; ++m)
#pragma unroll
                for (int bj = 0; bj < 2; ++bj) ow[m][bj] = *(const u32x4*)(O + (size_t)(row0 + ai * 128 + m * 16) * DM + col0 + bj * 128);
#pragma unroll
            for (int m = 0; m < 4; ++m)
#pragma unroll
                for (int bj = 0; bj < 2; ++bj) { f32x4 v0 = acc[ai][bj][m][0], v1 = acc[ai][bj][m][1];
#pragma unroll
                    for (int e = 0; e < 4; ++e) { v0[e] = fsigmoid(v0[e]); v1[e] = fsigmoid(v1[e]); }
                    mul8(v0, v1, ow[m][bj]);
                    *(u32x4*)(O + (size_t)(row0 + ai * 128 + m * 16) * DM + col0 + bj * 128) = pack8(v0, v1); }
        }
    }
};

struct PanelOrder {
    int nN, pm;
    __device__ void init(int N, int pm_) { nN = N / 256; pm = pm_; }
    __device__ bool next(int i, Unit& u) const { if (i >= nN) return false; u.pm = pm; u.pn = i; return true; }
    __device__ __forceinline__ void a_ready(const Unit&) const {}
    __device__ __forceinline__ void done(const Unit&) const {}
};
template <int MODE> __device__ __forceinline__ void transpose_item(const float* W, int K, int N, bf16_t* WT, LAS float* scr, int item, int lane) {
    const int nblk = N / 32, kb = item / nblk, nb = item % nblk, k0 = 64 * kb, n0 = 32 * nb;
    float tv[32];
#pragma unroll
    for (int i = 0; i < 32; ++i) tv[i] = W[(size_t)(k0 + 2 * i + (lane >> 5)) * N + n0 + (lane & 31)];
#pragma unroll
    for (int i = 0; i < 32; ++i) scr[(2 * i + (lane >> 5)) * 33 + (lane & 31)] = tv[i];
    asm volatile("s_waitcnt lgkmcnt(0)" ::: "memory");
    const int c = lane & 7;
#pragma unroll
    for (int j = 0; j < 4; ++j) { const int n = (lane >> 3) + 8 * j; const LAS float* s = scr + (8 * c) * 33 + n;
        u32x4 o; o.x = cvt_pk_bf16(s[0 * 33], s[1 * 33]); o.y = cvt_pk_bf16(s[2 * 33], s[3 * 33]); o.z = cvt_pk_bf16(s[4 * 33], s[5 * 33]); o.w = cvt_pk_bf16(s[6 * 33], s[7 * 33]);
        const int ng = n0 + n; const int drow = (MODE == 0) ? ng : (256 * (ng >> 7) + (ng & 127) + 128 * (MODE - 1));
        *(u32x4*)(WT + (size_t)drow * K + k0 + 8 * c) = o; }
    asm volatile("s_waitcnt lgkmcnt(0)" ::: "memory");
}

struct Args { const float* in[28]; float* out; unsigned char* ws; int ph_lo, ph_hi; };

__device__ __forceinline__ void prologue(const __attribute__((address_space(4))) Args* ap, LAS unsigned char* lds, int gw, int NGW, int wave, int lane) {
    Args a;
    for (int i = 0; i < 28; ++i) a.in[i] = ap->in[i];
    a.out = ap->out; a.ws = ap->ws;
    unsigned char* ws = a.ws;
    LAS float* scr = (LAS float*)(lds + wave * 16384);
    constexpr int I_IN = 16 * (NIN / 32), I_SQ = 16 * 32, I_GU = 16 * (DFF / 32), I_DN = (DFF / 64) * 32, I_PI = 4 * 32;
    constexpr int NITEMS = I_IN + 4 * I_SQ + 2 * I_GU + I_DN + I_PI;
    for (int it = gw; it < NITEMS; it += NGW) {
        int r = it;
        if (r < I_IN) { transpose_item<0>(a.in[4], DM, NIN, (bf16_t*)(ws + WS_WIN), scr, r, lane); continue; } r -= I_IN;
        if (r < I_SQ) { transpose_item<0>(a.in[16], DM, DM, (bf16_t*)(ws + WS_WA), scr, r, lane); continue; } r -= I_SQ;
        if (r < I_SQ) { transpose_item<0>(a.in[17], DM, DM, (bf16_t*)(ws + WS_WB), scr, r, lane); continue; } r -= I_SQ;
        if (r < I_SQ) { transpose_item<0>(a.in[18], DM, DM, (bf16_t*)(ws + WS_WO), scr, r, lane); continue; } r -= I_SQ;
        if (r < I_SQ) { transpose_item<0>(a.in[27], DM, DM, (bf16_t*)(ws + WS_WPG), scr, r, lane); continue; } r -= I_SQ;
        if (r < I_GU) { transpose_item<1>(a.in[21], DM, DFF, (bf16_t*)(ws + WS_WGU), scr, r, lane); continue; } r -= I_GU;
        if (r < I_GU) { transpose_item<2>(a.in[22], DM, DFF, (bf16_t*)(ws + WS_WGU), scr, r, lane); continue; } r -= I_GU;
        if (r < I_DN) { transpose_item<0>(a.in[23], DFF, DM, (bf16_t*)(ws + WS_WDN), scr, r, lane); continue; } r -= I_DN;
        transpose_item<0>(a.in[26], PLE, DM, (bf16_t*)(ws + WS_WPIN), scr, r, lane);
    }
    const int gt = gw * 64 + lane, NGT = NGW * 64;
    { const float* wsrc = a.in[7]; bf16_t* d = (bf16_t*)(ws + WS_WSB);
      for (int e = gt; e < 8 * 128 * 128; e += NGT) { const int i = (e >> 7) & 127, j = e & 127; d[e] = ((j >> 6) <= (i >> 6)) ? f2bf(wsrc[e]) : (bf16_t)0; } }
    { bf16_t* d = (bf16_t*)(ws + WS_LRT); const float* cw = a.in[9];
      for (int e = gt; e < 2 * 16 * 4 * 64 * 64; e += NGT) { const int c = e & 63, j = (e >> 6) & 63, k = (e >> 12) & 3, hd = (e >> 14) & 15, which = e >> 18;
          const float* src = which ? a.in[13] : a.in[11]; d[e] = f2bf(cw[k * DM + hd * 64 + c] * src[hd * 4096 + c * 64 + j]); } }
    { float* d = (float*)(ws + WS_BIASP); const float* cb = a.in[10];
      for (int e = gw; e < 2 * DM; e += NGW) { const int which = e >> 10, ch = e & 1023, hd = ch >> 6, j = ch & 63; const float* w = (which ? a.in[13] : a.in[11]) + hd * 4096 + j;
          const float part = wave_sum(cb[hd * 64 + lane] * w[lane * 64]);
          if (lane == 0) d[e] = (which ? a.in[14] : a.in[12])[ch] + part; }
      for (int e = gt; e < DM; e += NGT) d[2 * DM + e] = 8.0f * 1.4426950408889634f * log1pf(expf(-a.in[15][e])); }
    { const f32x4* src = (const f32x4*)a.in[1]; u32x2* d = (u32x2*)(ws + WS_PB);
      for (int e = gt; e < M * PLE / 4; e += 4 * NGT) { f32x4 v[4];
#pragma unroll
          for (int i = 0; i < 4; ++i) v[i] = src[e + i * NGT < M * PLE / 4 ? e + i * NGT : e];
#pragma unroll
          for (int i = 0; i < 4; ++i) if (e + i * NGT < M * PLE / 4) { u32x2 w; w.x = cvt_pk_bf16(v[i][0], v[i][1]); w.y = cvt_pk_bf16(v[i][2], v[i][3]); d[e + i * NGT] = w; } } }
    { const float* x = a.in[0]; const float* g = a.in[2]; bf16_t* H = (bf16_t*)(ws + WS_H);
      f32x4 nx[4], gq[4];
#pragma unroll
      for (int j = 0; j < 4; ++j) { gq[j] = *(const f32x4*)(g + 256 * j + 4 * lane); nx[j] = *(const f32x4*)(x + (size_t)gw * DM + 256 * j + 4 * lane); }
      for (int m = gw; m < M; m += NGW) {
          f32x4 v[4]; float ss = 0.f;
#pragma unroll
          for (int j = 0; j < 4; ++j) { v[j] = nx[j]; ss += (v[j][0] * v[j][0] + v[j][1] * v[j][1]) + (v[j][2] * v[j][2] + v[j][3] * v[j][3]); }
          { const int mn = m + NGW < M ? m + NGW : m;
#pragma unroll
              for (int j = 0; j < 4; ++j) nx[j] = *(const f32x4*)(x + (size_t)mn * DM + 256 * j + 4 * lane); }
          const float rs = rsqrtf(wave_sum(ss) * (1.f / DM) + EPS);
#pragma unroll
          for (int j = 0; j < 4; ++j) { const f32x4 gg = gq[j]; u32x2 w; w.x = cvt_pk_bf16(v[j][0] * rs * gg[0], v[j][1] * rs * gg[1]); w.y = cvt_pk_bf16(v[j][2] * rs * gg[2], v[j][3] * rs * gg[3]);
              *(u32x2*)(H + (size_t)m * DM + 256 * j + 4 * lane) = w; }
      } }
}

template <bool XIN_BF16, bool XOUT_BF16>
__device__ __forceinline__ void norm_pass(const unsigned char* xin, size_t xin_pitch, const bf16_t* y, int ldy, const float* g1, unsigned char* xo, size_t xo_pitch, const float* g2, bf16_t* hn, int wave, int lane) {
    u32x4 yq[2], xb[2]; f32x4 xf[2][2];
    f32x4 G1[2][2], G2[2][2];
#pragma unroll
    for (int j = 0; j < 2; ++j) { const int c0 = 512 * j + 8 * lane; G1[j][0] = *(const f32x4*)(g1 + c0); G1[j][1] = *(const f32x4*)(g1 + c0 + 4);
        if (g2) { G2[j][0] = *(const f32x4*)(g2 + c0); G2[j][1] = *(const f32x4*)(g2 + c0 + 4); } else { G2[j][0] = G1[j][0]; G2[j][1] = G1[j][1]; } }
#define NP_LOAD(r_) do { _Pragma("unroll") for (int j = 0; j < 2; ++j) { const int c0 = 512 * j + 8 * lane; yq[j] = *(const u32x4*)(y + (size_t)(r_) * ldy + c0); \
        if (XIN_BF16) xb[j] = *(const u32x4*)(xin + (size_t)(r_) * xin_pitch + 2 * c0); \
        else { xf[j][0] = *(const f32x4*)(xin + (size_t)(r_) * xin_pitch + 4 * c0); xf[j][1] = *(const f32x4*)(xin + (size_t)(r_) * xin_pitch + 4 * c0 + 16); } } } while (0)
    NP_LOAD(wave);
    for (int r = wave; r < 256; r += NWAVES) {
        float yv[16], xv[16]; float ss = 0.f;
#pragma unroll
        for (int j = 0; j < 2; ++j) { const u32x4 w = yq[j];
            yv[8 * j + 0] = bf_lo(w.x); yv[8 * j + 1] = bf_hi(w.x); yv[8 * j + 2] = bf_lo(w.y); yv[8 * j + 3] = bf_hi(w.y); yv[8 * j + 4] = bf_lo(w.z); yv[8 * j + 5] = bf_hi(w.z); yv[8 * j + 6] = bf_lo(w.w); yv[8 * j + 7] = bf_hi(w.w);
            if (XIN_BF16) { const u32x4 a = xb[j];
                xv[8 * j + 0] = bf_lo(a.x); xv[8 * j + 1] = bf_hi(a.x); xv[8 * j + 2] = bf_lo(a.y); xv[8 * j + 3] = bf_hi(a.y); xv[8 * j + 4] = bf_lo(a.z); xv[8 * j + 5] = bf_hi(a.z); xv[8 * j + 6] = bf_lo(a.w); xv[8 * j + 7] = bf_hi(a.w);
            } else {
#pragma unroll
                for (int e = 0; e < 4; ++e) { xv[8 * j + e] = xf[j][0][e]; xv[8 * j + 4 + e] = xf[j][1][e]; } } }
        NP_LOAD(r + NWAVES < 256 ? r + NWAVES : r);
#pragma unroll
        for (int e = 0; e < 16; ++e) ss += yv[e] * yv[e];
        const float rs = rsqrtf(wave_sum(ss) * (1.f / DM) + EPS);
        float s2 = 0.f;
#pragma unroll
        for (int j = 0; j < 2; ++j) { const int c0 = 512 * j + 8 * lane; const f32x4 ga = G1[j][0], gb = G1[j][1];
#pragma unroll
            for (int e = 0; e < 4; ++e) { xv[8 * j + e] += yv[8 * j + e] * rs * ga[e]; xv[8 * j + 4 + e] += yv[8 * j + 4 + e] * rs * gb[e]; }
            if (XOUT_BF16) { *(u32x4*)(xo + (size_t)r * xo_pitch + 2 * c0) = pack8((f32x4){xv[8 * j], xv[8 * j + 1], xv[8 * j + 2], xv[8 * j + 3]}, (f32x4){xv[8 * j + 4], xv[8 * j + 5], xv[8 * j + 6], xv[8 * j + 7]});
#pragma unroll
                for (int e = 0; e < 8; ++e) xv[8 * j + e] = bf1(f2bf(xv[8 * j + e]));
            } else { *(f32x4*)(xo + (size_t)r * xo_pitch + 4 * c0) = (f32x4){xv[8 * j], xv[8 * j + 1], xv[8 * j + 2], xv[8 * j + 3]};
                *(f32x4*)(xo + (size_t)r * xo_pitch + 4 * c0 + 16) = (f32x4){xv[8 * j + 4], xv[8 * j + 5], xv[8 * j + 6], xv[8 * j + 7]}; } }
        if (hn) {
#pragma unroll
            for (int e = 0; e < 16; ++e) s2 += xv[e] * xv[e];
            const float r2 = rsqrtf(wave_sum(s2) * (1.f / DM) + EPS);
#pragma unroll
            for (int j = 0; j < 2; ++j) { const int c0 = 512 * j + 8 * lane; const f32x4 ga = G2[j][0], gb = G2[j][1];
                f32x4 o0, o1;
#pragma unroll
                for (int e = 0; e < 4; ++e) { o0[e] = xv[8 * j + e] * r2 * ga[e]; o1[e] = xv[8 * j + 4 + e] * r2 * gb[e]; }
                *(u32x4*)(hn + (size_t)r * DM + c0) = pack8(o0, o1); }
        }
    }
#undef NP_LOAD
}
#define LDS_BARRIER() do { asm volatile("s_waitcnt lgkmcnt(0)" ::: "memory"); __builtin_amdgcn_s_barrier(); asm volatile("" ::: "memory"); } while (0)
typedef short s16x4 __attribute__((ext_vector_type(4)));
__device__ __forceinline__ void mixerA_unit(LAS unsigned char* lds, int blk, const bf16_t* Z, bf16_t* AO, const bf16_t* WSB, const float* ln_g, const float* ln_b, const float* b_s) {
    const int tid = threadIdx.x, wave = __builtin_amdgcn_readfirstlane(tid >> 6), lane = tid & 63, fr = lane & 15, fq = lane >> 4;
    LAS float* st = (LAS float*)lds;
    LAS bf16_t* Wl = (LAS bf16_t*)(lds + 1024);
    LAS bf16_t* Vn = Wl + 128 * 136;
    LAS float* bsl = (LAS float*)(Vn + 128 * 136);
    const size_t row0 = (size_t)blk * 128;
    const int cc = tid & 15;
    u32x4 wq[4], vq[4]; f32x4 lg0, lg1, lb0, lb1;
#define MA_PREFETCH(g) do { _Pragma("unroll") for (int it = 0; it < 4; ++it) { const int q = tid + 512 * it; wq[it] = *(const u32x4*)(WSB + (g) * 16384 + (q >> 4) * 128 + (q & 15) * 8); \
        vq[it] = *(const u32x4*)(Z + (row0 + (tid >> 4) + 32 * it) * ZLD + ZSEC + (g) * 128 + cc * 8); } \
        lg0 = *(const f32x4*)(ln_g + (g) * 128 + cc * 8); lg1 = *(const f32x4*)(ln_g + (g) * 128 + cc * 8 + 4); lb0 = *(const f32x4*)(ln_b + (g) * 128 + cc * 8); lb1 = *(const f32x4*)(ln_b + (g) * 128 + cc * 8 + 4); } while (0)
    MA_PREFETCH(0);
    u32x2 un[8];
#define MA_LOAD_U(g) do { _Pragma("unroll") for (int it = 0; it < 8; ++it) un[it] = *(const u32x2*)(Z + (row0 + 16 * it + fr) * ZLD + (g) * 128 + 16 * wave + 4 * fq); } while (0)
    MA_LOAD_U(0);
    bsl[tid] = b_s[tid]; bsl[512 + tid] = b_s[512 + tid];
#pragma unroll 8
    for (int rr = 0; rr < 16; ++rr) {
        const int r = 16 * wave + rr; const bf16_t* vp = Z + (row0 + r) * ZLD + ZSEC + lane * 16;
        const u32x4 w0 = *(const u32x4*)vp, w1 = *(const u32x4*)(vp + 8);
        float f[16] = {bf_lo(w0.x), bf_hi(w0.x), bf_lo(w0.y), bf_hi(w0.y), bf_lo(w0.z), bf_hi(w0.z), bf_lo(w0.w), bf_hi(w0.w), bf_lo(w1.x), bf_hi(w1.x), bf_lo(w1.y), bf_hi(w1.y), bf_lo(w1.z), bf_hi(w1.z), bf_lo(w1.w), bf_hi(w1.w)};
        float s = 0.f, q = 0.f;
#pragma unroll
        for (int e = 0; e < 16; ++e) { s += f[e]; q += f[e] * f[e]; }
#pragma unroll
        for (int o = 1; o < 64; o <<= 1) { s += __shfl_xor(s, o); q += __shfl_xor(q, o); }
        const float mean = s * (1.f / 1024.f); const float var = fmaxf(q * (1.f / 1024.f) - mean * mean, 0.f);
        if (lane == 0) { st[2 * r] = mean; st[2 * r + 1] = rsqrtf(var + EPS); }
    }
    LDS_BARRIER();
    const unsigned vaddr = (unsigned)(uintptr_t)(Vn + (8 * fq + (fr >> 2)) * 136 + 16 * wave + 4 * (fr & 3));
    for (int g = 0; g < 8; ++g) {
#pragma unroll
        for (int it = 0; it < 4; ++it) { const int q = tid + 512 * it; *(LAS u32x4*)(Wl + (q >> 4) * 136 + (q & 15) * 8) = wq[it]; }
#pragma unroll
        for (int it = 0; it < 4; ++it) { const int j = (tid >> 4) + 32 * it; const u32x4 w = vq[it]; const float mu = st[2 * j], rs = st[2 * j + 1];
            const f32x4 o0 = (f32x4){(bf_lo(w.x) - mu) * rs * lg0[0] + lb0[0], (bf_hi(w.x) - mu) * rs * lg0[1] + lb0[1], (bf_lo(w.y) - mu) * rs * lg0[2] + lb0[2], (bf_hi(w.y) - mu) * rs * lg0[3] + lb0[3]};
            const f32x4 o1 = (f32x4){(bf_lo(w.z) - mu) * rs * lg1[0] + lb1[0], (bf_hi(w.z) - mu) * rs * lg1[1] + lb1[1], (bf_lo(w.w) - mu) * rs * lg1[2] + lb1[2], (bf_hi(w.w) - mu) * rs * lg1[3] + lb1[3]};
            *(LAS u32x4*)(Vn + j * 136 + cc * 8) = pack8(o0, o1); }
        LDS_BARRIER();
        u32x2 uq[8]; float bsv[8];
#pragma unroll
        for (int it = 0; it < 8; ++it) { uq[it] = un[it]; bsv[it] = bsl[g * 128 + 16 * it + fr]; }
        MA_LOAD_U(g < 7 ? g + 1 : 7);
        MA_PREFETCH(g < 7 ? g + 1 : 7);
        s16x4 t00, t01, t10, t11, t20, t21, t30, t31;
        asm volatile("ds_read_b64_tr_b16 %0, %8\n\tds_read_b64_tr_b16 %1, %8 offset:1088\n\tds_read_b64_tr_b16 %2, %8 offset:8704\n\tds_read_b64_tr_b16 %3, %8 offset:9792\n\t"
                     "ds_read_b64_tr_b16 %4, %8 offset:17408\n\tds_read_b64_tr_b16 %5, %8 offset:18496\n\tds_read_b64_tr_b16 %6, %8 offset:26112\n\tds_read_b64_tr_b16 %7, %8 offset:27200\n\ts_waitcnt lgkmcnt(0)"
                     : "=&v"(t00), "=&v"(t01), "=&v"(t10), "=&v"(t11), "=&v"(t20), "=&v"(t21), "=&v"(t30), "=&v"(t31) : "v"(vaddr) : "memory");
        bf16x8 avk[4];
        avk[0] = __builtin_shufflevector(t00, t01, 0, 1, 2, 3, 4, 5, 6, 7); avk[1] = __builtin_shufflevector(t10, t11, 0, 1, 2, 3, 4, 5, 6, 7);
        avk[2] = __builtin_shufflevector(t20, t21, 0, 1, 2, 3, 4, 5, 6, 7); avk[3] = __builtin_shufflevector(t30, t31, 0, 1, 2, 3, 4, 5, 6, 7);
        f32x4 acc[8];
#pragma unroll
        for (int it = 0; it < 8; ++it) acc[it] = (f32x4){0.f, 0.f, 0.f, 0.f};
#pragma unroll
        for (int k = 0; k < 4; ++k) {
#pragma unroll
            for (int it = 0; it < 8; ++it) { if (it < 4 && k >= 2) continue;
                const bf16x8 bv = *(const LAS bf16x8*)(Wl + (16 * it + fr) * 136 + 32 * k + 8 * fq);
                acc[it] = __builtin_amdgcn_mfma_f32_16x16x32_bf16(avk[k], bv, acc[it], 0, 0, 0); } }
#pragma unroll
        for (int it = 0; it < 8; ++it) { const float bs = bsv[it]; const u32x2 uw = uq[it];
            u32x2 o; o.x = cvt_pk_bf16(bf_lo(uw.x) * (acc[it][0] + bs), bf_hi(uw.x) * (acc[it][1] + bs)); o.y = cvt_pk_bf16(bf_lo(uw.y) * (acc[it][2] + bs), bf_hi(uw.y) * (acc[it][3] + bs));
            *(u32x2*)(AO + (row0 + 16 * it + fr) * DM + g * 128 + 16 * wave + 4 * fq) = o; }
        LDS_BARRIER();
    }
#undef MA_PREFETCH
#undef MA_LOAD_U
}

typedef float f32x16 __attribute__((ext_vector_type(16)));
__device__ __forceinline__ void mixerB_unit(LAS unsigned char* lds, int unit, const bf16_t* Z, bf16_t* BO, const bf16_t* LRT, const float* BIASP, const float* conv_w, const float* conv_b) {
    const int tid = threadIdx.x, wave = __builtin_amdgcn_readfirstlane(tid >> 6), lane = tid & 63, l31 = lane & 31, hh = lane >> 5;
    const int b = unit >> 5, hd = (unit >> 1) & 15, half = unit & 1, ch0 = hd * 64, jo = half * 32;
    const bool is_c = wave < 4;
    constexpr int NT = SEQ / 128;
    LAS bf16_t* wl = (LAS bf16_t*)lds;
    LAS bf16_t* xrl = (LAS bf16_t*)(lds + 36864);
    LAS float* cwl = (LAS float*)(lds + 74592);
    LAS float* alb = (LAS float*)(lds + 75616);
    LAS float* gil = (LAS float*)(lds + 112480);
    LAS float* sA = (LAS float*)(lds + 130912);
    LAS float* sH = sA + 256;
    LAS float* cry = sH + 256;
#pragma unroll
    for (int it = 0; it < 4; ++it) { const int q = tid + 512 * it, row = q >> 3, c8 = q & 7, gate = row >> 7, k = (row >> 5) & 3, j = row & 31;
        *(LAS u32x4*)(wl + row * 72 + c8 * 8) = *(const u32x4*)(LRT + ((size_t)((gate * 16 + hd) * 4 + k) * 64 + jo + j) * 64 + c8 * 8); }
    if (tid < 128) cwl[tid] = conv_w[(tid >> 5) * DM + ch0 + jo + (tid & 31)];
    else if (tid < 192) { const int wq = (tid - 128) >> 5, ch = ch0 + jo + (tid & 31); cwl[128 + (tid - 128)] = BIASP[wq * DM + ch]; cwl[192 + (tid - 128)] = wq ? conv_b[ch] : BIASP[2 * DM + ch]; }
    if (tid < 64) cry[tid] = 0.f;
    const int sid = tid & 255, sc = sid & 31, seg = sid >> 5;
    const bf16_t* xbase = Z + ((size_t)b * SEQ + (sid >> 3)) * ZLD + 2 * ZSEC + ch0 + (sid & 7) * 8;
    const bf16_t* xhalo = Z + ((size_t)b * SEQ + (sid < 24 ? (sid >> 3) : 0)) * ZLD + 2 * ZSEC + ch0 + (sid & 7) * 8 - (ptrdiff_t)3 * ZLD;
    const bf16_t* gbase = Z + ((size_t)b * SEQ + 16 * seg) * ZLD + 3 * ZSEC + ch0 + jo + sc;
    bf16_t* obase = BO + ((size_t)b * SEQ + 16 * seg) * DM + ch0 + jo + sc;
    u32x4 rq[4], hq; unsigned gy[16];
#define MB_LOAD_RAW(tile) do { const bf16_t* xp_ = xbase + (size_t)(tile) * 128 * ZLD; _Pragma("unroll") for (int it = 0; it < 4; ++it) rq[it] = *(const u32x4*)(xp_ + (size_t)(32 * it) * ZLD); \
        hq = *(const u32x4*)(xhalo + (size_t)((tile) > 0 ? (tile) : 1) * 128 * ZLD); } while (0)
#define MB_STORE_RAW(buf) do { LAS bf16_t* xd_ = xrl + (buf) * 9432; _Pragma("unroll") for (int it = 0; it < 4; ++it) *(LAS u32x4*)(xd_ + (3 + (sid >> 3) + 32 * it) * 72 + (sid & 7) * 8) = rq[it]; \
        if (sid < 24) *(LAS u32x4*)(xd_ + (sid >> 3) * 72 + (sid & 7) * 8) = hq; } while (0)
#define MB_LOAD_GY(tile) do { _Pragma("unroll") for (int s_ = 0; s_ < 16; ++s_) gy[s_] = (unsigned)gbase[((size_t)(tile) * 128 + s_) * ZLD]; } while (0)
    const int t_ = 32 * wave + l31;
#define MB_MFMA(GATE, buf, a0_, a1_) do { const LAS bf16_t* xs_ = xrl + (buf) * 9432; _Pragma("unroll") for (int e_ = 0; e_ < 16; ++e_) { a0_[e_] = 0.f; a1_[e_] = 0.f; } \
        _Pragma("unroll") for (int ks = 0; ks < 16; ks += 2) { \
            const bf16x8 w0_ = *(const LAS bf16x8*)(wl + (((GATE) * 4 + (ks >> 2)) * 32 + l31) * 72 + 16 * (ks & 3) + 8 * hh), x0_ = *(const LAS bf16x8*)(xs_ + (t_ + (ks >> 2)) * 72 + 16 * (ks & 3) + 8 * hh); \
            const bf16x8 w1_ = *(const LAS bf16x8*)(wl + (((GATE) * 4 + ((ks + 1) >> 2)) * 32 + l31) * 72 + 16 * ((ks + 1) & 3) + 8 * hh), x1_ = *(const LAS bf16x8*)(xs_ + (t_ + ((ks + 1) >> 2)) * 72 + 16 * ((ks + 1) & 3) + 8 * hh); \
            a0_ = __builtin_amdgcn_mfma_f32_32x32x16_bf16(w0_, x0_, a0_, 0, 0, 0); a1_ = __builtin_amdgcn_mfma_f32_32x32x16_bf16(w1_, x1_, a1_, 0, 0, 0); \
            if ((ks & 2) != 0) __builtin_amdgcn_sched_barrier(0); } \
        } while (0)
#define MB_EW_R(accA, accB, dst) do { const LAS float* bsl_ = cwl + 128; const LAS float* c2l_ = cwl + 192; \
        _Pragma("unroll") for (int i = 0; i < 4; ++i) { f32x4 o_; const f32x4 bs_ = *(const LAS f32x4*)(bsl_ + 8 * i + 4 * hh), c2_ = *(const LAS f32x4*)(c2l_ + 8 * i + 4 * hh); \
            _Pragma("unroll") for (int j = 0; j < 4; ++j) o_[j] = __builtin_amdgcn_exp2f(-c2_[j] * fsigmoid(((accA)[4 * i + j] + (accB)[4 * i + j]) + bs_[j])); \
            *(LAS f32x4*)((dst) + t_ * 36 + 8 * i + 4 * hh) = o_; } } while (0)
#define MB_EW_I(accA, accB, buf, dst) do { const LAS bf16_t* xs_ = xrl + (buf) * 9432; const LAS float* bsl_ = cwl + 160; const LAS float* c2l_ = cwl + 224; \
        _Pragma("unroll") for (int i = 0; i < 4; ++i) { f32x4 xc_ = *(const LAS f32x4*)(c2l_ + 8 * i + 4 * hh); const f32x4 bs_ = *(const LAS f32x4*)(bsl_ + 8 * i + 4 * hh); \
            _Pragma("unroll") for (int k = 0; k < 4; ++k) { const u32x2 w_ = *(const LAS u32x2*)(xs_ + (t_ + k) * 72 + jo + 8 * i + 4 * hh); const f32x4 cw_ = *(const LAS f32x4*)(cwl + k * 32 + 8 * i + 4 * hh); \
                xc_[0] += cw_[0] * bf_lo(w_.x); xc_[1] += cw_[1] * bf_hi(w_.x); xc_[2] += cw_[2] * bf_lo(w_.y); xc_[3] += cw_[3] * bf_hi(w_.y); } \
            f32x4 o_; \
            _Pragma("unroll") for (int j = 0; j < 4; ++j) o_[j] = fsigmoid(((accA)[4 * i + j] + (accB)[4 * i + j]) + bs_[j]) * xc_[j]; \
            *(LAS f32x4*)((dst) + t_ * 36 + 8 * i + 4 * hh) = o_; } } while (0)
    if (!is_c) { MB_LOAD_RAW(0); hq = (u32x4){0u, 0u, 0u, 0u}; MB_STORE_RAW(0); MB_LOAD_RAW(1); MB_STORE_RAW(1); MB_LOAD_RAW(2); MB_LOAD_GY(0); }
    LDS_BARRIER();
    f32x16 accR0, accR1, accI0, accI1;
    if (is_c) { MB_MFMA(0, 0, accR0, accR1); MB_MFMA(1, 0, accI0, accI1); MB_EW_R(accR0, accR1, alb); MB_EW_I(accI0, accI1, 0, gil); MB_MFMA(0, 1, accR0, accR1); }
    LDS_BARRIER();
    float a16[16], g16[16];
    for (int tile = 0; tile < NT; ++tile) {
        if (is_c) { MB_MFMA(1, (tile + 1) & 1, accI0, accI1); MB_EW_R(accR0, accR1, alb + ((tile + 1) & 1) * 4608); }
        else {
            const LAS float* al = alb + (tile & 1) * 4608; float A = 1.f, Hh = 0.f;
#pragma unroll
            for (int s = 0; s < 16; ++s) { const float av = al[(16 * seg + s) * 36 + sc]; a16[s] = av; g16[s] = __builtin_amdgcn_sqrtf(fmaxf(1.0f - av * av, 0.f)) * gil[(16 * seg + s) * 36 + sc]; A *= av; Hh = av * Hh + g16[s]; }
            sA[seg * 32 + sc] = A; sH[seg * 32 + sc] = Hh;
            MB_STORE_RAW(tile & 1);
            MB_LOAD_RAW(tile + 3 < NT ? tile + 3 : NT - 1);
        }
        LDS_BARRIER();
        if (is_c) { MB_MFMA(0, tile & 1, accR0, accR1); MB_EW_I(accI0, accI1, (tile + 1) & 1, gil); }
        else {
            float h = cry[(tile & 1) * 32 + sc];
#pragma unroll
            for (int s = 0; s < 7; ++s) { const float As = sA[s * 32 + sc], Hs = sH[s * 32 + sc]; h = (s < seg) ? As * h + Hs : h; }
            bf16_t* op = obase + (size_t)tile * 128 * DM;
#pragma unroll
            for (int s = 0; s < 16; ++s) { h = a16[s] * h + g16[s]; op[(size_t)s * DM] = f2bf(h * __builtin_bit_cast(float, gy[s] << 16)); }
            if (seg == 7) cry[((tile + 1) & 1) * 32 + sc] = h;
            MB_LOAD_GY(tile + 1 < NT ? tile + 1 : NT - 1);
        }
        LDS_BARRIER();
    }
#undef MB_LOAD_RAW
#undef MB_STORE_RAW
#undef MB_LOAD_GY
#undef MB_MFMA
#undef MB_EW_R
#undef MB_EW_I
}

typedef __attribute__((address_space(1))) unsigned gu32;
#define XB_TMO      128
#define XB_XCNT(j)  (256  + 64 * (j))
#define XB_XSUB(j)  (1280 + 64 * (j))
#define XB_XGEN(j)  (2304 + 64 * (j))
#define XB_TOP      3328
#define XB_TOPGEN   3392
#define XCD_BAR_WORDS 3456
#define XB_SPIN_CAP (1u << 18)

__device__ __forceinline__ unsigned xb_ld(unsigned* p)              { return __hip_atomic_load(p, __ATOMIC_RELAXED, __HIP_MEMORY_SCOPE_AGENT); }
__device__ __forceinline__ unsigned xb_add(unsigned* p, unsigned v) { return __hip_atomic_fetch_add(p, v, __ATOMIC_RELAXED, __HIP_MEMORY_SCOPE_AGENT); }
__device__ __forceinline__ unsigned xb_xcc_id() { return (unsigned)__builtin_amdgcn_s_getreg((3 << 11) | 20) & 0xFu; }
#define XB_SPIN(cond, bar) do { unsigned _sp = 0; while (cond) { __builtin_amdgcn_s_sleep(1); \
    if ((++_sp & 255u) == 0u) { if (xb_ld(&(bar)[XB_TMO])) break; if (_sp > XB_SPIN_CAP) { atomicAdd(&(bar)[XB_TMO], 1u); break; } } } } while (0)

struct XcdBarrier {
    unsigned* bar; unsigned x;
    volatile LAS unsigned* st;
};

__device__ __forceinline__ XcdBarrier xcd_barrier_post(unsigned* bar, volatile LAS unsigned* st) {
    XcdBarrier b; b.bar = bar; b.x = xb_xcc_id(); b.st = st;
    if (threadIdx.x == 0) (void)xb_add(&bar[XB_XCNT(b.x)], 1u);
    return b;
}
__device__ __forceinline__ void xcd_barrier_complete(unsigned* bar, unsigned x, unsigned& nloc, unsigned& nx) {
    const unsigned G = gridDim.x * gridDim.y * gridDim.z;
    unsigned sum, cnt, mine, sp = 0u;
    for (;;) {
        sum = 0u; cnt = 0u; mine = 0u;
#pragma unroll
        for (unsigned j = 0; j < 16; ++j) { const unsigned c = xb_ld(&bar[XB_XCNT(j)]); sum += c; cnt += (c > 0u) ? 1u : 0u; mine = (j == x) ? c : mine; }
        if (sum == G) break;
        __builtin_amdgcn_s_sleep(1);
        if ((++sp & 255u) == 0u) { if (xb_ld(&bar[XB_TMO])) break; if (sp > XB_SPIN_CAP) { atomicAdd(&bar[XB_TMO], 1u); break; } }
    }
    nloc = mine > 0u ? mine : 1u; nx = cnt > 0u ? cnt : 1u;
}

__device__ __forceinline__ void xcd_barrier(const XcdBarrier& b) {
    asm volatile("s_waitcnt vmcnt(0)" ::: "memory");
    __syncthreads();
    if (threadIdx.x == 0) {
        unsigned* bar = b.bar;
        __builtin_amdgcn_s_waitcnt(0);
        unsigned nloc = b.st[0], nx = b.st[1];
        if (nloc == 0u) { xcd_barrier_complete(bar, b.x, nloc, nx); b.st[0] = nloc; b.st[1] = nx; }
        const unsigned old = xb_add(&bar[XB_XSUB(b.x)], 1u);
        const unsigned gen = old / nloc;
        if (old + 1u == (gen + 1u) * nloc) {
            __builtin_amdgcn_fence(__ATOMIC_RELEASE, "agent");
            asm volatile("s_waitcnt vmcnt(0)" ::: "memory");
            const unsigned og = xb_add(&bar[XB_TOP], 1u);
            const unsigned tg = og / nx;
            if (og + 1u == (tg + 1u) * nx) xb_add(&bar[XB_TOPGEN], 1u);
            else XB_SPIN(xb_ld(&bar[XB_TOPGEN]) == tg, bar);
            __builtin_amdgcn_fence(__ATOMIC_ACQUIRE, "agent");
            xb_add(&bar[XB_XGEN(b.x)], 1u);
            asm volatile("s_waitcnt vmcnt(0)" ::: "memory");
        } else {
            XB_SPIN(xb_ld(&bar[XB_XGEN(b.x)]) == gen, bar);
            __builtin_amdgcn_fence(__ATOMIC_ACQUIRE, "agent");
            asm volatile("s_waitcnt vmcnt(0)" ::: "memory");
        }
    }
    __syncthreads();
}
typedef const __attribute__((address_space(4))) Args* KArgs;
__device__ __forceinline__ KArgs kargs() {
#if defined(__HIP_DEVICE_COMPILE__)
    auto p0 = __builtin_amdgcn_kernarg_segment_ptr(); KArgs p = (KArgs)p0; asm volatile("" : "+s"(p)); return p;
#else
    return nullptr;
#endif
}
constexpr int NPHASE = 12;
__global__ void __launch_bounds__(NTHR, 2) fwd_kernel(Args args) {
    extern __shared__ __attribute__((aligned(16))) unsigned char lds_raw[];
    LAS unsigned char* lds = (LAS unsigned char*)lds_raw;
    const int lo = args.ph_lo, hi = args.ph_hi;
    volatile LAS unsigned* bst = (volatile LAS unsigned*)(lds + LDS_BYTES - 64);
    if (threadIdx.x == 0) { bst[0] = 0u; bst[1] = 0u; }
    __syncthreads();
    XcdBarrier xbar; xbar.bar = (unsigned*)args.ws; xbar.x = 0; xbar.st = bst;
    if (hi - lo > 1) xbar = xcd_barrier_post((unsigned*)args.ws, bst);
#define IN(k) (lo <= (k) && (k) < hi)
#define SEAM(k) do { if (IN(k) && IN((k) + 1)) { if ((k) == 0) cg::this_grid().sync(); else xcd_barrier(xbar); } } while (0)
#define PH KArgs ka = kargs(); unsigned char* ws = ka->ws; bf16_t* Z = (bf16_t*)(ws + WS_Z); bf16_t* H = (bf16_t*)(ws + WS_H); const int G = gridDim.x, bx = blockIdx.x; (void)Z; (void)H; (void)G; (void)bx;
#define WV const int lane = threadIdx.x & 63, wave = __builtin_amdgcn_readfirstlane(threadIdx.x >> 6);
    typedef pg8::StaticOrder SO;
    typedef PanelOrder PO;
    if (IN(0)) { PH WV prologue(ka, lds, bx * NWAVES + wave, G * NWAVES, wave, lane); __syncthreads(); }
    SEAM(0);
    if (IN(1)) { PH pg8::Gemm g{H, (const bf16_t*)(ws + WS_WIN), M, NIN, DM, DM}; SO S; S.init(M, NIN, G, bx); EpiZ E{Z};
        pg8::gemm_phase<EpiZ, SO, true, true>(lds, g, S, E); }
    SEAM(1);
    if (IN(2)) { PH mixerB_unit(lds, ((((bx >> 4) << 3) | (bx & 7)) << 1) | ((bx >> 3) & 1), Z, (bf16_t*)ka->out + (size_t)M * DM, (const bf16_t*)(ws + WS_LRT), (const float*)(ws + WS_BIASP), ka->in[9], ka->in[10]); }
    if (IN(3)) { PH for (int u = bx; u < M / 128; u += G) mixerA_unit(lds, u, Z, (bf16_t*)ka->out, (const bf16_t*)(ws + WS_WSB), ka->in[5], ka->in[6], ka->in[8]); }
    SEAM(3);
    if (IN(4)) { PH
        { SO S; S.init(M, DM, G, bx); pg8::Gemm g{(const bf16_t*)ka->out, (const bf16_t*)(ws + WS_WA), M, DM, DM, DM}; EpiGate<false> E{Z + ZSEC, Z + 4 * ZSEC, ZLD}; pg8::gemm_phase<EpiGate<false>, SO, true, true>(lds, g, S, E); }
        __syncthreads();
        { SO S; S.init(M, DM, G, bx); pg8::Gemm g{(const bf16_t*)ka->out + (size_t)M * DM, (const bf16_t*)(ws + WS_WB), M, DM, DM, DM}; EpiGate<true> E{Z + ZSEC, Z + 5 * ZSEC, ZLD}; pg8::gemm_phase<EpiGate<true>, SO, true, true>(lds, g, S, E); }
        __syncthreads();
    }
    SEAM(4);
    if (IN(5)) { PH PO S; S.init(DM, bx); pg8::Gemm g{Z + ZSEC, (const bf16_t*)(ws + WS_WO), M, DM, DM, ZLD}; EpiPlain E{Z + 2 * ZSEC, ZLD}; pg8::gemm_phase<EpiPlain, PO, true, true>(lds, g, S, E); __syncthreads(); }
    if (IN(6)) { PH WV norm_pass<false, true>((const unsigned char*)(ka->in[0] + (size_t)bx * 256 * DM), (size_t)DM * 4, Z + 2 * ZSEC + (size_t)bx * 256 * ZLD, ZLD, ka->in[3], (unsigned char*)ka->out + ((size_t)bx << 20), (size_t)DM * 2, ka->in[19], H + (size_t)bx * 256 * DM, wave, lane); }
    SEAM(6);
    if (IN(7)) { PH pg8::Gemm g{H, (const bf16_t*)(ws + WS_WGU), M, NGU, DM, DM}; SO S; S.init(M, NGU, G, bx); EpiSwiglu E{(bf16_t*)(ws + WS_ACT)};
        pg8::gemm_phase<EpiSwiglu, SO, true, true>(lds, g, S, E); }
    SEAM(7);
    if (IN(8)) { PH pg8::Gemm g{(const bf16_t*)(ws + WS_ACT), (const bf16_t*)(ws + WS_WDN), M, DM, DFF, DFF}; SO S; S.init(M, DM, G, bx); EpiPlain E{(bf16_t*)(ws + WS_F), DM};
        pg8::gemm_phase<EpiPlain, SO, true, true>(lds, g, S, E); }
    SEAM(8);
    if (IN(9)) { PH WV bf16_t* F = (bf16_t*)(ws + WS_F) + (size_t)bx * 256 * DM; norm_pass<true, true>((const unsigned char*)ka->out + ((size_t)bx << 20), (size_t)DM * 2, F, DM, ka->in[20], (unsigned char*)F, (size_t)DM * 2, ka->in[24], H + (size_t)bx * 256 * DM, wave, lane); __syncthreads(); }
    if (IN(10)) { PH
        { PO S; S.init(DM, bx); pg8::Gemm g{(const bf16_t*)(ws + WS_PB), (const bf16_t*)(ws + WS_WPIN), M, DM, PLE, PLE}; EpiPlain E{(bf16_t*)(ws + WS_GE), DM}; pg8::gemm_phase<EpiPlain, PO, true, true>(lds, g, S, E); }
        __syncthreads();
        { PO S; S.init(DM, bx); pg8::Gemm g{H, (const bf16_t*)(ws + WS_WPG), M, DM, DM, DM}; EpiSigMul E{(bf16_t*)(ws + WS_GE)}; pg8::gemm_phase<EpiSigMul, PO, true, true>(lds, g, S, E); }
        __syncthreads();
    }
    if (IN(11)) { PH WV norm_pass<true, false>((const unsigned char*)(ws + WS_F) + (size_t)bx * 256 * DM * 2, (size_t)DM * 2, (const bf16_t*)(ws + WS_GE) + (size_t)bx * 256 * DM, DM, ka->in[25], (unsigned char*)(ka->out + (size_t)bx * 256 * DM), (size_t)DM * 4, nullptr, nullptr, wave, lane); }
#undef PH
#undef WV
#undef IN
#undef SEAM
}

extern "C" void kernel_launch(void* const* d_in, const int* in_sizes, int n_in, void* d_out, int out_size, void* d_ws, size_t ws_size, hipStream_t stream) {
    static int grid = 0;
    if (grid == 0) {
        if (n_in != 28 || in_sizes[0] != M * DM || out_size != M * DM || ws_size < WS_END) { fprintf(stderr, "kernel_launch: unexpected shapes (n_in %d, in0 %d, out %d, ws %zu)\n", n_in, n_in > 0 ? in_sizes[0] : -1, out_size, ws_size); grid = -1; return; }
        int dev = 0, cus = 0, per_cu = 0;
        if (hipGetDevice(&dev) != hipSuccess || hipDeviceGetAttribute(&cus, hipDeviceAttributeMultiprocessorCount, dev) != hipSuccess) { grid = -1; return; }
        if (hipFuncSetAttribute((const void*)fwd_kernel, hipFuncAttributeMaxDynamicSharedMemorySize, LDS_BYTES) != hipSuccess) { fprintf(stderr, "kernel_launch: hipFuncSetAttribute failed\n"); grid = -1; return; }
        if (hipOccupancyMaxActiveBlocksPerMultiprocessor(&per_cu, (const void*)fwd_kernel, NTHR, LDS_BYTES) != hipSuccess || per_cu < 1) { fprintf(stderr, "kernel_launch: occupancy query says %d\n", per_cu); per_cu = 1; }
        (void)hipGetLastError();
        grid = cus * 1;
        if (grid != M / 256) { fprintf(stderr, "kernel_launch: built for a 256-CU device (one workgroup per 256-row panel); got %d CUs\n", cus); grid = -1; return; }
    }
    if (grid < 0) return;
    if (hipMemsetAsync(d_ws, 0, 16384, stream) != hipSuccess) { fprintf(stderr, "kernel_launch: memset failed\n"); return; }
    Args a{};
    for (int i = 0; i < 28; ++i) a.in[i] = (const float*)d_in[i];
    a.out = (float*)d_out; a.ws = (unsigned char*)d_ws;
#if MK_ONE
    a.ph_lo = 0; a.ph_hi = NPHASE;
    void* kargs[] = {&a};
    hipError_t e = hipLaunchCooperativeKernel((const void*)fwd_kernel, dim3(grid), dim3(NTHR), kargs, LDS_BYTES, stream);
    if (e != hipSuccess) fprintf(stderr, "kernel_launch: cooperative launch failed: %s (grid %d)\n", hipGetErrorString(e), grid);
#else
    for (int k = 0; k < NPHASE; ++k) for (int rep = 0; rep < 1 + ((REP_MASK >> k) & 1); ++rep) { a.ph_lo = k; a.ph_hi = k + 1; hipLaunchKernelGGL(fwd_kernel, dim3(grid), dim3(NTHR), LDS_BYTES, stream, a); }
#endif
}
```
